# Optimizing an MI355X kernel written in HIP

```python
import functools
import jax, jax.numpy as jnp
from jax import lax
import numpy as np

D_MODEL = 1024
BATCH = 16
SEQ = 2048
DEPTH = 2

GRID_W = 64
CTX_LEN = 256
HEAD_DIM = 64
A_Q_HEADS = 8
A_KV_HEADS = 2
B_Q_HEADS = 8
B_KV_HEADS = 2
C_HEADS = 16
Q_BLOCK = 128
WINDOW = 128
NA_ROWS = 8
NA_COLS = 16
ROPE_THETA = 10000.0
D_FF = 2816
N_EXPERTS = 8
TOP_K = 2
D_FF_EXPERT = 3584
N_MOD = 6
EPS = 1e-6
NEG_INF = -1e30
ATTN_SCALE = HEAD_DIM ** -0.5

kernel_name = 'hybrid_dit_prefix_block'


def rms_norm(x, g):
    xf = x.astype(jnp.float32)
    y = xf * lax.rsqrt(jnp.mean(xf * xf, axis=-1, keepdims=True) + EPS)
    return (y * g.astype(jnp.float32)).astype(x.dtype)


def modulate(x, g, shift, scale):
    return rms_norm(x, g) * (1 + scale) + shift


def heads(t, n):
    return t.reshape(t.shape[:-1] + (n, HEAD_DIM))


def group(q, n_kv):
    b, n, hq, dh = q.shape
    return q.reshape(b, n, n_kv, hq // n_kv, dh)


def axial_rope(n_tokens):
    t = jnp.arange(n_tokens, dtype=jnp.int32)
    row = (t // GRID_W).astype(jnp.float32)
    col = (t % GRID_W).astype(jnp.float32)
    half = HEAD_DIM // 2
    freqs = ROPE_THETA ** (-jnp.arange(0, half, 2, dtype=jnp.float32) / half)
    ang = jnp.concatenate([row[:, None] * freqs, col[:, None] * freqs], axis=-1)
    return jnp.cos(ang), jnp.sin(ang)


def apply_rope(x, cos, sin):
    xf = x.astype(jnp.float32).reshape(x.shape[:-1] + (HEAD_DIM // 2, 2))
    x1, x2 = xf[..., 0], xf[..., 1]
    c, s = cos[:, None, :], sin[:, None, :]
    out = jnp.stack([x1 * c - x2 * s, x1 * s + x2 * c], axis=-1)
    return out.reshape(x.shape).astype(x.dtype)


def softmax_with_sink(s, sink):
    m = jnp.maximum(jnp.max(s, axis=-1, keepdims=True), sink)
    e = jnp.exp(s - m)
    return e / (jnp.sum(e, axis=-1, keepdims=True) + jnp.exp(sink - m))


def context_attend(q, k, v, sink):
    b, n, hkv, g, dh = q.shape
    s = jnp.einsum('bqhgd,bkhd->bhgqk', q * ATTN_SCALE, k).astype(jnp.float32)
    p = jax.nn.softmax(s, axis=-1) if sink is None else softmax_with_sink(s, sink)
    o = jnp.einsum('bhgqk,bkhd->bqhgd', p.astype(v.dtype), v)
    return o.reshape(b, n, hkv * g * dh)


def global_gqa_latent(q, k_all, v_all):
    b, s, hkv, g, dh = q.shape
    nb = s // Q_BLOCK
    qb = jnp.moveaxis(q.reshape(b, nb, Q_BLOCK, hkv, g, dh), 1, 0) * ATTN_SCALE

    def one_block(q_blk):
        sc = jnp.einsum('bqhgd,bkhd->bhgqk', q_blk, k_all).astype(jnp.float32)
        p = jax.nn.softmax(sc, axis=-1).astype(v_all.dtype)
        return jnp.einsum('bhgqk,bkhd->bqhgd', p, v_all)

    o = lax.map(one_block, qb)
    return jnp.moveaxis(o, 0, 1).reshape(b, s, hkv * g * dh)


def window_gqa_latent(q, k, v, k_ctx, v_ctx, sink):
    b, s, hkv, g, dh = q.shape
    nb = s // Q_BLOCK
    nw = 3 * Q_BLOCK

    def band(t):
        tp = jnp.pad(t, ((0, 0), (Q_BLOCK, Q_BLOCK), (0, 0), (0, 0))).reshape(b, nb + 2, Q_BLOCK, hkv, dh)
        tw = jnp.concatenate([tp[:, :-2], tp[:, 1:-1], tp[:, 2:]], axis=2)
        return jnp.moveaxis(tw, 1, 0)

    kw, vw = band(k), band(v)
    qb = jnp.moveaxis(q.reshape(b, nb, Q_BLOCK, hkv, g, dh), 1, 0) * ATTN_SCALE
    blk = jnp.arange(nb, dtype=jnp.int32)[:, None, None]
    qi = jnp.arange(Q_BLOCK, dtype=jnp.int32)[None, :, None]
    kj = jnp.arange(nw, dtype=jnp.int32)[None, None, :]
    key_pos = (blk - 1) * Q_BLOCK + kj
    allowed = (jnp.abs(kj - Q_BLOCK - qi) <= WINDOW) & (key_pos >= 0) & (key_pos < s)

    def one_block(args):
        q_blk, k_blk, v_blk, ok = args
        s_win = jnp.einsum('bqhgd,bkhd->bhgqk', q_blk, k_blk).astype(jnp.float32)
        s_win = jnp.where(ok[None, None, None], s_win, NEG_INF)
        s_ctx = jnp.einsum('bqhgd,bchd->bhgqc', q_blk, k_ctx).astype(jnp.float32)
        p = softmax_with_sink(jnp.concatenate([s_win, s_ctx], axis=-1), sink).astype(v.dtype)
        return (jnp.einsum('bhgqk,bkhd->bqhgd', p[..., :nw], v_blk)
                + jnp.einsum('bhgqc,bchd->bqhgd', p[..., nw:], v_ctx))

    o = lax.map(one_block, (qb, kw, vw, allowed))
    return jnp.moveaxis(o, 0, 1).reshape(b, s, hkv * g * dh)


def neighbourhood_latent(q, k, v, k_ctx, v_ctx, rpb, rows):
    b, s, h, dh = q.shape
    kh = min(NA_ROWS, rows)
    kg = k.reshape(b, rows, GRID_W, h, dh)
    vg = v.reshape(b, rows, GRID_W, h, dh)
    qg = jnp.moveaxis(q.reshape(b, rows, GRID_W, h, dh), 1, 0) * ATTN_SCALE
    r_idx = jnp.arange(rows, dtype=jnp.int32)
    row_start = jnp.clip(r_idx - kh // 2, 0, rows - kh)
    cols = jnp.arange(GRID_W, dtype=jnp.int32)
    col_start = jnp.clip(cols - NA_COLS // 2, 0, GRID_W - NA_COLS)
    col_in = (cols[None, :] >= col_start[:, None]) & (cols[None, :] < col_start[:, None] + NA_COLS)
    col_bias_idx = jnp.clip(cols[None, :] - cols[:, None] + NA_COLS - 1, 0, 2 * NA_COLS - 2)
    rpb32 = rpb.astype(jnp.float32)
    n_loc = kh * GRID_W

    def one_row(args):
        q_row, r, rs = args
        k_band = lax.dynamic_slice_in_dim(kg, rs, kh, axis=1)
        v_band = lax.dynamic_slice_in_dim(vg, rs, kh, axis=1)
        s_loc = jnp.einsum('bqhd,brkhd->bhqrk', q_row, k_band).astype(jnp.float32)
        row_bias_idx = rs + jnp.arange(kh, dtype=jnp.int32) - r + NA_ROWS - 1
        bias = rpb32[:, row_bias_idx[None, :, None], col_bias_idx[:, None, :]]
        s_loc = jnp.where(col_in[:, None, :], s_loc + bias[None], NEG_INF).reshape(b, h, GRID_W, n_loc)
        s_ctx = jnp.einsum('bqhd,bchd->bhqc', q_row, k_ctx).astype(jnp.float32)
        p = jax.nn.softmax(jnp.concatenate([s_loc, s_ctx], axis=-1), axis=-1).astype(v.dtype)
        return (jnp.einsum('bhqn,bnhd->bqhd', p[..., :n_loc], v_band.reshape(b, n_loc, h, dh))
                + jnp.einsum('bhqc,bchd->bqhd', p[..., n_loc:], v_ctx))

    o = lax.map(one_row, (qg, r_idx, row_start))
    return jnp.moveaxis(o, 0, 1).reshape(b, s, h * dh)


def even_mixer(h_lat, h_ctx, last, *, w_in, w_out, g_q, g_k, sink, cos, sin):
    sizes = [A_Q_HEADS * HEAD_DIM, A_KV_HEADS * HEAD_DIM, A_KV_HEADS * HEAD_DIM,
             B_Q_HEADS * HEAD_DIM, B_KV_HEADS * HEAD_DIM, B_KV_HEADS * HEAD_DIM]
    splits = np.cumsum(sizes)[:-1].tolist()

    def project(h):
        qa, ka, va, qb, kb, vb = jnp.split(h @ w_in, splits, axis=-1)
        return (rms_norm(heads(qa, A_Q_HEADS), g_q), rms_norm(heads(ka, A_KV_HEADS), g_k), heads(va, A_KV_HEADS),
                heads(qb, B_Q_HEADS), heads(kb, B_KV_HEADS), heads(vb, B_KV_HEADS))

    qa, ka, va, qb, kb, vb = project(h_lat)
    cqa, cka, cva, cqb, ckb, cvb = project(h_ctx)
    qa, ka, qb, kb = (apply_rope(t, cos, sin) for t in (qa, ka, qb, kb))
    sink4 = sink.astype(jnp.float32).reshape(B_KV_HEADS, B_Q_HEADS // B_KV_HEADS, 1, 1)
    o_a = global_gqa_latent(group(qa, A_KV_HEADS), jnp.concatenate([ka, cka], axis=1),
                            jnp.concatenate([va, cva], axis=1))
    o_b = window_gqa_latent(group(qb, B_KV_HEADS), kb, vb, ckb, cvb, sink4)
    y_lat = jnp.concatenate([o_a, o_b], axis=-1) @ w_out
    if last:
        return y_lat, None
    c_a = context_attend(group(cqa, A_KV_HEADS), cka, cva, None)
    c_b = context_attend(group(cqb, B_KV_HEADS), ckb, cvb, sink4)
    return y_lat, jnp.concatenate([c_a, c_b], axis=-1) @ w_out


def odd_mixer(h_lat, h_ctx, last, *, w_in, w_out, rpb, rows):
    def project(h):
        q, k, v = jnp.split(h @ w_in, 3, axis=-1)
        return heads(q, C_HEADS), heads(k, C_HEADS), heads(v, C_HEADS)

    q, k, v = project(h_lat)
    cq, ck, cv = project(h_ctx)
    y_lat = neighbourhood_latent(q, k, v, ck, cv, rpb, rows) @ w_out
    if last:
        return y_lat, None
    return y_lat, context_attend(cq[:, :, :, None, :], ck, cv, None) @ w_out


def swiglu(h, w_gate, w_up, w_down):
    return (jax.nn.silu(h @ w_gate) * (h @ w_up)) @ w_down


def moe_swiglu(h, w_router, w_gate, w_up, w_down):
    logits = (h @ w_router).astype(jnp.float32)
    top_val, top_idx = lax.top_k(logits, TOP_K)
    weights = jax.nn.softmax(top_val, axis=-1)
    gates = jnp.sum(jax.nn.one_hot(top_idx, N_EXPERTS, dtype=jnp.float32) * weights[..., None], axis=-2)
    gates = gates.astype(h.dtype)
    out = jnp.zeros_like(h)
    for e in range(N_EXPERTS):
        out = out + gates[..., e:e + 1] * swiglu(h, w_gate[e], w_up[e], w_down[e])
    return out


def sandwich_layer(x, ctx, c, c_ctx, mixer, ffn, last, w_mod, b_mod, g_pre_mix, g_post_mix, g_pre_ffn, g_post_ffn):
    m_lat = jnp.split(jax.nn.silu(c)[:, None, :] @ w_mod + b_mod, N_MOD, axis=-1)
    m_ctx = jnp.split(jax.nn.silu(c_ctx) @ w_mod + b_mod, N_MOD, axis=-1)
    y_lat, y_ctx = mixer(modulate(x, g_pre_mix, m_lat[0], m_lat[1]),
                         modulate(ctx, g_pre_mix, m_ctx[0], m_ctx[1]), last)
    x = x + m_lat[2] * rms_norm(y_lat, g_post_mix)
    x = x + m_lat[5] * rms_norm(ffn(modulate(x, g_pre_ffn, m_lat[3], m_lat[4])), g_post_ffn)
    if not last:
        ctx = ctx + m_ctx[2] * rms_norm(y_ctx, g_post_mix)
        ctx = ctx + m_ctx[5] * rms_norm(ffn(modulate(ctx, g_pre_ffn, m_ctx[3], m_ctx[4])), g_post_ffn)
    return x, ctx


def setup_inputs(seed: int = 0) -> dict:
    key = jax.random.key(seed)
    keys = iter(jax.random.split(key, 64))
    ne, no = (DEPTH + 1) // 2, DEPTH // 2
    in_even = (A_Q_HEADS + 2 * A_KV_HEADS + B_Q_HEADS + 2 * B_KV_HEADS) * HEAD_DIM
    mix_even = (A_Q_HEADS + B_Q_HEADS) * HEAD_DIM
    mix_odd = C_HEADS * HEAD_DIM

    def normal(shape, scale):
        return scale * jax.random.normal(next(keys), shape, jnp.float32)

    def gain(shape):
        return 1.0 + normal(shape, 0.05)

    return {
        'x': normal((BATCH, SEQ, D_MODEL), 1.0),
        'c': normal((BATCH, D_MODEL), 1.0),
        'ctx': normal((BATCH, CTX_LEN, D_MODEL), 1.0),
        'c_ctx': normal((D_MODEL,), 1.0),
        'e_w_mod': normal((ne, D_MODEL, N_MOD * D_MODEL), D_MODEL ** -0.5),
        'e_b_mod': normal((ne, N_MOD * D_MODEL), 0.02),
        'e_g_pre_mix': gain((ne, D_MODEL)),
        'e_g_post_mix': gain((ne, D_MODEL)),
        'e_g_pre_ffn': gain((ne, D_MODEL)),
        'e_g_post_ffn': gain((ne, D_MODEL)),
        'e_w_in': normal((ne, D_MODEL, in_even), D_MODEL ** -0.5),
        'e_w_out': normal((ne, mix_even, D_MODEL), mix_even ** -0.5),
        'e_g_q': gain((ne, HEAD_DIM)),
        'e_g_k': gain((ne, HEAD_DIM)),
        'e_sink': normal((ne, B_Q_HEADS), 0.5),
        'e_w_gate': normal((ne, D_MODEL, D_FF), D_MODEL ** -0.5),
        'e_w_up': normal((ne, D_MODEL, D_FF), D_MODEL ** -0.5),
        'e_w_down': normal((ne, D_FF, D_MODEL), D_FF ** -0.5),
        'o_w_mod': normal((no, D_MODEL, N_MOD * D_MODEL), D_MODEL ** -0.5),
        'o_b_mod': normal((no, N_MOD * D_MODEL), 0.02),
        'o_g_pre_mix': gain((no, D_MODEL)),
        'o_g_post_mix': gain((no, D_MODEL)),
        'o_g_pre_ffn': gain((no, D_MODEL)),
        'o_g_post_ffn': gain((no, D_MODEL)),
        'o_w_in': normal((no, D_MODEL, 3 * mix_odd), D_MODEL ** -0.5),
        'o_w_out': normal((no, mix_odd, D_MODEL), mix_odd ** -0.5),
        'o_rpb': normal((no, C_HEADS, 2 * NA_ROWS - 1, 2 * NA_COLS - 1), 0.1),
        'o_w_router': normal((no, D_MODEL, N_EXPERTS), D_MODEL ** -0.5),
        'o_w_gate': normal((no, N_EXPERTS, D_MODEL, D_FF_EXPERT), D_MODEL ** -0.5),
        'o_w_up': normal((no, N_EXPERTS, D_MODEL, D_FF_EXPERT), D_MODEL ** -0.5),
        'o_w_down': normal((no, N_EXPERTS, D_FF_EXPERT, D_MODEL), D_FF_EXPERT ** -0.5),
    }


def reference(x, c, ctx, c_ctx,
              e_w_mod, e_b_mod, e_g_pre_mix, e_g_post_mix, e_g_pre_ffn, e_g_post_ffn,
              e_w_in, e_w_out, e_g_q, e_g_k, e_sink, e_w_gate, e_w_up, e_w_down,
              o_w_mod, o_b_mod, o_g_pre_mix, o_g_post_mix, o_g_pre_ffn, o_g_post_ffn,
              o_w_in, o_w_out, o_rpb, o_w_router, o_w_gate, o_w_up, o_w_down):
    rows = x.shape[1] // GRID_W
    cos, sin = axial_rope(x.shape[1])
    for i in range(DEPTH):
        j = i // 2
        last = i == DEPTH - 1
        if i % 2 == 0:
            mixer = functools.partial(even_mixer, w_in=e_w_in[j], w_out=e_w_out[j], g_q=e_g_q[j], g_k=e_g_k[j],
                                      sink=e_sink[j], cos=cos, sin=sin)
            ffn = functools.partial(swiglu, w_gate=e_w_gate[j], w_up=e_w_up[j], w_down=e_w_down[j])
            x, ctx = sandwich_layer(x, ctx, c, c_ctx, mixer, ffn, last, e_w_mod[j], e_b_mod[j],
                                    e_g_pre_mix[j], e_g_post_mix[j], e_g_pre_ffn[j], e_g_post_ffn[j])
        else:
            mixer = functools.partial(odd_mixer, w_in=o_w_in[j], w_out=o_w_out[j], rpb=o_rpb[j], rows=rows)
            ffn = functools.partial(moe_swiglu, w_router=o_w_router[j], w_gate=o_w_gate[j], w_up=o_w_up[j],
                                    w_down=o_w_down[j])
            x, ctx = sandwich_layer(x, ctx, c, c_ctx, mixer, ffn, last, o_w_mod[j], o_b_mod[j],
                                    o_g_pre_mix[j], o_g_post_mix[j], o_g_pre_ffn[j], o_g_post_ffn[j])
    return x
```

```cpp
#include <hip/hip_runtime.h>
#include <cstdint>
#include <cstdio>

#define GAS __attribute__((address_space(1)))
#define LAS __attribute__((address_space(3)))
typedef unsigned short bf16;
typedef float f32x4 __attribute__((ext_vector_type(4)));
typedef float f32x2 __attribute__((ext_vector_type(2)));
typedef unsigned u32x4 __attribute__((ext_vector_type(4)));
typedef unsigned u32x2 __attribute__((ext_vector_type(2)));

constexpr int D = 1024, NB = 16, SEQ = 2048, NLAT = NB * SEQ, CTXL = 256, NCTX = NB * CTXL, MTOT = NLAT + NCTX;
constexpr int NQKV0 = 1536, NQKV1 = 3072, FF0 = 2816, FFE = 3584, NE = 8, NMOD = 6;
constexpr int MAXTILES = 264;
constexpr int MAXCH = 4;
constexpr float EPS = 1e-6f;
constexpr float LOG2E = 1.4426950408889634f;
constexpr float QSCALE = 0.125f * LOG2E;
constexpr float W8GU_SCALE = 32.f, W8DN_SCALE = 64.f;
constexpr float W8DN0_SCALE = 64.f, ACT0_SCALE = 8.f;

constexpr size_t MiB = 1u << 20;
constexpr size_t WS_CTL = 0, CTL_ZERO_BYTES = 1 * MiB;
constexpr size_t WS_MODS = 1 * MiB;
constexpr size_t WS_RE = 2 * MiB;
constexpr size_t WS_RW = WS_RE + 256 * 1024;
constexpr size_t WS_RJ = WS_RW + 256 * 1024;
constexpr size_t WS_HS = WS_RJ + 256 * 1024;
constexpr size_t WS_TOKOF = 3 * MiB;
constexpr size_t WS_CTXS = 4 * MiB;
constexpr size_t WS_WIN1 = 20 * MiB, WS_WOUT1 = 26 * MiB;
constexpr size_t WS_W8GU = 28 * MiB, WS_W8DN = 84 * MiB;
constexpr size_t WS_H8 = 112 * MiB;
constexpr size_t WS_HB = 196 * MiB;
constexpr size_t WS_WIN0 = 268 * MiB, WS_WOUT0 = 271 * MiB, WS_WGU0 = 273 * MiB, WS_WDN0 = 284 * MiB;
constexpr size_t WS_OV = 290 * MiB;
constexpr size_t WS_QKV = WS_OV;
constexpr size_t WS_YA = WS_OV;
constexpr size_t WS_ACT0 = WS_OV;
constexpr size_t WS_YB = 488 * MiB;
constexpr size_t WS_ACT8 = 144 * MiB;
constexpr size_t WS_YS = 375 * MiB;
constexpr size_t WS_X3 = 507 * MiB;
constexpr size_t WS_MIN = 571 * MiB;
constexpr int CW_CNT = 64;
constexpr int CW_FILL = 128;
constexpr int CW_DONE = 192;
constexpr int CW_CM = 65536;
constexpr int CM_IN0 = CW_CM, CM_GU0 = CW_CM + 1536, CM_IN1 = CM_GU0 + 5632;
constexpr int CW_BAR = 4096;
constexpr int ROPE_OFF = 131072 + 1024;
constexpr int MISC_OFF = 131072 + 320;

constexpr int TOK_OFF = 131072 + 1024 + 9216;
constexpr int LDS_BYTES = TOK_OFF + 8192;
constexpr int NWAVES = 8, NT = 512;

struct Params {
    const float* in[31];
    float* out;
    unsigned char* ws;
    int tpc;
    int pad;
};

__device__ __forceinline__ unsigned f2bf(float f) { unsigned u = __builtin_bit_cast(unsigned, f); return (u + 0x7fffu + ((u >> 16) & 1u)) >> 16; }
__device__ __forceinline__ unsigned pk2(float lo, float hi) { return f2bf(lo) | (f2bf(hi) << 16); }
__device__ __forceinline__ unsigned pk4_fp8(float a, float b, float c, float d) { unsigned r = 0; r = __builtin_amdgcn_cvt_pk_fp8_f32(a, b, r, false); r = __builtin_amdgcn_cvt_pk_fp8_f32(c, d, r, true); return r; }
__device__ __forceinline__ float bflo(unsigned w) { return __builtin_bit_cast(float, w << 16); }
__device__ __forceinline__ float bfhi(unsigned w) { return __builtin_bit_cast(float, w & 0xffff0000u); }
__device__ __forceinline__ float bf2f(bf16 b) { return __builtin_bit_cast(float, (unsigned)b << 16); }
__device__ __forceinline__ float wave_sum(float v) {
#pragma unroll
    for (int o = 1; o < 64; o <<= 1) v += __shfl_xor(v, o);
    return v;
}
__device__ __forceinline__ float wave_max(float v) {
#pragma unroll
    for (int o = 1; o < 64; o <<= 1) v = fmaxf(v, __shfl_xor(v, o));
    return v;
}
__device__ __forceinline__ float silu_f(float v) { return v / (1.f + __expf(-v)); }

struct Row16 { f32x4 v[4]; };
__device__ __forceinline__ void ld_f32(Row16& r, const float* p, int lane) {
    const f32x4* q = (const f32x4*)p + lane;
#pragma unroll
    for (int j = 0; j < 4; ++j) r.v[j] = q[64 * j];
}
__device__ __forceinline__ void st_f32(const Row16& r, float* p, int lane) {
    f32x4* q = (f32x4*)p + lane;
#pragma unroll
    for (int j = 0; j < 4; ++j) q[64 * j] = r.v[j];
}
__device__ __forceinline__ void ld_bf(Row16& r, const bf16* p, int lane) {
    const u32x2* q = (const u32x2*)p + lane;
#pragma unroll
    for (int j = 0; j < 4; ++j) { const u32x2 w = q[64 * j]; r.v[j] = (f32x4){bflo(w.x), bfhi(w.x), bflo(w.y), bfhi(w.y)}; }
}
__device__ __forceinline__ void st_bf(const Row16& r, bf16* p, int lane) {
    u32x2* q = (u32x2*)p + lane;
#pragma unroll
    for (int j = 0; j < 4; ++j) { u32x2 w; w.x = pk2(r.v[j][0], r.v[j][1]); w.y = pk2(r.v[j][2], r.v[j][3]); q[64 * j] = w; }
}
__device__ __forceinline__ float row_rstd(const Row16& r) {
    float s = 0.f;
#pragma unroll
    for (int j = 0; j < 4; ++j) s += (r.v[j][0] * r.v[j][0] + r.v[j][1] * r.v[j][1]) + (r.v[j][2] * r.v[j][2] + r.v[j][3] * r.v[j][3]);
    return rsqrtf(wave_sum(s) * (1.f / D) + EPS);
}

#define XB_TMO      128
#define XB_XCNT(j)  (256  + 64 * (j))
#define XB_XSUB(j)  (1280 + 64 * (j))
#define XB_XGEN(j)  (2304 + 64 * (j))
#define XB_TOP      3328
#define XB_TOPGEN   3392
#define XCD_BAR_WORDS 3456
#define XB_SPIN_CAP (1u << 18)

__device__ __forceinline__ unsigned xb_ld(unsigned* p)              { return __hip_atomic_load(p, __ATOMIC_RELAXED, __HIP_MEMORY_SCOPE_AGENT); }
__device__ __forceinline__ unsigned xb_add(unsigned* p, unsigned v) { return __hip_atomic_fetch_add(p, v, __ATOMIC_RELAXED, __HIP_MEMORY_SCOPE_AGENT); }
__device__ __forceinline__ unsigned xb_xcc_id() { return (unsigned)__builtin_amdgcn_s_getreg((3 << 11) | 20) & 0xFu; }
#define XB_SPIN(cond, bar) do { unsigned _sp = 0; while (cond) { __builtin_amdgcn_s_sleep(1); \
    if ((++_sp & 255u) == 0u) { if (xb_ld(&(bar)[XB_TMO])) break; if (_sp > XB_SPIN_CAP) { atomicAdd(&(bar)[XB_TMO], 1u); break; } } } } while (0)

struct XcdBarrier {
    unsigned* bar; unsigned x;
    volatile LAS unsigned* st;
};

__device__ __forceinline__ XcdBarrier xcd_barrier_post(unsigned* bar, volatile LAS unsigned* st) {
    XcdBarrier b; b.bar = bar; b.x = xb_xcc_id(); b.st = st;
    if (threadIdx.x == 0) (void)xb_add(&bar[XB_XCNT(b.x)], 1u);
    return b;
}
__device__ __forceinline__ void xcd_barrier_complete(unsigned* bar, unsigned x, unsigned& nloc, unsigned& nx) {
    const unsigned G = gridDim.x * gridDim.y * gridDim.z;
    unsigned sum, cnt, mine, sp = 0u;
    for (;;) {
        sum = 0u; cnt = 0u; mine = 0u;
#pragma unroll
        for (unsigned j = 0; j < 16; ++j) { const unsigned c = xb_ld(&bar[XB_XCNT(j)]); sum += c; cnt += (c > 0u) ? 1u : 0u; mine = (j == x) ? c : mine; }
        if (sum == G) break;
        __builtin_amdgcn_s_sleep(1);
        if ((++sp & 255u) == 0u) { if (xb_ld(&bar[XB_TMO])) break; if (sp > XB_SPIN_CAP) { atomicAdd(&bar[XB_TMO], 1u); break; } }
    }
    nloc = mine > 0u ? mine : 1u; nx = cnt > 0u ? cnt : 1u;
}

__device__ __forceinline__ void xcd_barrier(const XcdBarrier& b) {
    asm volatile("s_waitcnt vmcnt(0)" ::: "memory");
    __syncthreads();
    if (threadIdx.x == 0) {
        unsigned* bar = b.bar;
        __builtin_amdgcn_s_waitcnt(0);
        unsigned nloc = b.st[0], nx = b.st[1];
        if (nloc == 0u) { xcd_barrier_complete(bar, b.x, nloc, nx); b.st[0] = nloc; b.st[1] = nx; }
        const unsigned old = xb_add(&bar[XB_XSUB(b.x)], 1u);
        const unsigned gen = old / nloc;
        if (old + 1u == (gen + 1u) * nloc) {
            __builtin_amdgcn_fence(__ATOMIC_RELEASE, "agent");
            asm volatile("s_waitcnt vmcnt(0)" ::: "memory");
            const unsigned og = xb_add(&bar[XB_TOP], 1u);
            const unsigned tg = og / nx;
            if (og + 1u == (tg + 1u) * nx) xb_add(&bar[XB_TOPGEN], 1u);
            else XB_SPIN(xb_ld(&bar[XB_TOPGEN]) == tg, bar);
            __builtin_amdgcn_fence(__ATOMIC_ACQUIRE, "agent");
            xb_add(&bar[XB_XGEN(b.x)], 1u);
            asm volatile("s_waitcnt vmcnt(0)" ::: "memory");
        } else {
            XB_SPIN(xb_ld(&bar[XB_XGEN(b.x)]) == gen, bar);
            __builtin_amdgcn_fence(__ATOMIC_ACQUIRE, "agent");
            asm volatile("s_waitcnt vmcnt(0)" ::: "memory");
        }
    }
    __syncthreads();
}

__device__ __forceinline__ void st_q8(const Row16& h, unsigned char* qrow, float* scale_out, int lane) {
    float am = 0.f;
#pragma unroll
    for (int j = 0; j < 4; ++j) am = fmaxf(fmaxf(am, fmaxf(fabsf(h.v[j][0]), fabsf(h.v[j][1]))), fmaxf(fabsf(h.v[j][2]), fabsf(h.v[j][3])));
    am = fmaxf(wave_max(am), 1e-20f);
    const float inv = 127.f / am;
    unsigned* q = (unsigned*)qrow + lane;
#pragma unroll
    for (int j = 0; j < 4; ++j) { const int a = (int)__builtin_rintf(h.v[j][0] * inv), b = (int)__builtin_rintf(h.v[j][1] * inv), c = (int)__builtin_rintf(h.v[j][2] * inv), d = (int)__builtin_rintf(h.v[j][3] * inv);
        q[64 * j] = (unsigned)(a & 255) | ((unsigned)(b & 255) << 8) | ((unsigned)(c & 255) << 16) | ((unsigned)d << 24); }
    if (lane == 0) *scale_out = am * (1.f / 127.f);
}
struct Ctx {
    Params p;
    LAS unsigned char* lds;
    int tid, lane, wave, vcu, G;
    __device__ __forceinline__ const float* mods(int layer, int r) const { return (const float*)(p.ws + WS_MODS) + ((size_t)layer * 17 + r) * (NMOD * D); }
    __device__ __forceinline__ bf16* hb() const { return (bf16*)(p.ws + WS_HB); }
    __device__ __forceinline__ unsigned* ctl() const { return (unsigned*)(p.ws + WS_CTL); }
};

struct TileTab { int tb[9]; int cnt[8]; };
__device__ __forceinline__ void load_tiletab(const Ctx& C, TileTab& T) {
    int acc = 0;
#pragma unroll
    for (int e = 0; e < NE; ++e) { const int c = __builtin_amdgcn_readfirstlane((int)__hip_atomic_load(C.ctl() + CW_CNT + e, __ATOMIC_RELAXED, __HIP_MEMORY_SCOPE_AGENT)); T.cnt[e] = c; T.tb[e] = acc; acc += (c + 255) >> 8; }
    T.tb[8] = acc;
}
__device__ __forceinline__ int tile_expert(const TileTab& T, int st) {
    int e = 0;
#pragma unroll
    for (int k = 1; k < NE; ++k) e += (st >= T.tb[k]) ? 1 : 0;
    return e;
}

__device__ __forceinline__ void phase_mods(const Ctx& C) {
    LAS float* sl = (LAS float*)C.lds;
    LAS float* part = (LAS float*)(C.lds + 17 * 1024 * 4);
    const float* cin = C.p.in[1]; const float* cctx = C.p.in[3];
    for (int i = C.tid; i < 17 * 1024; i += NT) { const float v = (i < 16 * 1024) ? cin[i] : cctx[i - 16 * 1024]; sl[i] = silu_f(v); }
    __syncthreads();
    const int nitems = 2 * (NMOD * D / 64);
    for (int it = C.vcu; it < nitems; it += C.G) {
        const int layer = it / (NMOD * D / 64), cb = it % (NMOD * D / 64);
        const float* W = C.p.in[layer == 0 ? 4 : 18]; const float* Bv = C.p.in[layer == 0 ? 5 : 19];
        const int col = cb * 64 + C.lane;
        float acc[17];
#pragma unroll
        for (int r = 0; r < 17; ++r) acc[r] = 0.f;
        const int k0 = C.wave * 128;
        float wa[8], wb[8];
#define MODS_LD(w, kb) do { const float* Wk_ = W + (size_t)(kb) * (NMOD * D) + col; _Pragma("unroll") for (int u = 0; u < 8; ++u) w[u] = Wk_[(size_t)u * (NMOD * D)]; } while (0)
#define MODS_FMA(w, kb) do { _Pragma("unroll") for (int u4 = 0; u4 < 2; ++u4) _Pragma("unroll") for (int r = 0; r < 17; ++r) { const f32x4 s = *(const LAS f32x4*)(sl + r * 1024 + (kb) + 4 * u4); \
            acc[r] += s[0] * w[4 * u4] + s[1] * w[4 * u4 + 1] + s[2] * w[4 * u4 + 2] + s[3] * w[4 * u4 + 3]; } } while (0)
        MODS_LD(wa, k0);
#pragma nounroll
        for (int kb = k0; kb < k0 + 128; kb += 16) {
            MODS_LD(wb, kb + 8);
            MODS_FMA(wa, kb);
            if (kb + 16 < k0 + 128) MODS_LD(wa, kb + 16);
            MODS_FMA(wb, kb + 8);
        }
#undef MODS_LD
#undef MODS_FMA
#pragma unroll
        for (int r = 0; r < 17; ++r) part[(C.wave * 17 + r) * 64 + C.lane] = acc[r];
        __syncthreads();
        for (int o = C.tid; o < 17 * 64; o += NT) {
            const int r = o / 64, c = o % 64; float s = 0.f;
#pragma unroll
            for (int w = 0; w < 8; ++w) s += part[(w * 17 + r) * 64 + c];
            ((float*)(C.p.ws + WS_MODS))[((size_t)layer * 17 + r) * (NMOD * D) + cb * 64 + c] = s + Bv[cb * 64 + c];
        }
        __syncthreads();
    }
}

__device__ __forceinline__ void modulate_row(const Row16& x, Row16& h, const float* g, const float* shift, const float* scale, int lane) {
    const float rs = row_rstd(x);
    Row16 gv, sh, sc; ld_f32(gv, g, lane); ld_f32(sh, shift, lane); ld_f32(sc, scale, lane);
#pragma unroll
    for (int j = 0; j < 4; ++j) h.v[j] = x.v[j] * rs * gv.v[j] * (1.f + sc.v[j]) + sh.v[j];
}
__device__ __forceinline__ void ld_lds(Row16& r, const LAS float* p, int lane) {
    const LAS f32x4* q = (const LAS f32x4*)p + lane;
#pragma unroll
    for (int j = 0; j < 4; ++j) r.v[j] = q[64 * j];
}
__device__ __forceinline__ void modulate_row_l(const Row16& x, Row16& h, const LAS float* g, const LAS float* shift, const LAS float* scale, int lane) {
    const float rs = row_rstd(x);
    Row16 gv, sh, sc; ld_lds(gv, g, lane); ld_lds(sh, shift, lane); ld_lds(sc, scale, lane);
#pragma unroll
    for (int j = 0; j < 4; ++j) h.v[j] = x.v[j] * rs * gv.v[j] * (1.f + sc.v[j]) + sh.v[j];
}
__device__ __forceinline__ void resid_row_l(Row16& x, const Row16& y, const LAS float* g, const LAS float* gate, int lane) {
    const float rs = row_rstd(y);
    Row16 gv, ga; ld_lds(gv, g, lane); ld_lds(ga, gate, lane);
#pragma unroll
    for (int j = 0; j < 4; ++j) x.v[j] = x.v[j] + ga.v[j] * (y.v[j] * rs * gv.v[j]);
}
__device__ __forceinline__ void stage5(const Ctx& C, int set, const float* v0, const float* v1, const float* v2, const float* v3, const float* v4, int base = 0) {
    LAS f32x4* P = (LAS f32x4*)(C.lds + base + set * 5 * D * 4);
    int tid_ = C.tid; asm volatile("" : "+v"(tid_));
    for (int i = tid_; i < 5 * D / 4; i += NT) { const int v = i / (D / 4), k = i % (D / 4); const float* src = (v == 0) ? v0 : (v == 1) ? v1 : (v == 2) ? v2 : (v == 3) ? v3 : v4; P[i] = ((const f32x4*)src)[k]; }
}
__device__ __forceinline__ int thin_row(const Ctx& C, int t) {
    return (t < 8) ? (C.vcu >> 4) * SEQ + (C.vcu & 15) * 128 + C.wave * 16 + 2 * t : NLAT + C.vcu * 16 + C.wave * 2;
}
__device__ __forceinline__ void resid_row(Row16& x, const Row16& y, const float* g, const float* gate, int lane) {
    const float rs = row_rstd(y);
    Row16 gv, ga; ld_f32(gv, g, lane); ld_f32(ga, gate, lane);
#pragma unroll
    for (int j = 0; j < 4; ++j) x.v[j] = x.v[j] + ga.v[j] * (y.v[j] * rs * gv.v[j]);
}

__device__ __forceinline__ void modulate0_generic(const Ctx& C) {
    const int gw = C.vcu * NWAVES + C.wave, NGW = C.G * NWAVES;
    Row16 x0, x1, nx0, nx1, h;
#define M0_LD(a0, a1, mm) do { const float* xin_ = ((mm) < NLAT) ? C.p.in[0] + (size_t)(mm) * D : C.p.in[2] + (size_t)((mm) - NLAT) * D; ld_f32(a0, xin_, C.lane); ld_f32(a1, xin_ + D, C.lane); } while (0)
    if (gw < MTOT / 2) M0_LD(x0, x1, 2 * gw);
    for (int mp = gw; mp < MTOT / 2; mp += NGW) {
        const int m = 2 * mp;
        const bool lat = m < NLAT; const int r = lat ? m / SEQ : 16;
        const float* md = C.mods(0, r);
        const bool more = mp + NGW < MTOT / 2;
        if (more) M0_LD(nx0, nx1, 2 * (mp + NGW));
        modulate_row(x0, h, C.p.in[6], md + 0 * D, md + 1 * D, C.lane);
        st_q8(h, C.p.ws + WS_HB + (size_t)m * D, (float*)(C.p.ws + WS_HS) + m, C.lane);
        modulate_row(x1, h, C.p.in[6], md + 0 * D, md + 1 * D, C.lane);
        st_q8(h, C.p.ws + WS_HB + (size_t)(m + 1) * D, (float*)(C.p.ws + WS_HS) + m + 1, C.lane);
        if (more) { x0 = nx0; x1 = nx1; }
    }
#undef M0_LD
}
__device__ __forceinline__ void phase_modulate0(const Ctx& C) {
    int ln = C.lane; asm volatile("" : "+v"(ln));
    if (C.G != 256) { modulate0_generic(C); return; }
    { const float* md = C.mods(0, C.vcu >> 4); const float* mc = C.mods(0, 16);
      stage5(C, 0, C.p.in[6], md, md + D, md, md); stage5(C, 1, C.p.in[6], mc, mc + D, mc, mc); }
    __syncthreads();
    Row16 x0, x1, nx0, nx1, h;
#define M0_LD(a0, a1, mm) do { const float* xin_ = ((mm) < NLAT) ? C.p.in[0] + (size_t)(mm) * D : C.p.in[2] + (size_t)((mm) - NLAT) * D; ld_f32(a0, xin_, ln); ld_f32(a1, xin_ + D, ln); } while (0)
    M0_LD(x0, x1, thin_row(C, 0));
#pragma nounroll
    for (int t = 0; t < 9; ++t) {
        const int m = thin_row(C, t);
        const LAS float* P = (const LAS float*)(C.lds + (t < 8 ? 0 : 5 * D * 4));
        if (t < 8) M0_LD(nx0, nx1, thin_row(C, t + 1));
        modulate_row_l(x0, h, P, P + D, P + 2 * D, ln);
        st_q8(h, C.p.ws + WS_HB + (size_t)m * D, (float*)(C.p.ws + WS_HS) + m, ln);
        modulate_row_l(x1, h, P, P + D, P + 2 * D, ln);
        st_q8(h, C.p.ws + WS_HB + (size_t)(m + 1) * D, (float*)(C.p.ws + WS_HS) + m + 1, ln);
        if (t < 8) { x0 = nx0; x1 = nx1; }
    }
#undef M0_LD
    __syncthreads();
}
__device__ __forceinline__ void thin0a_generic(const Ctx& C) {
    const int gw = C.vcu * NWAVES + C.wave, NGW = C.G * NWAVES;
    const bf16* Y = (const bf16*)(C.p.ws + WS_YA);
    Row16 x0, x1, y0, y1, nx0, nx1, ny0, ny1, h;
#define T0A_LD(a0, a1, b0, b1, mm) do { const float* xin_ = ((mm) < NLAT) ? C.p.in[0] + (size_t)(mm) * D : C.p.in[2] + (size_t)((mm) - NLAT) * D; \
        ld_f32(a0, xin_, C.lane); ld_f32(a1, xin_ + D, C.lane); ld_bf(b0, Y + (size_t)(mm) * D, C.lane); ld_bf(b1, Y + (size_t)((mm) + 1) * D, C.lane); } while (0)
    if (gw < MTOT / 2) T0A_LD(x0, x1, y0, y1, 2 * gw);
    for (int mp = gw; mp < MTOT / 2; mp += NGW) {
        const int m = 2 * mp;
        const bool lat = m < NLAT; const int r = lat ? m / SEQ : 16;
        const float* md = C.mods(0, r);
        const bool more = mp + NGW < MTOT / 2;
        if (more) T0A_LD(nx0, nx1, ny0, ny1, 2 * (mp + NGW));
        resid_row(x0, y0, C.p.in[7], md + 2 * D, C.lane);
        resid_row(x1, y1, C.p.in[7], md + 2 * D, C.lane);
        if (lat) { st_bf(x0, (bf16*)C.p.out + (size_t)m * D, C.lane); st_bf(x1, (bf16*)C.p.out + (size_t)(m + 1) * D, C.lane); }
        else { st_f32(x0, (float*)(C.p.ws + WS_CTXS) + (size_t)(m - NLAT) * D, C.lane); st_f32(x1, (float*)(C.p.ws + WS_CTXS) + (size_t)(m + 1 - NLAT) * D, C.lane); }
        modulate_row(x0, h, C.p.in[8], md + 3 * D, md + 4 * D, C.lane);
        st_q8(h, C.p.ws + WS_HB + (size_t)m * D, (float*)(C.p.ws + WS_HS) + m, C.lane);
        modulate_row(x1, h, C.p.in[8], md + 3 * D, md + 4 * D, C.lane);
        st_q8(h, C.p.ws + WS_HB + (size_t)(m + 1) * D, (float*)(C.p.ws + WS_HS) + m + 1, C.lane);
        if (more) { x0 = nx0; x1 = nx1; y0 = ny0; y1 = ny1; }
    }
#undef T0A_LD
}
__device__ __forceinline__ void phase_thin0a(const Ctx& C) {
    int ln = C.lane; asm volatile("" : "+v"(ln));
    const bf16* Y = (const bf16*)(C.p.ws + WS_YA);
    if (C.G != 256) { thin0a_generic(C); return; }
    { const float* md = C.mods(0, C.vcu >> 4); const float* mc = C.mods(0, 16);
      stage5(C, 0, C.p.in[7], md + 2 * D, C.p.in[8], md + 3 * D, md + 4 * D); stage5(C, 1, C.p.in[7], mc + 2 * D, C.p.in[8], mc + 3 * D, mc + 4 * D); }
    __syncthreads();
    Row16 x0, x1, y0, y1, nx0, nx1, ny0, ny1, h;
#define T0A_LD(a0, a1, b0, b1, mm) do { const float* xin_ = ((mm) < NLAT) ? C.p.in[0] + (size_t)(mm) * D : C.p.in[2] + (size_t)((mm) - NLAT) * D; \
        ld_f32(a0, xin_, ln); ld_f32(a1, xin_ + D, ln); ld_bf(b0, Y + (size_t)(mm) * D, ln); ld_bf(b1, Y + (size_t)((mm) + 1) * D, ln); } while (0)
    T0A_LD(x0, x1, y0, y1, thin_row(C, 0));
#pragma nounroll
    for (int t = 0; t < 9; ++t) {
        const int m = thin_row(C, t);
        const bool lat = t < 8;
        const LAS float* P = (const LAS float*)(C.lds + (lat ? 0 : 5 * D * 4));
        if (t < 8) T0A_LD(nx0, nx1, ny0, ny1, thin_row(C, t + 1));
        resid_row_l(x0, y0, P, P + D, ln);
        resid_row_l(x1, y1, P, P + D, ln);
        if (lat) { st_bf(x0, (bf16*)C.p.out + (size_t)m * D, ln); st_bf(x1, (bf16*)C.p.out + (size_t)(m + 1) * D, ln); }
        else { st_f32(x0, (float*)(C.p.ws + WS_CTXS) + (size_t)(m - NLAT) * D, ln); st_f32(x1, (float*)(C.p.ws + WS_CTXS) + (size_t)(m + 1 - NLAT) * D, ln); }
        modulate_row_l(x0, h, P + 2 * D, P + 3 * D, P + 4 * D, ln);
        st_q8(h, C.p.ws + WS_HB + (size_t)m * D, (float*)(C.p.ws + WS_HS) + m, ln);
        modulate_row_l(x1, h, P + 2 * D, P + 3 * D, P + 4 * D, ln);
        st_q8(h, C.p.ws + WS_HB + (size_t)(m + 1) * D, (float*)(C.p.ws + WS_HS) + m + 1, ln);
        if (t < 8) { x0 = nx0; x1 = nx1; y0 = ny0; y1 = ny1; }
    }
#undef T0A_LD
    __syncthreads();
}
__device__ __forceinline__ void thin0b_generic(const Ctx& C) {
    const int gw = C.vcu * NWAVES + C.wave, NGW = C.G * NWAVES;
    const bf16* Y = (const bf16*)(C.p.ws + WS_YB);
    Row16 x0, x1, y0, y1, nx0, nx1, ny0, ny1, h;
#define T0B_LD(a0, a1, b0, b1, mm) do { \
        if ((mm) < NLAT) { ld_bf(a0, (const bf16*)C.p.out + (size_t)(mm) * D, C.lane); ld_bf(a1, (const bf16*)C.p.out + (size_t)((mm) + 1) * D, C.lane); } \
        else { ld_f32(a0, (const float*)(C.p.ws + WS_CTXS) + (size_t)((mm) - NLAT) * D, C.lane); ld_f32(a1, (const float*)(C.p.ws + WS_CTXS) + (size_t)((mm) + 1 - NLAT) * D, C.lane); } \
        ld_bf(b0, Y + (size_t)(mm) * D, C.lane); ld_bf(b1, Y + (size_t)((mm) + 1) * D, C.lane); } while (0)
    if (gw < MTOT / 2) T0B_LD(x0, x1, y0, y1, 2 * gw);
    for (int mp = gw; mp < MTOT / 2; mp += NGW) {
        const int m = 2 * mp;
        const bool lat = m < NLAT; const int r = lat ? m / SEQ : 16;
        const float* md0 = C.mods(0, r); const float* md1 = C.mods(1, r);
        const bool more = mp + NGW < MTOT / 2;
        if (more) T0B_LD(nx0, nx1, ny0, ny1, 2 * (mp + NGW));
        resid_row(x0, y0, C.p.in[9], md0 + 5 * D, C.lane);
        resid_row(x1, y1, C.p.in[9], md0 + 5 * D, C.lane);
        if (lat) { st_bf(x0, (bf16*)C.p.out + (size_t)m * D, C.lane); st_bf(x1, (bf16*)C.p.out + (size_t)(m + 1) * D, C.lane); }
        modulate_row(x0, h, C.p.in[20], md1 + 0 * D, md1 + 1 * D, C.lane);
        st_q8(h, C.p.ws + WS_HB + (size_t)m * D, (float*)(C.p.ws + WS_HS) + m, C.lane);
        modulate_row(x1, h, C.p.in[20], md1 + 0 * D, md1 + 1 * D, C.lane);
        st_q8(h, C.p.ws + WS_HB + (size_t)(m + 1) * D, (float*)(C.p.ws + WS_HS) + m + 1, C.lane);
        if (more) { x0 = nx0; x1 = nx1; y0 = ny0; y1 = ny1; }
    }
#undef T0B_LD
}
__device__ __forceinline__ void phase_thin0b(const Ctx& C) {
    int ln = C.lane; asm volatile("" : "+v"(ln));
    const bf16* Y = (const bf16*)(C.p.ws + WS_YB);
    if (C.G != 256) { thin0b_generic(C); return; }
    { const float* m0 = C.mods(0, C.vcu >> 4); const float* m1 = C.mods(1, C.vcu >> 4); const float* c0 = C.mods(0, 16); const float* c1 = C.mods(1, 16);
      stage5(C, 0, C.p.in[9], m0 + 5 * D, C.p.in[20], m1, m1 + D); stage5(C, 1, C.p.in[9], c0 + 5 * D, C.p.in[20], c1, c1 + D); }
    __syncthreads();
    Row16 x0, x1, y0, y1, nx0, nx1, ny0, ny1, h;
#define T0B_LD(a0, a1, b0, b1, mm) do { \
        if ((mm) < NLAT) { ld_bf(a0, (const bf16*)C.p.out + (size_t)(mm) * D, ln); ld_bf(a1, (const bf16*)C.p.out + (size_t)((mm) + 1) * D, ln); } \
        else { ld_f32(a0, (const float*)(C.p.ws + WS_CTXS) + (size_t)((mm) - NLAT) * D, ln); ld_f32(a1, (const float*)(C.p.ws + WS_CTXS) + (size_t)((mm) + 1 - NLAT) * D, ln); } \
        ld_bf(b0, Y + (size_t)(mm) * D, ln); ld_bf(b1, Y + (size_t)((mm) + 1) * D, ln); } while (0)
    T0B_LD(x0, x1, y0, y1, thin_row(C, 0));
#pragma nounroll
    for (int t = 0; t < 9; ++t) {
        const int m = thin_row(C, t);
        const bool lat = t < 8;
        const LAS float* P = (const LAS float*)(C.lds + (lat ? 0 : 5 * D * 4));
        if (t < 8) T0B_LD(nx0, nx1, ny0, ny1, thin_row(C, t + 1));
        resid_row_l(x0, y0, P, P + D, ln);
        resid_row_l(x1, y1, P, P + D, ln);
        if (lat) { st_bf(x0, (bf16*)C.p.out + (size_t)m * D, ln); st_bf(x1, (bf16*)C.p.out + (size_t)(m + 1) * D, ln); }
        modulate_row_l(x0, h, P + 2 * D, P + 3 * D, P + 4 * D, ln);
        st_q8(h, C.p.ws + WS_HB + (size_t)m * D, (float*)(C.p.ws + WS_HS) + m, ln);
        modulate_row_l(x1, h, P + 2 * D, P + 3 * D, P + 4 * D, ln);
        st_q8(h, C.p.ws + WS_HB + (size_t)(m + 1) * D, (float*)(C.p.ws + WS_HS) + m + 1, ln);
        if (t < 8) { x0 = nx0; x1 = nx1; y0 = ny0; y1 = ny1; }
    }
#undef T0B_LD
    __syncthreads();
}
__device__ __forceinline__ void thin1a_generic(const Ctx& C) {
    const int gw = C.vcu * NWAVES + C.wave, NGW = C.G * NWAVES;
    const bf16* Y = (const bf16*)(C.p.ws + WS_YA);
    LAS int* lcnt = (LAS int*)C.lds;
    LAS int* lrec = (LAS int*)(C.lds + 256);
    if (C.tid < 16) lcnt[C.tid] = 0;
    __syncthreads();
    const float* wr = C.p.in[27];
    int* RE = (int*)(C.p.ws + WS_RE); float* RW = (float*)(C.p.ws + WS_RW); int* RJ = (int*)(C.p.ws + WS_RJ);
    int it = 0;
    LAS float* wl = (LAS float*)(C.lds + 16384);
    for (int i = C.tid; i < D * 8 / 4; i += NT) { const int col = i >> 1, hh = i & 1;
        ((LAS f32x4*)wl)[(((col >> 8) * 4 + (col & 3)) * 2 + hh) * 64 + ((col & 255) >> 2)] = ((const f32x4*)wr)[i]; }
    __syncthreads();
    auto route = [&](int m, const float (&lg)[8], int it) {
        int e0 = 0; float v0 = lg[0];
#pragma unroll
        for (int e = 1; e < 8; ++e) if (lg[e] > v0) { v0 = lg[e]; e0 = e; }
        int e1 = (e0 == 0) ? 1 : 0; float v1 = (e0 == 0) ? lg[1] : lg[0];
#pragma unroll
        for (int e = 1; e < 8; ++e) if (e != e0 && e != e1 && lg[e] > v1) { v1 = lg[e]; e1 = e; }
        const float w1v = 1.f / (1.f + __expf(v0 - v1)), w0v = 1.f - w1v;
        if (C.lane == 0) {
            const int s0 = __hip_atomic_fetch_add(&lcnt[e0], 1, __ATOMIC_RELAXED, __HIP_MEMORY_SCOPE_WORKGROUP), s1 = __hip_atomic_fetch_add(&lcnt[e1], 1, __ATOMIC_RELAXED, __HIP_MEMORY_SCOPE_WORKGROUP);
            LAS int* rec = lrec + (C.wave * 64 + (it & 63)) * 4; rec[0] = e0; rec[1] = e1; rec[2] = s0; rec[3] = s1;
            RE[2 * m] = e0; RE[2 * m + 1] = e1; RW[2 * m] = w0v; RW[2 * m + 1] = w1v;
        }
    };
    auto do_pair = [&](int m, Row16& xa, const Row16& ya, Row16& xb, const Row16& yb, const float* md, int it) {
        Row16 ha, hb;
        resid_row(xa, ya, C.p.in[21], md + 2 * D, C.lane); resid_row(xb, yb, C.p.in[21], md + 2 * D, C.lane);
        st_bf(xa, (bf16*)(C.p.ws + WS_X3) + (size_t)m * D, C.lane); st_bf(xb, (bf16*)(C.p.ws + WS_X3) + (size_t)(m + 1) * D, C.lane);
        modulate_row(xa, ha, C.p.in[22], md + 3 * D, md + 4 * D, C.lane); modulate_row(xb, hb, C.p.in[22], md + 3 * D, md + 4 * D, C.lane);
        { unsigned* h8 = (unsigned*)(C.p.ws + WS_H8 + (size_t)m * D) + C.lane;
#pragma unroll
          for (int j = 0; j < 4; ++j) { h8[64 * j] = pk4_fp8(ha.v[j][0], ha.v[j][1], ha.v[j][2], ha.v[j][3]); h8[D / 4 + 64 * j] = pk4_fp8(hb.v[j][0], hb.v[j][1], hb.v[j][2], hb.v[j][3]); } }
        float la[8], lb[8];
#pragma unroll
        for (int e = 0; e < 8; ++e) { la[e] = 0.f; lb[e] = 0.f; }
#pragma unroll
        for (int j = 0; j < 4; ++j)
#pragma unroll
            for (int i = 0; i < 4; ++i) {
                const f32x4 w0 = ((const LAS f32x4*)wl)[((j * 4 + i) * 2 + 0) * 64 + C.lane], w1 = ((const LAS f32x4*)wl)[((j * 4 + i) * 2 + 1) * 64 + C.lane];
                const float va = ha.v[j][i], vb = hb.v[j][i];
                la[0] += va * w0[0]; la[1] += va * w0[1]; la[2] += va * w0[2]; la[3] += va * w0[3]; la[4] += va * w1[0]; la[5] += va * w1[1]; la[6] += va * w1[2]; la[7] += va * w1[3];
                lb[0] += vb * w0[0]; lb[1] += vb * w0[1]; lb[2] += vb * w0[2]; lb[3] += vb * w0[3]; lb[4] += vb * w1[0]; lb[5] += vb * w1[1]; lb[6] += vb * w1[2]; lb[7] += vb * w1[3];
            }
#pragma unroll
        for (int e = 0; e < 8; ++e) { la[e] = wave_sum(la[e]); lb[e] = wave_sum(lb[e]); }
        route(m, la, it); route(m + 1, lb, it + 1);
    };
    Row16 x0, x1, y0, y1, nx0, nx1, ny0, ny1;
#define T1A_LD(a0, a1, b0, b1, mm) do { ld_bf(a0, (const bf16*)C.p.out + (size_t)(mm) * D, C.lane); ld_bf(a1, (const bf16*)C.p.out + (size_t)((mm) + 1) * D, C.lane); \
        ld_bf(b0, Y + (size_t)(mm) * D, C.lane); ld_bf(b1, Y + (size_t)((mm) + 1) * D, C.lane); } while (0)
    if (gw < NLAT / 2) T1A_LD(x0, x1, y0, y1, 2 * gw);
    for (int mp = gw; mp < NLAT / 2; mp += NGW, it += 2) {
        const int m = 2 * mp;
        const float* md = C.mods(1, m / SEQ);
        const bool more = mp + NGW < NLAT / 2;
        if (more) T1A_LD(nx0, nx1, ny0, ny1, 2 * (mp + NGW));
        do_pair(m, x0, y0, x1, y1, md, it);
        if (more) { x0 = nx0; x1 = nx1; y0 = ny0; y1 = ny1; }
    }
#undef T1A_LD
    __syncthreads();
    if (C.tid < 8) lcnt[8 + C.tid] = (int)__hip_atomic_fetch_add(C.ctl() + CW_CNT + C.tid, (unsigned)lcnt[C.tid], __ATOMIC_RELAXED, __HIP_MEMORY_SCOPE_AGENT);
    __syncthreads();
    int* TOKOF = (int*)(C.p.ws + WS_TOKOF);
    it = 0;
    for (int mp = gw; mp < NLAT / 2; mp += NGW)
      for (int q = 0; q < 2; ++q, ++it) { const int m = 2 * mp + q;
        if (C.lane == 0) {
            LAS int* rec = lrec + (C.wave * 64 + (it & 63)) * 4; const int e0 = rec[0], e1 = rec[1];
            const int j0 = lcnt[8 + e0] + rec[2], j1 = lcnt[8 + e1] + rec[3];
            RJ[2 * m] = j0; RJ[2 * m + 1] = j1;
            TOKOF[e0 * NLAT + j0] = m; TOKOF[e1 * NLAT + j1] = m;
        }
    }
}
__device__ __forceinline__ void phase_thin1a(const Ctx& C) {
    if (C.G != 256) { thin1a_generic(C); return; }
    int ln = C.lane; asm volatile("" : "+v"(ln));
    const int gw = C.vcu * NWAVES + C.wave, NGW = C.G * NWAVES;
    const bf16* Y = (const bf16*)(C.p.ws + WS_YA);
    LAS int* lcnt = (LAS int*)C.lds;
    LAS int* lrec = (LAS int*)(C.lds + 256);
    if (C.tid < 16) lcnt[C.tid] = 0;
    __syncthreads();
    const float* wr = C.p.in[27];
    int* RE = (int*)(C.p.ws + WS_RE); float* RW = (float*)(C.p.ws + WS_RW); int* RJ = (int*)(C.p.ws + WS_RJ);
    int it = 0;
    LAS float* wl = (LAS float*)(C.lds + 16384);
    for (int i = C.tid; i < D * 8 / 4; i += NT) { const int col = i >> 1, hh = i & 1;
        ((LAS f32x4*)wl)[(((col >> 8) * 4 + (col & 3)) * 2 + hh) * 64 + ((col & 255) >> 2)] = ((const f32x4*)wr)[i]; }
    constexpr int PB = 16384 + 32768;
    { const float* md = C.mods(1, C.vcu >> 4); stage5(C, 0, C.p.in[21], md + 2 * D, C.p.in[22], md + 3 * D, md + 4 * D, PB); }
    const LAS float* P = (const LAS float*)(C.lds + PB);
    __syncthreads();
    auto route = [&](int m, const float (&lg)[8], int it) {
        int e0 = 0; float v0 = lg[0];
#pragma unroll
        for (int e = 1; e < 8; ++e) if (lg[e] > v0) { v0 = lg[e]; e0 = e; }
        int e1 = (e0 == 0) ? 1 : 0; float v1 = (e0 == 0) ? lg[1] : lg[0];
#pragma unroll
        for (int e = 1; e < 8; ++e) if (e != e0 && e != e1 && lg[e] > v1) { v1 = lg[e]; e1 = e; }
        const float w1v = 1.f / (1.f + __expf(v0 - v1)), w0v = 1.f - w1v;
        if (ln == 0) {
            const int s0 = __hip_atomic_fetch_add(&lcnt[e0], 1, __ATOMIC_RELAXED, __HIP_MEMORY_SCOPE_WORKGROUP), s1 = __hip_atomic_fetch_add(&lcnt[e1], 1, __ATOMIC_RELAXED, __HIP_MEMORY_SCOPE_WORKGROUP);
            LAS int* rec = lrec + (C.wave * 64 + (it & 63)) * 4; rec[0] = e0; rec[1] = e1; rec[2] = s0; rec[3] = s1;
            RE[2 * m] = e0; RE[2 * m + 1] = e1; RW[2 * m] = w0v; RW[2 * m + 1] = w1v;
        }
    };
    auto do_pair = [&](int m, Row16& xa, const Row16& ya, Row16& xb, const Row16& yb, const float* md, int it) {
        Row16 ha, hb;
        resid_row_l(xa, ya, P, P + D, ln); resid_row_l(xb, yb, P, P + D, ln);
        st_bf(xa, (bf16*)(C.p.ws + WS_X3) + (size_t)m * D, ln); st_bf(xb, (bf16*)(C.p.ws + WS_X3) + (size_t)(m + 1) * D, ln);
        modulate_row_l(xa, ha, P + 2 * D, P + 3 * D, P + 4 * D, ln); modulate_row_l(xb, hb, P + 2 * D, P + 3 * D, P + 4 * D, ln);
        { unsigned* h8 = (unsigned*)(C.p.ws + WS_H8 + (size_t)m * D) + ln;
#pragma unroll
          for (int j = 0; j < 4; ++j) { h8[64 * j] = pk4_fp8(ha.v[j][0], ha.v[j][1], ha.v[j][2], ha.v[j][3]); h8[D / 4 + 64 * j] = pk4_fp8(hb.v[j][0], hb.v[j][1], hb.v[j][2], hb.v[j][3]); } }
        float la[8], lb[8];
#pragma unroll
        for (int e = 0; e < 8; ++e) { la[e] = 0.f; lb[e] = 0.f; }
#pragma unroll
        for (int j = 0; j < 4; ++j)
#pragma unroll
            for (int i = 0; i < 4; ++i) {
                const f32x4 w0 = ((const LAS f32x4*)wl)[((j * 4 + i) * 2 + 0) * 64 + ln], w1 = ((const LAS f32x4*)wl)[((j * 4 + i) * 2 + 1) * 64 + ln];
                const float va = ha.v[j][i], vb = hb.v[j][i];
                la[0] += va * w0[0]; la[1] += va * w0[1]; la[2] += va * w0[2]; la[3] += va * w0[3]; la[4] += va * w1[0]; la[5] += va * w1[1]; la[6] += va * w1[2]; la[7] += va * w1[3];
                lb[0] += vb * w0[0]; lb[1] += vb * w0[1]; lb[2] += vb * w0[2]; lb[3] += vb * w0[3]; lb[4] += vb * w1[0]; lb[5] += vb * w1[1]; lb[6] += vb * w1[2]; lb[7] += vb * w1[3];
            }
#pragma unroll
        for (int e = 0; e < 8; ++e) { la[e] = wave_sum(la[e]); lb[e] = wave_sum(lb[e]); }
        route(m, la, it); route(m + 1, lb, it + 1);
    };
    Row16 x0, x1, y0, y1, nx0, nx1, ny0, ny1;
#define T1A_LD(a0, a1, b0, b1, mm) do { ld_bf(a0, (const bf16*)C.p.out + (size_t)(mm) * D, ln); ld_bf(a1, (const bf16*)C.p.out + (size_t)((mm) + 1) * D, ln); \
        ld_bf(b0, Y + (size_t)(mm) * D, ln); ld_bf(b1, Y + (size_t)((mm) + 1) * D, ln); } while (0)
    { const int m0 = thin_row(C, 0); ld_bf(x0, (const bf16*)C.p.out + (size_t)m0 * D, ln); ld_bf(x1, (const bf16*)C.p.out + (size_t)(m0 + 1) * D, ln); }
#pragma nounroll
    for (int t = 0; t < 8; ++t, it += 2) {
        const int m = thin_row(C, t);
        ld_bf(y0, Y + (size_t)m * D, ln); ld_bf(y1, Y + (size_t)(m + 1) * D, ln);
        if (t < 7) { const int mn = thin_row(C, t + 1); ld_bf(nx0, (const bf16*)C.p.out + (size_t)mn * D, ln); ld_bf(nx1, (const bf16*)C.p.out + (size_t)(mn + 1) * D, ln); }
        do_pair(m, x0, y0, x1, y1, nullptr, it);
        if (t < 7) { x0 = nx0; x1 = nx1; }
    }
#undef T1A_LD
    __syncthreads();
    if (C.tid < 8) lcnt[8 + C.tid] = (int)__hip_atomic_fetch_add(C.ctl() + CW_CNT + C.tid, (unsigned)lcnt[C.tid], __ATOMIC_RELAXED, __HIP_MEMORY_SCOPE_AGENT);
    __syncthreads();
    int* TOKOF = (int*)(C.p.ws + WS_TOKOF);
    it = 0;
    for (int t = 0; t < 8; ++t)
      for (int q = 0; q < 2; ++q, ++it) { const int m = thin_row(C, t) + q;
        if (ln == 0) {
            LAS int* rec = lrec + (C.wave * 64 + (it & 63)) * 4; const int e0 = rec[0], e1 = rec[1];
            const int j0 = lcnt[8 + e0] + rec[2], j1 = lcnt[8 + e1] + rec[3];
            RJ[2 * m] = j0; RJ[2 * m + 1] = j1;
            TOKOF[e0 * NLAT + j0] = m; TOKOF[e1 * NLAT + j1] = m;
        }
    }
}
static_assert(FFE / 128 == 28 && D / 256 == 4, "K-split geometry");
constexpr int MOE_PTILE0 = (int)(((long long)WS_W8GU - (long long)WS_YS) / (256LL * D * 2));
static_assert(((long long)WS_W8GU - (long long)WS_YS) % (256LL * D * 2) == 0, "partial rows tile-aligned");
__device__ __forceinline__ void moe_split(const Ctx& C, int nT, int& tmt, int& nl) {
    tmt = ((nT * 4) / C.G) * C.G / 4; nl = nT - tmt;
    if ((C.G & 3) != 0 || nl > 8) { tmt = nT; nl = 0; }
}
__device__ __forceinline__ void phase_final(const Ctx& C) {
    const int gw = C.vcu * NWAVES + C.wave, NGW = C.G * NWAVES;
    TileTab T; load_tiletab(C, T);
    const bf16* YS = (const bf16*)(C.p.ws + WS_YS); const bf16* PART = (const bf16*)(C.p.ws + WS_W8GU);
    int tmt, nl; moe_split(C, T.tb[8], tmt, nl);
    const int* RE = (const int*)(C.p.ws + WS_RE); const float* RW = (const float*)(C.p.ws + WS_RW); const int* RJ = (const int*)(C.p.ws + WS_RJ);
    auto rows_of = [&](int m, size_t& p0, size_t& p1, float& w0, float& w1) {
        const int e0 = RE[2 * m], e1 = RE[2 * m + 1]; w0 = RW[2 * m]; w1 = RW[2 * m + 1];
        int b0 = 0, b1 = 0;
#pragma unroll
        for (int k = 0; k < NE; ++k) { b0 = (k == e0) ? T.tb[k] : b0; b1 = (k == e1) ? T.tb[k] : b1; }
        p0 = (size_t)b0 * 256 + RJ[2 * m]; p1 = (size_t)b1 * 256 + RJ[2 * m + 1]; };
    auto add_parts = [&](Row16& y, size_t p) {
        if ((int)(p >> 8) >= tmt) {
#pragma unroll
            for (int k = 0; k < 3; ++k) { Row16 t; ld_bf(t, PART + ((size_t)(8 * k + (int)(p >> 8) - tmt) * 256 + (p & 255)) * D, C.lane);
#pragma unroll
                for (int j = 0; j < 4; ++j) y.v[j] = y.v[j] + t.v[j]; } } };
    size_t pa0, pa1, pb0, pb1, qa0 = 0, qa1 = 0, qb0 = 0, qb1 = 0; float wa0, wa1, wb0, wb1, va0 = 0.f, va1 = 0.f, vb0 = 0.f, vb1 = 0.f;
    Row16 xa, xb, ya0, ya1, yb0, yb1, nxa, nxb, nya0, nya1, nyb0, nyb1;
#define FIN_LD(m_, P0, P1, Q0, Q1, W0, W1, V0, V1, XA, XB, A0, A1, B0_, B1_) do { rows_of((m_), P0, P1, W0, W1); rows_of((m_) + 1, Q0, Q1, V0, V1); \
        ld_bf(XA, (const bf16*)(C.p.ws + WS_X3) + (size_t)(m_) * D, C.lane); ld_bf(XB, (const bf16*)(C.p.ws + WS_X3) + (size_t)((m_) + 1) * D, C.lane); \
        ld_bf(A0, YS + P0 * D, C.lane); ld_bf(A1, YS + P1 * D, C.lane); ld_bf(B0_, YS + Q0 * D, C.lane); ld_bf(B1_, YS + Q1 * D, C.lane); } while (0)
    if (gw < NLAT / 2) FIN_LD(2 * gw, pa0, pa1, pb0, pb1, wa0, wa1, wb0, wb1, xa, xb, ya0, ya1, yb0, yb1);
    for (int mp = gw; mp < NLAT / 2; mp += NGW) {
        const int m = 2 * mp;
        const float* md = C.mods(1, m / SEQ);
        const bool more = mp + NGW < NLAT / 2;
        if (more) FIN_LD(2 * (mp + NGW), qa0, qa1, qb0, qb1, va0, va1, vb0, vb1, nxa, nxb, nya0, nya1, nyb0, nyb1);
        add_parts(ya0, pa0); add_parts(ya1, pa1); add_parts(yb0, pb0); add_parts(yb1, pb1);
#pragma unroll
        for (int j = 0; j < 4; ++j) { ya0.v[j] = ya0.v[j] * wa0 + ya1.v[j] * wa1; yb0.v[j] = yb0.v[j] * wb0 + yb1.v[j] * wb1; }
        resid_row(xa, ya0, C.p.in[23], md + 5 * D, C.lane);
        resid_row(xb, yb0, C.p.in[23], md + 5 * D, C.lane);
        st_f32(xa, C.p.out + (size_t)m * D, C.lane); st_f32(xb, C.p.out + (size_t)(m + 1) * D, C.lane);
        if (more) { pa0 = qa0; pa1 = qa1; pb0 = qb0; pb1 = qb1; wa0 = va0; wa1 = va1; wb0 = vb0; wb1 = vb1; xa = nxa; xb = nxb; ya0 = nya0; ya1 = nya1; yb0 = nyb0; yb1 = nyb1; }
    }
#undef FIN_LD
}

namespace pg8 {
typedef short bf16x8 __attribute__((ext_vector_type(8)));
typedef int i32x4 __attribute__((ext_vector_type(4)));
typedef int i32x8 __attribute__((ext_vector_type(8)));
constexpr int BM = 256, BK = 64, HALF = 128, HTB = HALF * BK * 2, STAGE_BYTES = 8 * HTB, NXCD = 8, WGM = 8;
__host__ __device__ __forceinline__ int lds_byte(int r, int c) { const int st = (r >> 4) * 2 + (c >> 5), rr = r & 15, cc = c & 31, ob = rr * 64 + cc * 2; return st * 1024 + (ob ^ (((ob >> 9) & 1) << 5)); }
__host__ __device__ __forceinline__ void stage_rc(int b, int& R, int& C) { const int st = b / 1024, sb = b % 1024, swz = sb ^ (((sb >> 9) & 1) << 5); R = (st >> 1) * 16 + swz / 64; C = (st & 1) * 32 + (swz % 64) / 2; }
__host__ __device__ __forceinline__ int perm32(int rho) { const int n = rho >> 4, i = rho & 15; return 8 * (i >> 2) + 4 * n + (i & 3); }
struct Unit { int pm, pn, xa, xb, koff, nkt; };
struct Gemm { const bf16* A; const bf16* Bt; int K; };
__device__ __forceinline__ unsigned cvt_pk_bf16(float lo, float hi) { unsigned r; asm volatile("v_cvt_pk_bf16_f32 %0, %1, %2" : "=v"(r) : "v"(lo), "v"(hi)); return r; }
__device__ __forceinline__ void static_map(int L, int nM, int nN, int& pm, int& pn) {
    const int nwg = nM * nN; int wgid = L; { const int q = nwg / NXCD, r = nwg % NXCD, xcd = wgid % NXCD, off = wgid / NXCD; wgid = (xcd < r ? xcd * (q + 1) : r * (q + 1) + (xcd - r) * q) + off; }
    const int nig = WGM * nN, gid = wgid / nig, fm = gid * WGM, gsz = (nM - fm) < WGM ? (nM - fm) : WGM;
    pm = fm + ((wgid % nig) % gsz); pn = (wgid % nig) / gsz;
}
template <class Epi, class Sched, bool ALIGN_EPI, int MODE = 0>
__device__ __forceinline__ void gemm_phase(LAS unsigned char* lds, const Gemm g, const Sched& S, const Epi& E) {
    const int tid = threadIdx.x, wid = __builtin_amdgcn_readfirstlane(tid >> 6), lane = tid & 63, wr = wid >> 2, wc = wid & 3, fr = lane & 15, fq = lane >> 4;
    constexpr bool F8 = MODE == 1, I8 = MODE == 2;
    constexpr int EB = (F8 || I8) ? 1 : 2;
    const int K = g.K, nt = K * EB / (BK * 2);
    unsigned voffB[2], cA2[2]; int RA[2];
#pragma unroll
    for (int i = 0; i < 2; ++i) { int R, C; stage_rc(tid * 16 + i * 8192, R, C); const int Rb = (R & ~31) + perm32(R & 31);
        RA[i] = R; cA2[i] = (unsigned)C * 2u; voffB[i] = (unsigned)(Rb * K * EB + C * 2); }
    const size_t kstep = (size_t)(BK * 2);
    const size_t hstep = (size_t)HALF * K * EB;
    const size_t tstep = 2 * hstep;
    const unsigned ldsw = (unsigned)wid * 1024u;
    const int aoff = lds_byte(wr * 64 + fr, fq * 8), boff = lds_byte(wc * 32 + fr, fq * 8);
#define PG8_SA(b, h) (((b) * 2 + (h)) * HTB)
#define PG8_SB(b, h) ((4 + (b) * 2 + (h)) * HTB)
#define PG8_STAGE(bufoff, gbase, voff) do { _Pragma("unroll") for (int _i = 0; _i < 2; ++_i) \
        __builtin_amdgcn_global_load_lds((const unsigned*)((const char*)(gbase) + (voff)[_i]), (LAS unsigned*)(lds + (bufoff) + ldsw + _i * 8192), 16, 0, 0); } while (0)
#define PG8_LDA(dst, b, h) do { _Pragma("unroll") for (int m = 0; m < 4; ++m) { dst[m].lo = *(const LAS i32x4*)(lds + PG8_SA(b, h) + aoff + m * 2048); dst[m].hi = *(const LAS i32x4*)(lds + PG8_SA(b, h) + aoff + m * 2048 + 1024); } } while (0)
#define PG8_LDB(dst, b, h) do { _Pragma("unroll") for (int n = 0; n < 2; ++n) { dst[n].lo = *(const LAS i32x4*)(lds + PG8_SB(b, h) + boff + n * 2048); dst[n].hi = *(const LAS i32x4*)(lds + PG8_SB(b, h) + boff + n * 2048 + 1024); } } while (0)
#define PG8_H(x, k) __builtin_bit_cast(bf16x8, (k) == 0 ? (x).lo : (x).hi)
#define PG8_MMA(ai, bj, At, Bt) do { __builtin_amdgcn_s_setprio(1); \
        if constexpr (F8) { _Pragma("unroll") for (int m = 0; m < 4; ++m) _Pragma("unroll") for (int n = 0; n < 2; ++n) \
            asm volatile("v_mfma_scale_f32_16x16x128_f8f6f4 %0, %1, %2, %0, %3, %3 op_sel_hi:[0,0,0]" : "+v"(acc[ai][bj][m][n]) : "v"(Bt[n]), "v"(At[m]), "v"(sc127)); } \
        else if constexpr (I8) { _Pragma("unroll") for (int m = 0; m < 4; ++m) _Pragma("unroll") for (int n = 0; n < 2; ++n) _Pragma("unroll") for (int k = 0; k < 2; ++k) \
            acc[ai][bj][m][n] = __builtin_bit_cast(f32x4, __builtin_amdgcn_mfma_i32_16x16x64_i8((k) == 0 ? Bt[n].lo : Bt[n].hi, (k) == 0 ? At[m].lo : At[m].hi, __builtin_bit_cast(i32x4, acc[ai][bj][m][n]), 0, 0, 0)); } \
        else { _Pragma("unroll") for (int m = 0; m < 4; ++m) _Pragma("unroll") for (int n = 0; n < 2; ++n) _Pragma("unroll") for (int k = 0; k < 2; ++k) \
            acc[ai][bj][m][n] = __builtin_amdgcn_mfma_f32_16x16x32_bf16(PG8_H(Bt[n], k), PG8_H(At[m], k), acc[ai][bj][m][n], 0, 0, 0); } \
        __builtin_amdgcn_s_setprio(0); } while (0)
#define PG8_WAIT_V(n) asm volatile("s_waitcnt vmcnt(" #n ")" ::: "memory")
#define PG8_WAIT_L(n) asm volatile("s_waitcnt lgkmcnt(" #n ")" ::: "memory")
#define PG8_BAR __builtin_amdgcn_s_barrier()
#define PG8_SCHED __builtin_amdgcn_sched_barrier(0)
#define PG8_AOFFS(dst, u) do { _Pragma("unroll") for (int _h = 0; _h < 2; ++_h) _Pragma("unroll") for (int _i = 0; _i < 2; ++_i) dst[_h][_i] = S.a_off(u, _h * HALF + RA[_i]) + cA2[_i]; } while (0)
    Unit cur, nxt; int ui = 0;
    if (!S.next(0, cur)) return;
#define PG8_TOKDMA(u) do { _Pragma("unroll") for (int _h = 0; _h < 2; ++_h) _Pragma("unroll") for (int _i = 0; _i < 2; ++_i) \
        __builtin_amdgcn_global_load_lds((const unsigned*)S.a_tokp(u, _h * HALF + RA[_i]), (LAS unsigned*)(lds + TOK_OFF + (wid * 4 + _h * 2 + _i) * 256), 4, 0, 0); } while (0)
    if constexpr (Sched::GATHER) { Unit u1; if (S.next(1, u1)) PG8_TOKDMA(u1); }
    f32x4 acc[2][2][4][2];
#pragma unroll
    for (int a = 0; a < 2; ++a)
#pragma unroll
        for (int b = 0; b < 2; ++b)
#pragma unroll
            for (int m = 0; m < 4; ++m)
#pragma unroll
                for (int n = 0; n < 2; ++n) acc[a][b][m][n] = (f32x4){0.f, 0.f, 0.f, 0.f};
    const int sc127 = 0x7f7f7f7f;
    i32x8 At[4], B0[2], B1[2];
    const char* pA = (const char*)g.A;
    unsigned oA[2][2], nO[2][2];
    PG8_AOFFS(oA, cur);
    constexpr bool KS = Sched::KSPLIT;
    const char* cA = KS ? pA + (size_t)cur.koff * kstep : pA;
    const char* cB = (const char*)g.Bt + (size_t)cur.pn * tstep + (KS ? (size_t)cur.koff * kstep : 0);
    int ntc = KS ? cur.nkt : nt;
    PG8_STAGE(PG8_SB(0, 0), cB, voffB); PG8_STAGE(PG8_SB(0, 1), cB + hstep, voffB); PG8_STAGE(PG8_SA(0, 0), cA, oA[0]); PG8_STAGE(PG8_SA(0, 1), cA, oA[1]);
    if (wr == 1) PG8_BAR;
    PG8_WAIT_V(2); PG8_BAR;
    PG8_STAGE(PG8_SB(1, 0), cB + kstep, voffB); PG8_STAGE(PG8_SA(1, 0), cA + kstep, oA[0]); PG8_STAGE(PG8_SB(1, 1), cB + hstep + kstep, voffB);
    PG8_WAIT_V(6); PG8_BAR;
    for (;;) {
        const bool has_next = S.next(ui + 1, nxt);
        if (has_next) { if constexpr (!Sched::GATHER) PG8_AOFFS(nO, nxt); } else {
#pragma unroll
            for (int h = 0; h < 2; ++h)
#pragma unroll
                for (int i = 0; i < 2; ++i) nO[h][i] = oA[h][i]; }
        const char* nB = has_next ? (const char*)g.Bt + (size_t)nxt.pn * tstep + (KS ? (size_t)nxt.koff * kstep : 0) : cB;
        const char* nA = (KS && has_next) ? pA + (size_t)nxt.koff * kstep : cA;
#pragma nounroll
        for (int t = 0; t < ntc; t += 2) {
            const bool last = (t == ntc - 2);
            if constexpr (Sched::GATHER) { if (last && has_next) {
#pragma unroll
                for (int h = 0; h < 2; ++h)
#pragma unroll
                    for (int i = 0; i < 2; ++i) nO[h][i] = *(const LAS unsigned*)(lds + TOK_OFF + (wid * 4 + h * 2 + i) * 256 + lane * 4) * S.rowbytes + cA2[i]; } }
            const char* a1 = cA + (size_t)(t + 1) * kstep;
            const char* a2 = last ? nA : cA + (size_t)(t + 2) * kstep; const char* b2 = last ? nB : cB + (size_t)(t + 2) * kstep;
            const char* a3 = a2 + kstep; const char* b3 = b2 + kstep;
#define PG8_STAGE_A2(bufoff, gbase, h) do { if constexpr (Sched::GATHER) { if (last) { PG8_STAGE(bufoff, gbase, nO[h]); } else { PG8_STAGE(bufoff, gbase, oA[h]); } } \
                else { unsigned o2_[2]; o2_[0] = last ? nO[h][0] : oA[h][0]; o2_[1] = last ? nO[h][1] : oA[h][1]; PG8_STAGE(bufoff, gbase, o2_); } } while (0)
            PG8_LDB(B0, 0, 0); PG8_LDB(B1, 0, 1); PG8_SCHED; PG8_LDA(At, 0, 0); PG8_STAGE(PG8_SA(1, 1), a1, oA[1]);
            PG8_WAIT_V(8); PG8_WAIT_L(0); PG8_BAR; PG8_MMA(0, 0, At, B0); PG8_MMA(0, 1, At, B1); PG8_BAR; PG8_SCHED;
            PG8_LDA(At, 0, 1); PG8_STAGE(PG8_SB(0, 0), b2, voffB); PG8_STAGE(PG8_SB(0, 1), b2 + hstep, voffB); PG8_STAGE_A2(PG8_SA(0, 0), a2, 0);
            PG8_WAIT_V(8); PG8_WAIT_L(0); PG8_BAR; PG8_MMA(1, 0, At, B0); PG8_MMA(1, 1, At, B1); PG8_BAR; PG8_SCHED;
            PG8_LDB(B0, 1, 0); PG8_LDB(B1, 1, 1); PG8_SCHED; PG8_LDA(At, 1, 0); PG8_STAGE_A2(PG8_SA(0, 1), a2, 1);
            PG8_WAIT_V(8); PG8_WAIT_L(0); PG8_BAR; PG8_MMA(0, 0, At, B0); PG8_MMA(0, 1, At, B1); PG8_BAR; PG8_SCHED;
            PG8_LDA(At, 1, 1); PG8_STAGE(PG8_SB(1, 0), b3, voffB); PG8_STAGE(PG8_SB(1, 1), b3 + hstep, voffB); PG8_STAGE_A2(PG8_SA(1, 0), a3, 0);
            PG8_WAIT_V(8); PG8_WAIT_L(0); PG8_BAR; PG8_MMA(1, 0, At, B0); PG8_MMA(1, 1, At, B1); PG8_BAR; PG8_SCHED;
#undef PG8_STAGE_A2
        }
        if constexpr (Sched::GATHER) { Unit u2; if (S.next(ui + 2, u2)) PG8_TOKDMA(u2); }
        if constexpr (ALIGN_EPI) { if (wr == 0) PG8_BAR; }
        asm volatile("s_nop 15\n\ts_nop 15" ::: "memory");
        E(acc, cur, wr, wc, fr, fq);
        if (!has_next) break;
#pragma unroll
        for (int a = 0; a < 2; ++a)
#pragma unroll
            for (int b = 0; b < 2; ++b)
#pragma unroll
                for (int m = 0; m < 4; ++m)
#pragma unroll
                    for (int n = 0; n < 2; ++n) acc[a][b][m][n] = (f32x4){0.f, 0.f, 0.f, 0.f};
        cur = nxt; cB = nB; cA = nA; if constexpr (KS) ntc = nxt.nkt; ++ui;
#pragma unroll
        for (int h = 0; h < 2; ++h)
#pragma unroll
            for (int i = 0; i < 2; ++i) oA[h][i] = nO[h][i];
        if constexpr (ALIGN_EPI) { if (wr == 1) PG8_BAR; }
    }
    PG8_WAIT_V(0);
    if constexpr (!ALIGN_EPI) { if (wr == 0) PG8_BAR; }
    PG8_BAR;
#undef PG8_SA
#undef PG8_SB
#undef PG8_STAGE
#undef PG8_LDA
#undef PG8_LDB
#undef PG8_MMA
#undef PG8_H
#undef PG8_WAIT_V
#undef PG8_WAIT_L
#undef PG8_BAR
#undef PG8_SCHED
#undef PG8_AOFFS
#undef PG8_TOKDMA
}

struct EpiStore {
    bf16* O; int ldc; float qscale; int qtiles;
    __device__ __forceinline__ void operator()(f32x4 (&acc)[2][2][4][2], const Unit& u, int wr, int wc, int fr, int fq) const {
        const int row0 = u.xa * BM + wr * 64 + fr, col0 = u.xb * BM + wc * 32 + 8 * fq;
        const float sc = (u.xb < qtiles) ? qscale : 1.f;
#pragma unroll
        for (int ai = 0; ai < 2; ++ai)
#pragma unroll
            for (int m = 0; m < 4; ++m) { bf16* rowp = O + (long long)(row0 + ai * HALF + m * 16) * ldc + col0;
#pragma unroll
                for (int bj = 0; bj < 2; ++bj) { const f32x4 v0 = acc[ai][bj][m][0] * sc, v1 = acc[ai][bj][m][1] * sc;
                    u32x4 w; w.x = cvt_pk_bf16(v0[0], v0[1]); w.y = cvt_pk_bf16(v0[2], v0[3]); w.z = cvt_pk_bf16(v1[0], v1[1]); w.w = cvt_pk_bf16(v1[2], v1[3]);
                    *(u32x4*)(rowp + bj * HALF) = w; } }
    }
};
__device__ __forceinline__ float silu_fast(float g) { return g * __builtin_amdgcn_rcpf(1.f + __builtin_amdgcn_exp2f(-g * LOG2E)); }
struct EpiSwigluF {
    bf16* O; int ldc;
    __device__ __forceinline__ void operator()(f32x4 (&acc)[2][2][4][2], const Unit& u, int wr, int wc, int fr, int fq) const {
        const int row0 = u.xa * BM + wr * 64 + fr, col0 = u.xb * HALF + wc * 32 + 8 * fq;
#pragma unroll
        for (int ai = 0; ai < 2; ++ai)
#pragma unroll
            for (int m = 0; m < 4; ++m) { bf16* rowp = O + (size_t)(row0 + ai * HALF + m * 16) * ldc + col0;
                const f32x4 g0 = acc[ai][0][m][0], g1 = acc[ai][0][m][1], u0 = acc[ai][1][m][0], u1 = acc[ai][1][m][1];
                u32x4 w; w.x = cvt_pk_bf16(silu_fast(g0[0]) * u0[0], silu_fast(g0[1]) * u0[1]); w.y = cvt_pk_bf16(silu_fast(g0[2]) * u0[2], silu_fast(g0[3]) * u0[3]);
                w.z = cvt_pk_bf16(silu_fast(g1[0]) * u1[0], silu_fast(g1[1]) * u1[1]); w.w = cvt_pk_bf16(silu_fast(g1[2]) * u1[2], silu_fast(g1[3]) * u1[3]);
                *(u32x4*)rowp = w; }
    }
};
#ifndef EPI_PK
#define EPI_PK 1
#endif
#if EPI_PK
__device__ __forceinline__ float mul1(float a, float b) { return a * b; }
#else
__device__ __forceinline__ float mul1(float a, float b) { float r; asm("v_mul_f32_e32 %0, %1, %2" : "=v"(r) : "v"(a), "v"(b)); return r; }
#endif
__device__ __forceinline__ f32x4 mul4(const f32x4 a, float b) { return (f32x4){mul1(a[0], b), mul1(a[1], b), mul1(a[2], b), mul1(a[3], b)}; }
#if EPI_PK
__device__ __forceinline__ float mul1s(float a, float b) { return a * b; }
#else
__device__ __forceinline__ float mul1s(float a, float b) { float r; asm("v_mul_f32_e32 %0, %2, %1" : "=v"(r) : "v"(a), "s"(b)); return r; }
#endif
__device__ __forceinline__ f32x4 mul4s(const f32x4 a, float b) { return (f32x4){mul1s(a[0], b), mul1s(a[1], b), mul1s(a[2], b), mul1s(a[3], b)}; }
__device__ __forceinline__ f32x4 mul4(const f32x4 a, const f32x4 b) { return (f32x4){mul1(a[0], b[0]), mul1(a[1], b[1]), mul1(a[2], b[2]), mul1(a[3], b[3])}; }
#if EPI_PK
__device__ __forceinline__ f32x4 swiglu4(const f32x4 g, const f32x4 a, const f32x4 uk) {
    f32x4 e; e[0] = __builtin_amdgcn_exp2f(a[0]); e[1] = __builtin_amdgcn_exp2f(a[1]); e[2] = __builtin_amdgcn_exp2f(a[2]); e[3] = __builtin_amdgcn_exp2f(a[3]);
    const f32x4 d = e + 1.f;
    f32x4 sg; sg[0] = __builtin_amdgcn_rcpf(d[0]); sg[1] = __builtin_amdgcn_rcpf(d[1]); sg[2] = __builtin_amdgcn_rcpf(d[2]); sg[3] = __builtin_amdgcn_rcpf(d[3]);
    return (g * sg) * uk;
}
#else
__device__ __forceinline__ f32x4 swiglu4(const f32x4 g, const f32x4 a, const f32x4 uk) {
    float o0 = a[0], o1 = a[1], o2 = a[2], o3 = a[3];
    asm("v_exp_f32_e32 %0, %0\n\tv_exp_f32_e32 %1, %1\n\tv_exp_f32_e32 %2, %2\n\tv_exp_f32_e32 %3, %3\n\t"
        "v_add_f32_e32 %0, 1.0, %0\n\tv_add_f32_e32 %1, 1.0, %1\n\tv_add_f32_e32 %2, 1.0, %2\n\tv_add_f32_e32 %3, 1.0, %3\n\t"
        "v_rcp_f32_e32 %0, %0\n\tv_rcp_f32_e32 %1, %1\n\tv_rcp_f32_e32 %2, %2\n\tv_rcp_f32_e32 %3, %3\n\t"
        "v_mul_f32_e32 %0, %0, %4\n\tv_mul_f32_e32 %1, %1, %5\n\tv_mul_f32_e32 %2, %2, %6\n\tv_mul_f32_e32 %3, %3, %7\n\t"
        "v_mul_f32_e32 %0, %0, %8\n\tv_mul_f32_e32 %1, %1, %9\n\tv_mul_f32_e32 %2, %2, %10\n\tv_mul_f32_e32 %3, %3, %11"
        : "+v"(o0), "+v"(o1), "+v"(o2), "+v"(o3)
        : "v"(g[0]), "v"(g[1]), "v"(g[2]), "v"(g[3]), "v"(uk[0]), "v"(uk[1]), "v"(uk[2]), "v"(uk[3]));
    return (f32x4){o0, o1, o2, o3};
}
#endif
__device__ __forceinline__ unsigned pk4_fp8c(const f32x4 v) { return pk4_fp8(__builtin_amdgcn_fmed3f(v[0], -448.f, 448.f), __builtin_amdgcn_fmed3f(v[1], -448.f, 448.f), __builtin_amdgcn_fmed3f(v[2], -448.f, 448.f), __builtin_amdgcn_fmed3f(v[3], -448.f, 448.f)); }
struct EpiSwiglu8 {
    unsigned char* O; int ldc; float insc, outsc;
    __device__ __forceinline__ void operator()(f32x4 (&acc)[2][2][4][2], const Unit& u, int wr, int wc, int fr, int fq) const {
        const int row0 = u.xa * BM + wr * 64 + fr, col0 = u.xb * HALF + wc * 32 + 8 * fq;
        const float k1 = -insc * LOG2E, k2 = insc * insc * outsc;
#pragma unroll
        for (int ai = 0; ai < 2; ++ai)
#pragma unroll
            for (int m = 0; m < 4; ++m) { unsigned char* rowp = O + (size_t)(row0 + ai * HALF + m * 16) * ldc + col0;
                const f32x4 g0 = acc[ai][0][m][0], g1 = acc[ai][0][m][1], u0 = acc[ai][1][m][0], u1 = acc[ai][1][m][1];
                u32x2 w; w.x = pk4_fp8c(swiglu4(g0, mul4s(g0, k1), mul4s(u0, k2))); w.y = pk4_fp8c(swiglu4(g1, mul4s(g1, k1), mul4s(u1, k2)));
                *(u32x2*)rowp = w; }
    }
};
struct EpiDeqSwiglu8 {
    unsigned char* O; int ldc; float outsc; const float* rs; const unsigned* cm;
    __device__ __forceinline__ void operator()(f32x4 (&acc)[2][2][4][2], const Unit& u, int wr, int wc, int fr, int fq) const {
        const int row0 = u.pm * BM + wr * 64 + fr, colb = u.pn * BM + wc * 32 + 8 * fq;
        f32x4 cg[2], cu[2];
#pragma unroll
        for (int n = 0; n < 2; ++n) { const u32x4 a = *(const u32x4*)(cm + colb + 4 * n), b = *(const u32x4*)(cm + colb + HALF + 4 * n);
            cg[n] = mul4s((f32x4){__uint_as_float(a.x), __uint_as_float(a.y), __uint_as_float(a.z), __uint_as_float(a.w)}, 1.f / 127.f);
            cu[n] = mul4s((f32x4){__uint_as_float(b.x), __uint_as_float(b.y), __uint_as_float(b.z), __uint_as_float(b.w)}, outsc / 127.f); }
        float r[2][4];
#pragma unroll
        for (int ai = 0; ai < 2; ++ai)
#pragma unroll
            for (int m = 0; m < 4; ++m) r[ai][m] = rs[row0 + ai * HALF + m * 16];
#pragma unroll
        for (int ai = 0; ai < 2; ++ai)
#pragma unroll
            for (int m = 0; m < 4; ++m) { unsigned char* rowp = O + (size_t)(u.xa * BM + wr * 64 + fr + ai * HALF + m * 16) * ldc + u.xb * HALF + wc * 32 + 8 * fq;
                const float rl = mul1(r[ai][m], -LOG2E), r2 = mul1(r[ai][m], r[ai][m]);
                u32x2 w;
#pragma unroll
                for (int n = 0; n < 2; ++n) { const i32x4 ga = __builtin_bit_cast(i32x4, acc[ai][0][m][n]), ua = __builtin_bit_cast(i32x4, acc[ai][1][m][n]);
                    const f32x4 t0 = mul4((f32x4){(float)ga[0], (float)ga[1], (float)ga[2], (float)ga[3]}, cg[n]);
                    const f32x4 uk = mul4(mul4((f32x4){(float)ua[0], (float)ua[1], (float)ua[2], (float)ua[3]}, cu[n]), r2);
                    const unsigned p = pk4_fp8c(swiglu4(t0, mul4(t0, rl), uk));
                    if (n == 0) w.x = p; else w.y = p; }
                *(u32x2*)rowp = w; }
    }
};
struct EpiQkv0 {
    bf16* O; const float* gq; const float* gk; const LAS f32x2* rope;
    __device__ __forceinline__ void operator()(f32x4 (&acc)[2][2][4][2], const Unit& u, int wr, int wc, int fr, int fq) const {
        const int s = 4 * u.xb + wc;
        const bool isv = (s == 10 || s == 11 || s == 22 || s == 23), isq = (s < 8) || (s >= 12 && s < 20), norm = s < 10, lat = u.xa < NLAT / 256;
        const float* g = (s < 8) ? gq : gk;
        f32x4 gv[2][2];
#pragma unroll
        for (int bj = 0; bj < 2; ++bj)
#pragma unroll
            for (int n = 0; n < 2; ++n) gv[bj][n] = norm ? *(const f32x4*)(g + 32 * bj + 8 * fq + 4 * n) : (f32x4){1.f, 1.f, 1.f, 1.f};
        const int row0 = u.xa * BM + wr * 64 + fr;
#pragma unroll
        for (int ai = 0; ai < 2; ++ai)
#pragma unroll
            for (int m = 0; m < 4; ++m) {
                const int row = row0 + ai * HALF + m * 16;
                f32x4 v[2][2];
#pragma unroll
                for (int bj = 0; bj < 2; ++bj)
#pragma unroll
                    for (int n = 0; n < 2; ++n) v[bj][n] = acc[ai][bj][m][n];
                if (norm) {
                    float ss = 0.f;
#pragma unroll
                    for (int bj = 0; bj < 2; ++bj)
#pragma unroll
                        for (int n = 0; n < 2; ++n) ss += (v[bj][n][0] * v[bj][n][0] + v[bj][n][1] * v[bj][n][1]) + (v[bj][n][2] * v[bj][n][2] + v[bj][n][3] * v[bj][n][3]);
                    ss += __shfl_xor(ss, 16); ss += __shfl_xor(ss, 32);
                    const float rs = rsqrtf(ss * (1.f / 64.f) + EPS);
#pragma unroll
                    for (int bj = 0; bj < 2; ++bj)
#pragma unroll
                        for (int n = 0; n < 2; ++n) v[bj][n] = v[bj][n] * rs * gv[bj][n];
                }
                if (lat && !isv) {
                    const int t = row & (SEQ - 1);
#pragma unroll
                    for (int bj = 0; bj < 2; ++bj) { const int pos = (bj == 0) ? (t >> 6) : (t & 63);
#pragma unroll
                        for (int n = 0; n < 2; ++n) { const f32x2 c0 = rope[pos * 17 + 4 * fq + 2 * n], c1 = rope[pos * 17 + 4 * fq + 2 * n + 1];
                            const float a0 = v[bj][n][0], a1 = v[bj][n][1], a2 = v[bj][n][2], a3 = v[bj][n][3];
                            v[bj][n][0] = a0 * c0.x - a1 * c0.y; v[bj][n][1] = a0 * c0.y + a1 * c0.x; v[bj][n][2] = a2 * c1.x - a3 * c1.y; v[bj][n][3] = a2 * c1.y + a3 * c1.x; } }
                }
                const float sc = isq ? QSCALE : 1.f;
                bf16* rowp = O + (size_t)row * NQKV0 + s * 64 + 8 * fq;
#pragma unroll
                for (int bj = 0; bj < 2; ++bj) { const f32x4 v0 = v[bj][0] * sc, v1 = v[bj][1] * sc;
                    u32x4 w; w.x = cvt_pk_bf16(v0[0], v0[1]); w.y = cvt_pk_bf16(v0[2], v0[3]); w.z = cvt_pk_bf16(v1[0], v1[1]); w.w = cvt_pk_bf16(v1[2], v1[3]);
                    *(u32x4*)(rowp + 32 * bj) = w; }
            }
    }
};
template <class Inner> struct EpiDeq {
    Inner in; const float* rs; const unsigned* cm;
    __device__ __forceinline__ void operator()(f32x4 (&acc)[2][2][4][2], const Unit& u, int wr, int wc, int fr, int fq) const {
        const int row0 = u.pm * BM + wr * 64 + fr, col0 = u.pn * BM + wc * 32 + 8 * fq;
        f32x4 cv[2][2];
#pragma unroll
        for (int bj = 0; bj < 2; ++bj)
#pragma unroll
            for (int n = 0; n < 2; ++n) { const u32x4 w = *(const u32x4*)(cm + col0 + bj * HALF + 4 * n);
                cv[bj][n] = (f32x4){__uint_as_float(w.x), __uint_as_float(w.y), __uint_as_float(w.z), __uint_as_float(w.w)} * (1.f / 127.f); }
#pragma unroll
        for (int ai = 0; ai < 2; ++ai)
#pragma unroll
            for (int m = 0; m < 4; ++m) { const float r = rs[row0 + ai * HALF + m * 16];
#pragma unroll
                for (int bj = 0; bj < 2; ++bj)
#pragma unroll
                    for (int n = 0; n < 2; ++n) { const i32x4 a = __builtin_bit_cast(i32x4, acc[ai][bj][m][n]);
                        acc[ai][bj][m][n] = (f32x4){(float)a[0], (float)a[1], (float)a[2], (float)a[3]} * r * cv[bj][n]; } }
        in(acc, u, wr, wc, fr, fq);
    }
};
struct SchedStatic {
    static constexpr bool GATHER = false, KSPLIT = false;
    int nM, nN, G, c; unsigned rowbytes;
    __device__ __forceinline__ bool next(int i, Unit& u) const { const long L = (long)i * G + c; if (L >= (long)nM * nN) return false; static_map((int)L, nM, nN, u.pm, u.pn); u.xa = u.pm; u.xb = u.pn; u.koff = 0; u.nkt = 0; return true; }
    __device__ __forceinline__ unsigned a_off(const Unit& u, int r) const { return (unsigned)(u.pm * BM + r) * rowbytes; }
};
struct SchedIn1 {
    static constexpr bool GATHER = false, KSPLIT = false;
    int G, c;
    __device__ __forceinline__ bool next(int i, Unit& u) const { const long L = (long)i * G + c; if (L >= 1536 + 128) return false;
        if (L < 1536) static_map((int)L, 128, 12, u.pm, u.pn); else { const int l2 = (int)L - 1536; u.pm = 128 + (l2 & 15); u.pn = 4 + (l2 >> 4); }
        u.xa = u.pm; u.xb = u.pn; u.koff = 0; u.nkt = 0; return true; }
    __device__ __forceinline__ unsigned a_off(const Unit& u, int r) const { return (unsigned)(u.pm * BM + r) * (unsigned)D; }
};
}
template <bool GATHER_> struct SchedMoeT {
    static constexpr bool GATHER = GATHER_, gather = GATHER_, KSPLIT = !GATHER_;
    TileTab T; int t0, nT, nN, G, c; const int* tokof; unsigned rowbytes;
    int um, tmt, nl, ptile0;
    __device__ __forceinline__ bool next(int i, pg8::Unit& u) const { const long L = (long)i * G + c;
        int lt, pn, kp = 0; u.koff = 0; u.nkt = 28;
        if (!KSPLIT || L < um) { if (L >= (KSPLIT ? (long)um : (long)nT * nN)) return false; pg8::static_map((int)L, KSPLIT ? tmt : nT, nN, lt, pn); }
        else { const int sx = (int)(L - um); if (sx >= nl * 16) return false; lt = tmt + (sx >> 4); pn = (sx >> 2) & 3; kp = sx & 3; u.koff = (kp < 2) ? 8 * kp : 16 + 6 * (kp - 2); u.nkt = (kp < 2) ? 8 : 6; }
        const int e = tile_expert(T, t0 + lt);
        int tbe = 0;
#pragma unroll
        for (int k = 0; k < NE; ++k) tbe = (k == e) ? T.tb[k] : tbe;
        u.pm = gather ? (t0 + lt - tbe) * 256 : lt; u.pn = e * nN + pn; u.xa = gather ? lt : (kp == 0 ? t0 + lt : ptile0 + 8 * (kp - 1) + (lt - tmt)); u.xb = pn; return true; }
    __device__ __forceinline__ unsigned a_off(const pg8::Unit& u, int r) const {
        if (gather) { const int e = u.pn / nN, j = u.pm + r; int ce = 0;
#pragma unroll
            for (int k = 0; k < NE; ++k) ce = (k == e) ? T.cnt[k] : ce;
            const int tok = tokof[e * NLAT + min(j, ce - 1)]; return (unsigned)tok * rowbytes; }
        return (unsigned)(u.pm * 256 + r) * rowbytes; }
    __device__ __forceinline__ const int* a_tokp(const pg8::Unit& u, int r) const {
        const int e = u.pn / nN, j = u.pm + r; int ce = 0;
#pragma unroll
        for (int k = 0; k < NE; ++k) ce = (k == e) ? T.cnt[k] : ce;
        return tokof + (e * NLAT + min(j, ce - 1)); }
};

struct ConvJob { const float* W; unsigned char* WT; const unsigned* cm; int K, N, gu, up, head, f8; float sc; };
__device__ __forceinline__ void conv_load(const ConvJob& J, float (&rg)[32], int item, int lane) {
    const int nblk = J.N / 32, kb = item / nblk, nb = item % nblk, k0 = 64 * kb, n0 = 32 * nb;
    const float* p = J.W + (size_t)(k0 + (lane >> 5)) * J.N + n0 + (lane & 31);
#pragma unroll
    for (int i = 0; i < 32; ++i) rg[i] = p[(size_t)(2 * i) * J.N];
}
__device__ __forceinline__ void conv_finish(const ConvJob& J, LAS float* scr, const float (&rg)[32], int item, int lane) {
    const int nblk = J.N / 32, kb = item / nblk, nb = item % nblk, k0 = 64 * kb, n0 = 32 * nb;
#pragma unroll
    for (int i = 0; i < 32; ++i) { const int kk = 2 * i + (lane >> 5); scr[kk * 33 + (lane & 31)] = rg[i]; }
    asm volatile("s_waitcnt lgkmcnt(0)" ::: "memory");
    const int c = lane & 7;
#pragma unroll
    for (int j = 0; j < 4; ++j) { const int n = n0 + (lane >> 3) + 8 * j; const LAS float* sp = scr + (8 * c) * 33 + (lane >> 3) + 8 * j;
        int row = n;
        if (J.gu) row = 256 * (n >> 7) + 128 * J.up + (n & 127);
        else if (J.head) { const int o = n & 255; row = (n & ~255) + 128 * ((o >> 5) & 1) + 32 * (o >> 6) + (o & 31); }
        const float v0 = sp[0 * 33] * J.sc, v1 = sp[1 * 33] * J.sc, v2 = sp[2 * 33] * J.sc, v3 = sp[3 * 33] * J.sc, v4 = sp[4 * 33] * J.sc, v5 = sp[5 * 33] * J.sc, v6 = sp[6 * 33] * J.sc, v7 = sp[7 * 33] * J.sc;
        if (J.f8 == 2) { const float qs = 127.f / fmaxf(__uint_as_float(J.cm[row]), 1e-30f) / J.sc;
            const int a0 = (int)__builtin_rintf(v0 * qs), a1 = (int)__builtin_rintf(v1 * qs), a2 = (int)__builtin_rintf(v2 * qs), a3 = (int)__builtin_rintf(v3 * qs), a4 = (int)__builtin_rintf(v4 * qs), a5 = (int)__builtin_rintf(v5 * qs), a6 = (int)__builtin_rintf(v6 * qs), a7 = (int)__builtin_rintf(v7 * qs);
            u32x2 o; o.x = (unsigned)(a0 & 255) | ((unsigned)(a1 & 255) << 8) | ((unsigned)(a2 & 255) << 16) | ((unsigned)a3 << 24);
            o.y = (unsigned)(a4 & 255) | ((unsigned)(a5 & 255) << 8) | ((unsigned)(a6 & 255) << 16) | ((unsigned)a7 << 24); *(u32x2*)(J.WT + (size_t)row * J.K + k0 + 8 * c) = o; }
        else if (J.f8) { u32x2 o; o.x = pk4_fp8(v0, v1, v2, v3); o.y = pk4_fp8(v4, v5, v6, v7); *(u32x2*)(J.WT + (size_t)row * J.K + k0 + 8 * c) = o; }
        else { u32x4 o; o.x = pk2(v0, v1); o.y = pk2(v2, v3); o.z = pk2(v4, v5); o.w = pk2(v6, v7); *(u32x4*)(J.WT + ((size_t)row * J.K + k0 + 8 * c) * 2) = o; } }
    asm volatile("s_waitcnt lgkmcnt(0)" ::: "memory");
}
__device__ __forceinline__ void conv_item(const ConvJob& J, LAS float* scr, int item, int lane) { float rg[32]; conv_load(J, rg, item, lane); conv_finish(J, scr, rg, item, lane); }
constexpr int I_IN0 = 16 * 48, I_OUT = 16 * 32, I_G0 = 16 * 88, I_D0 = 44 * 32, I_IN1 = 16 * 96, I_GE = 16 * 112, I_DE = 56 * 32;
constexpr int NCONV0 = I_OUT + I_D0;
constexpr int NCONVQ = I_IN0 + 2 * I_G0;
constexpr int NFILL_L1 = I_IN1 + I_OUT, NFILL = NFILL_L1 + 8 * (2 * I_GE + I_DE);
__device__ __forceinline__ void conv0_job(const Ctx& C, int& r, ConvJob& J) {
    unsigned char* ws = C.p.ws; J.gu = 0; J.up = 0; J.head = 0; J.f8 = 0; J.sc = 1.f; J.K = D; J.cm = nullptr;
    if (r < I_OUT) { J.W = C.p.in[11]; J.WT = ws + WS_WOUT0; J.N = D; return; } r -= I_OUT;
    J.W = C.p.in[17]; J.WT = ws + WS_WDN0; J.K = FF0; J.N = D; J.f8 = 1; J.sc = W8DN0_SCALE;
}
__device__ __forceinline__ void convq_job(const Ctx& C, int& r, ConvJob& J) {
    unsigned char* ws = C.p.ws; J.gu = 0; J.up = 0; J.head = 0; J.f8 = 2; J.sc = 1.f; J.K = D;
    if (r < I_IN0) { J.W = C.p.in[10]; J.WT = ws + WS_WIN0; J.N = NQKV0; J.head = 1; J.cm = C.ctl() + CM_IN0; return; } r -= I_IN0;
    J.WT = ws + WS_WGU0; J.N = FF0; J.gu = 1; J.cm = C.ctl() + CM_GU0;
    if (r < I_G0) { J.W = C.p.in[15]; return; } r -= I_G0;
    J.W = C.p.in[16]; J.up = 1;
}
__device__ __forceinline__ void fill_job(const Ctx& C, int& r, ConvJob& J) {
    unsigned char* ws = C.p.ws; J.gu = 0; J.up = 0; J.head = 0; J.f8 = 0; J.sc = 1.f; J.K = D; J.cm = nullptr;
    if (r < I_IN1) { J.W = C.p.in[24]; J.WT = ws + WS_WIN1; J.N = NQKV1; J.f8 = 2; J.cm = C.ctl() + CM_IN1; return; } r -= I_IN1;
    if (r < I_OUT) { J.W = C.p.in[25]; J.WT = ws + WS_WOUT1; J.N = D; return; } r -= I_OUT;
    const int e = r / (2 * I_GE + I_DE); r -= e * (2 * I_GE + I_DE); J.f8 = 1;
    if (r < I_GE) { J.W = C.p.in[28] + (size_t)e * D * FFE; J.WT = ws + WS_W8GU + (size_t)e * 2 * FFE * D; J.N = FFE; J.gu = 1; J.sc = W8GU_SCALE; return; } r -= I_GE;
    if (r < I_GE) { J.W = C.p.in[29] + (size_t)e * D * FFE; J.WT = ws + WS_W8GU + (size_t)e * 2 * FFE * D; J.N = FFE; J.gu = 1; J.up = 1; J.sc = W8GU_SCALE; return; } r -= I_GE;
    J.W = C.p.in[30] + (size_t)e * FFE * D; J.WT = ws + WS_W8DN + (size_t)e * D * FFE; J.K = FFE; J.N = D; J.sc = W8DN_SCALE;
}
__device__ __forceinline__ void phase_convert(const Ctx& C) {
    LAS float* scr = (LAS float*)(C.lds + C.wave * 16384);
    const int gw = C.vcu * NWAVES + C.wave, NGW = C.G * NWAVES;
    for (int it = gw; it < NCONV0; it += NGW) { int r = it; ConvJob J; conv0_job(C, r, J); conv_item(J, scr, r, C.lane); }
}
__device__ __forceinline__ void phase_convert_q(const Ctx& C) {
    LAS float* scr = (LAS float*)(C.lds + C.wave * 16384);
    const int gw = C.vcu * NWAVES + C.wave, NGW = C.G * NWAVES;
    for (int it = gw; it < NCONVQ; it += NGW) { int r = it; ConvJob J; convq_job(C, r, J); conv_item(J, scr, r, C.lane); }
}
__device__ __forceinline__ void phase_colmax(const Ctx& C) {
    const int gw = C.vcu * NWAVES + C.wave, NGW = C.G * NWAVES;
    constexpr int B0 = (NQKV0 / 64) * 32, B1 = (FF0 / 64) * 32, B3 = (NQKV1 / 64) * 32;
    for (int it = gw; it < B0 + 2 * B1 + B3; it += NGW) {
        int r = it; const float* W; int N, kind, up = 0; unsigned* cm;
        if (r < B0) { W = C.p.in[10]; N = NQKV0; kind = 1; cm = C.ctl() + CM_IN0; }
        else if ((r -= B0) < B1) { W = C.p.in[15]; N = FF0; kind = 2; cm = C.ctl() + CM_GU0; }
        else if ((r -= B1) < B1) { W = C.p.in[16]; N = FF0; kind = 2; up = 1; cm = C.ctl() + CM_GU0; }
        else { r -= B1; W = C.p.in[24]; N = NQKV1; kind = 0; cm = C.ctl() + CM_IN1; }
        const int cb = r >> 5, kc = r & 31, n = cb * 64 + C.lane;
        const float* p = W + (size_t)(kc * 32) * N + n;
        float m = 0.f;
#pragma unroll
        for (int k = 0; k < 32; ++k) m = fmaxf(m, fabsf(p[(size_t)k * N]));
        int row = n;
        if (kind == 2) row = 256 * (n >> 7) + 128 * up + (n & 127);
        else if (kind == 1) { const int o = n & 255; row = (n & ~255) + 128 * ((o >> 5) & 1) + 32 * (o >> 6) + (o & 31); }
        __hip_atomic_fetch_max(cm + row, __float_as_uint(m), __ATOMIC_RELAXED, __HIP_MEMORY_SCOPE_AGENT);
    }
}
__device__ __forceinline__ void filler(const Ctx& C, int seam, int need, volatile LAS unsigned* misc) {
    __syncthreads();
    if (misc[0] != 0u) return;
    unsigned* done = C.ctl() + CW_DONE + 64 * seam; unsigned* head = C.ctl() + CW_FILL;
    if (C.tid == 0) __hip_atomic_fetch_add(done, 1u, __ATOMIC_RELAXED, __HIP_MEMORY_SCOPE_AGENT);
    LAS float* scr = (LAS float*)(C.lds + C.wave * 16384);
    bool force = need > 0;
    for (;;) {
        if (C.tid == 0) {
            unsigned first = ~0u;
            bool go = force;
            if (!go) go = __hip_atomic_load(done, __ATOMIC_RELAXED, __HIP_MEMORY_SCOPE_AGENT) < (unsigned)C.G;
            if (go) { first = __hip_atomic_fetch_add(head, (unsigned)(2 * NWAVES), __ATOMIC_RELAXED, __HIP_MEMORY_SCOPE_AGENT); if (first >= (unsigned)NFILL) { first = ~0u; misc[0] = 1u; } }
            misc[1] = first;
        }
        __syncthreads();
        const unsigned first = misc[1];
        __syncthreads();
        if (first == ~0u) break;
        const unsigned ia = first + (unsigned)C.wave, ib = ia + (unsigned)NWAVES;
        if (ib < (unsigned)NFILL) { int ra = (int)ia, rb = (int)ib; ConvJob JA, JB; fill_job(C, ra, JA); fill_job(C, rb, JB);
            float ga[32], gb[32]; conv_load(JA, ga, ra, C.lane); conv_load(JB, gb, rb, C.lane); conv_finish(JA, scr, ga, ra, C.lane); conv_finish(JB, scr, gb, rb, C.lane); }
        else if (ia < (unsigned)NFILL) { int r = (int)ia; ConvJob J; fill_job(C, r, J); conv_item(J, scr, r, C.lane); }
        force = (int)first + 2 * NWAVES < need;
    }
}
__device__ __forceinline__ void phase_fgemm(const Ctx& C, const bf16* A, const bf16* Bt, int nM, int nN, int K, bf16* O, int ldo) {
    pg8::Gemm g{A, Bt, K}; pg8::SchedStatic S{nM, nN, C.G, (int)blockIdx.x, (unsigned)K * 2u}; pg8::EpiStore E{O, ldo, 1.f, 0};
    pg8::gemm_phase<pg8::EpiStore, pg8::SchedStatic, true>(C.lds, g, S, E);
}
__device__ __forceinline__ void phase_fgemm_in0(const Ctx& C) {
    pg8::Gemm g{(const bf16*)(C.p.ws + WS_HB), (const bf16*)(C.p.ws + WS_WIN0), D}; pg8::SchedStatic S{MTOT / 256, NQKV0 / 256, C.G, (int)blockIdx.x, (unsigned)D};
    typedef pg8::EpiDeq<pg8::EpiQkv0> Epi;
    Epi E{pg8::EpiQkv0{(bf16*)(C.p.ws + WS_QKV), C.p.in[12], C.p.in[13], (const LAS f32x2*)(C.lds + ROPE_OFF)}, (const float*)(C.p.ws + WS_HS), C.ctl() + CM_IN0};
    pg8::gemm_phase<Epi, pg8::SchedStatic, true, 2>(C.lds, g, S, E);
}
__device__ __forceinline__ void phase_fgemm_gu0(const Ctx& C) {
    pg8::Gemm g{(const bf16*)(C.p.ws + WS_HB), (const bf16*)(C.p.ws + WS_WGU0), D}; pg8::SchedStatic S{MTOT / 256, 2 * FF0 / 256, C.G, (int)blockIdx.x, (unsigned)D};
    typedef pg8::EpiDeqSwiglu8 Epi;
    Epi E{C.p.ws + WS_ACT0, FF0, ACT0_SCALE, (const float*)(C.p.ws + WS_HS), C.ctl() + CM_GU0};
    pg8::gemm_phase<Epi, pg8::SchedStatic, true, 2>(C.lds, g, S, E);
}
#ifdef PROBE_GU0
template <class Inner> struct EpiIf { Inner in; int on;
    __device__ __forceinline__ void operator()(f32x4 (&acc)[2][2][4][2], const pg8::Unit& u, int wr, int wc, int fr, int fq) const { if (on) in(acc, u, wr, wc, fr, fq); } };
__device__ __forceinline__ void phase_fgemm_gu0_probe(const Ctx& C) {
    pg8::Gemm g{(const bf16*)(C.p.ws + WS_HB), (const bf16*)(C.p.ws + WS_WGU0), D}; pg8::SchedStatic S{MTOT / 256, 2 * FF0 / 256, C.G, (int)blockIdx.x, (unsigned)D};
    typedef EpiIf<pg8::EpiDeq<pg8::EpiSwiglu8>> Epi;
    Epi E{pg8::EpiDeq<pg8::EpiSwiglu8>{pg8::EpiSwiglu8{C.p.ws + WS_ACT0, FF0, 1.f, ACT0_SCALE}, (const float*)(C.p.ws + WS_HS), C.ctl() + CM_GU0}, (PROBE_GU0 == 1) ? 1 : (C.p.tpc == 77)};
    pg8::gemm_phase<Epi, pg8::SchedStatic, true, 2>(C.lds, g, S, E);
}
#endif
__device__ __forceinline__ void phase_fgemm_dn0(const Ctx& C) {
    pg8::Gemm g{(const bf16*)(C.p.ws + WS_ACT0), (const bf16*)(C.p.ws + WS_WDN0), FF0}; pg8::SchedStatic S{MTOT / 256, D / 256, C.G, (int)blockIdx.x, (unsigned)FF0};
    pg8::EpiStore E{(bf16*)(C.p.ws + WS_YB), D, 1.f / (W8DN0_SCALE * ACT0_SCALE), 1 << 20};
    pg8::gemm_phase<pg8::EpiStore, pg8::SchedStatic, true, 1>(C.lds, g, S, E);
}
__device__ __forceinline__ void phase_fgemm_in1(const Ctx& C) {
    pg8::Gemm g{(const bf16*)(C.p.ws + WS_HB), (const bf16*)(C.p.ws + WS_WIN1), D}; pg8::SchedIn1 S{C.G, (int)blockIdx.x};
    typedef pg8::EpiDeq<pg8::EpiStore> Epi;
    Epi E{pg8::EpiStore{(bf16*)(C.p.ws + WS_QKV), NQKV1, QSCALE, 4}, (const float*)(C.p.ws + WS_HS), C.ctl() + CM_IN1};
    pg8::gemm_phase<Epi, pg8::SchedIn1, true, 2>(C.lds, g, S, E);
}
__device__ __forceinline__ void phase_moe_gu_fast(const Ctx& C) {
    SchedMoeT<true> S; load_tiletab(C, S.T);
    S.t0 = 0; S.nT = S.T.tb[8]; S.nN = 2 * FFE / 256; S.G = C.G; S.c = (int)blockIdx.x; S.tokof = (const int*)(C.p.ws + WS_TOKOF); S.rowbytes = D; S.um = 0; S.tmt = 0; S.nl = 0; S.ptile0 = 0;
    pg8::Gemm g{(const bf16*)(C.p.ws + WS_H8), (const bf16*)(C.p.ws + WS_W8GU), D}; pg8::EpiSwiglu8 E{C.p.ws + WS_ACT8, FFE, 1.f / W8GU_SCALE, 1.f};
    pg8::gemm_phase<pg8::EpiSwiglu8, SchedMoeT<true>, true, 1>(C.lds, g, S, E);
}
__device__ __forceinline__ void phase_moe_dn_fast(const Ctx& C) {
    SchedMoeT<false> S; load_tiletab(C, S.T);
    S.t0 = 0; S.nT = S.T.tb[8]; S.nN = D / 256; S.G = C.G; S.c = (int)blockIdx.x; S.tokof = nullptr; S.rowbytes = FFE;
    moe_split(C, S.nT, S.tmt, S.nl); S.um = S.tmt * 4; S.ptile0 = MOE_PTILE0;
    pg8::Gemm g{(const bf16*)(C.p.ws + WS_ACT8), (const bf16*)(C.p.ws + WS_W8DN), FFE}; pg8::EpiStore E{(bf16*)(C.p.ws + WS_YS), D, 1.f / W8DN_SCALE, 1 << 20};
    pg8::gemm_phase<pg8::EpiStore, SchedMoeT<false>, true, 1>(C.lds, g, S, E);
}
namespace att {
typedef short bf16x8 __attribute__((ext_vector_type(8)));
typedef short s16x4 __attribute__((ext_vector_type(4)));
typedef float f32x16 __attribute__((ext_vector_type(16)));
constexpr int NSLOT = 4, SLOTB = 8192, LDS_K = 0, LDS_V = NSLOT * SLOTB, LDS_WS = 2 * NSLOT * SLOTB, LDS_OST = LDS_WS + 8 * 64 * 4, LDS_BIAS = LDS_OST + 8 * 4096, LDS_END = LDS_BIAS + 4096;
constexpr int BIAS_PAD = 64;
constexpr float THR = 8.f;
static_assert(LDS_END <= 131072, "attention LDS");
__device__ __forceinline__ int crow(int r, int hi) { return (r & 3) + 8 * (r >> 2) + 4 * hi; }
__device__ __forceinline__ void glds16(const void* gsrc, unsigned lds_dst) { unsigned keep;
    asm volatile("s_mov_b32 %0, m0\n\ts_mov_b32 m0, %2\n\ts_nop 0\n\tglobal_load_lds_dwordx4 %1, off\n\ts_mov_b32 m0, %0" : "=&s"(keep) : "v"(gsrc), "s"(lds_dst) : "memory"); }
#define ATT_WAIT_BAR(N) asm volatile("s_waitcnt vmcnt(" #N ") lgkmcnt(0)\n\ts_barrier" ::: "memory")
#define ATT_WAIT_BAR_Q(N, q) asm volatile("s_waitcnt vmcnt(" #N ") lgkmcnt(0)\n\ts_barrier" : "+v"(q[0]), "+v"(q[1]), "+v"(q[2]), "+v"(q[3]) :: "memory")
#define ATT_MX3(a, b, c) __builtin_fmaxf(__builtin_fmaxf((a), (b)), (c))
__device__ __forceinline__ unsigned cvtpk(float lo, float hi) { typedef float f2 __attribute__((ext_vector_type(2))); typedef __bf16 b2 __attribute__((ext_vector_type(2))); f2 v = {lo, hi}; b2 b = __builtin_convertvector(v, b2); return __builtin_bit_cast(unsigned, b); }
template <bool PF>
__device__ __forceinline__ void qkt(f32x16& p0, f32x16& p1, const LAS char* kslot, const bf16x8* qr, const f32x16& negm, int r32, int hi) {
    const LAS char* kb = kslot + hi * 1024 + r32 * 16;
    if constexpr (!PF) {
#pragma unroll
        for (int d0 = 0; d0 < 4; ++d0) {
            const bf16x8 b0 = *(const LAS bf16x8*)(kb + d0 * 2048);
            const bf16x8 b1 = *(const LAS bf16x8*)(kb + d0 * 2048 + 512);
            if (d0 == 0) { p0 = __builtin_amdgcn_mfma_f32_32x32x16_bf16(b0, qr[0], negm, 0, 0, 0); p1 = __builtin_amdgcn_mfma_f32_32x32x16_bf16(b1, qr[0], negm, 0, 0, 0); }
            else { p0 = __builtin_amdgcn_mfma_f32_32x32x16_bf16(b0, qr[d0], p0, 0, 0, 0); p1 = __builtin_amdgcn_mfma_f32_32x32x16_bf16(b1, qr[d0], p1, 0, 0, 0); } }
        return;
    }
    bf16x8 kf[8];
#pragma unroll
    for (int d0 = 0; d0 < 4; ++d0) { kf[2 * d0] = *(const LAS bf16x8*)(kb + d0 * 2048); kf[2 * d0 + 1] = *(const LAS bf16x8*)(kb + d0 * 2048 + 512); }
    __builtin_amdgcn_sched_barrier(0);
    p0 = __builtin_amdgcn_mfma_f32_32x32x16_bf16(kf[0], qr[0], negm, 0, 0, 0); p1 = __builtin_amdgcn_mfma_f32_32x32x16_bf16(kf[1], qr[0], negm, 0, 0, 0);
#pragma unroll
    for (int d0 = 1; d0 < 4; ++d0) { p0 = __builtin_amdgcn_mfma_f32_32x32x16_bf16(kf[2 * d0], qr[d0], p0, 0, 0, 0); p1 = __builtin_amdgcn_mfma_f32_32x32x16_bf16(kf[2 * d0 + 1], qr[d0], p1, 0, 0, 0); }
    __builtin_amdgcn_sched_barrier(0);
}
__device__ __forceinline__ void pv_load(s16x4 (&lo)[8], s16x4 (&hi)[8], int vb) {
#pragma unroll
    for (int d0 = 0; d0 < 2; ++d0)
#pragma unroll
        for (int ks = 0; ks < 4; ++ks) {
            asm volatile("ds_read_b64_tr_b16 %0,%1 offset:%c2" : "=&v"(lo[d0 * 4 + ks]) : "v"(vb), "i"(d0 * 4096 + ks * 1024) : "memory");
            asm volatile("ds_read_b64_tr_b16 %0,%1 offset:%c2" : "=&v"(hi[d0 * 4 + ks]) : "v"(vb), "i"(d0 * 4096 + ks * 1024 + 512) : "memory"); }
}
__device__ __forceinline__ void pv_mma(f32x16* o, const s16x4 (&lo)[8], const s16x4 (&hi)[8], bf16x8 pa0, bf16x8 pa1, bf16x8 pa2, bf16x8 pa3) {
    asm volatile("s_waitcnt lgkmcnt(0)" ::: "memory"); __builtin_amdgcn_sched_barrier(0);
#define ATT_PK(k) (bf16x8){lo[k][0], lo[k][1], lo[k][2], lo[k][3], hi[k][0], hi[k][1], hi[k][2], hi[k][3]}
#pragma unroll
    for (int d0 = 0; d0 < 2; ++d0) {
        o[d0] = __builtin_amdgcn_mfma_f32_32x32x16_bf16(pa0, ATT_PK(d0 * 4 + 0), o[d0], 0, 0, 0);
        o[d0] = __builtin_amdgcn_mfma_f32_32x32x16_bf16(pa1, ATT_PK(d0 * 4 + 1), o[d0], 0, 0, 0);
        o[d0] = __builtin_amdgcn_mfma_f32_32x32x16_bf16(pa2, ATT_PK(d0 * 4 + 2), o[d0], 0, 0, 0);
        o[d0] = __builtin_amdgcn_mfma_f32_32x32x16_bf16(pa3, ATT_PK(d0 * 4 + 3), o[d0], 0, 0, 0);
    }
#undef ATT_PK
}
struct UnitDesc {
    const bf16* q;
    const bf16* kv;
    bf16* o;
    const float* rpb;
    int pitch, kcol, vcol;
    int base0, n0, base1, n1;
    int kind;
    int mk0, mk1;
    int has_sink; float sink2;
};
template <bool HAS1, bool HAS2, class DescFn>
__device__ __forceinline__ void attn_run(const Ctx& C, int nunits, const DescFn& desc) {
    if (nunits <= 0) return;
    const int lane = C.lane, r32 = lane & 31, hi = lane >> 5, wid = C.wave;
    LAS char* shm = (LAS char*)C.lds;
    const unsigned lds0 = (unsigned)(size_t)shm;
    LAS float* wsf = (LAS float*)(shm + LDS_WS) + wid * 64;
    LAS float* biasl = (LAS float*)(shm + LDS_BIAS);
    const unsigned kdst = lds0 + LDS_K + wid * 1024, vdst = lds0 + LDS_V + wid * 1024;
    const int vb0 = (int)(lds0 + LDS_V) + ((lane >> 4) & 1) * 32 + (lane & 3) * 8 + (4 * hi + ((lane & 15) >> 2)) * 64;
    const float NEG = -__builtin_inff();
#define ATT_TROW(U, t) ((t) < (U).n0 ? (U).base0 + 64 * (t) : (U).base1 + 64 * ((t) - (U).n0))
#define ATT_DMA(U, t, slot) do { const size_t ro_ = (size_t)(ATT_TROW(U, t)) * (U).pitch; \
        glds16((U).kv + (U).kcol + (size_t)lane * (U).pitch + wid * 8 + ro_, (unsigned)__builtin_amdgcn_readfirstlane(kdst + (slot))); \
        glds16((U).kv + (U).vcol + (size_t)(16 * (wid & 3) + (lane >> 2)) * (U).pitch + (wid >> 2) * 32 + (lane & 3) * 8 + ro_, (unsigned)__builtin_amdgcn_readfirstlane(vdst + (slot))); } while (0)
#define ATT_LDQ(dst, U) do { _Pragma("unroll") for (int d0_ = 0; d0_ < 4; ++d0_) { const bf16* qp_ = (U).q + (size_t)(wid * 32 + r32) * (U).pitch + d0_ * 16 + hi * 8; \
        asm volatile("global_load_dwordx4 %0, %1, off" : "=v"(dst[d0_]) : "v"(qp_) : "memory"); } } while (0)
    UnitDesc U, Un; desc(0, U); Un = U;
    bf16x8 qr[4];
    ATT_LDQ(qr, U);
    ATT_DMA(U, 0, 0); ATT_DMA(U, 1, SLOTB);
    int gs = 0;
    const float* bias_have = nullptr;
    for (int ui = 0; ui < nunits; ++ui) {
        const bool has_next = ui + 1 < nunits;
        if (has_next) desc(ui + 1, Un);
        const int NTL = U.n0 + U.n1;
        unsigned mbits = 0xffffffffu;
        int c_q = 0;
        if (HAS2 && U.kind == 2) {
            if (U.rpb != bias_have) {
                asm volatile("s_waitcnt lgkmcnt(0)\n\ts_barrier" ::: "memory");
                for (int i = C.tid; i < 1024; i += NT) { const int j = i - BIAS_PAD; biasl[i] = (j >= 0 && j < 465) ? U.rpb[j] * LOG2E : 0.f; }
                asm volatile("s_waitcnt lgkmcnt(0)\n\ts_barrier" ::: "memory");
                bias_have = U.rpb;
            }
            c_q = 32 * (wid & 1) + r32; const int cs = min(max(c_q - 8, 0), 48);
            mbits = 0u;
#pragma unroll
            for (int i = 0; i < 16; ++i) { const int kc = 4 * hi + (i & 3) + 8 * (i >> 2);
                if (kc >= cs && kc <= cs + 15) mbits |= 1u << i;
                if (kc + 32 >= cs && kc + 32 <= cs + 15) mbits |= 1u << (16 + i); }
        }
        float mhat = 0.f, lsum = 0.f; f32x16 o[2]; o[0] = f32x16{}; o[1] = f32x16{};
        f32x16 negm = f32x16{};
        for (int t = 0; t < NTL; ++t, ++gs) {
            const int slot = (gs & 3) * SLOTB, pslot = ((gs + 2) & 3) * SLOTB;
            if (t == 0) { ATT_WAIT_BAR_Q(0, qr); ATT_DMA(U, 2, pslot); }
            else if (t + 2 < NTL) { ATT_DMA(U, t + 2, pslot); ATT_WAIT_BAR(4); }
            else if (has_next) { ATT_DMA(Un, t + 2 - NTL, pslot); ATT_WAIT_BAR(4); }
            else if (t + 1 < NTL) { ATT_WAIT_BAR(2); }
            else { ATT_WAIT_BAR(0); }
            const int sgi = t - U.n0;
            bool active = true, need_mask = false;
            if (sgi >= 0) {
                if (HAS1 && U.kind == 1) { const int klo = U.mk0 + 64 * sgi; active = (klo + 63 >= 32 * wid - 128) && (klo <= 32 * wid + 31 + 128);
                    need_mask = !((klo - 32 * wid - 31 >= -128) && (klo + 63 - 32 * wid <= 128)); }
                else if (HAS2 && U.kind == 2) { const int kr = U.mk0 + sgi, r = U.mk1 + (wid >> 1), rs = min(max(r - 4, 0), 24); active = (kr >= rs) && (kr <= rs + 7); }
            }
            if (active) {
                f32x16 p0, p1;
                constexpr bool PF = !HAS2;
                qkt<PF>(p0, p1, shm + LDS_K + slot, qr, negm, r32, hi);
                s16x4 vlo[8], vhi[8];
                if constexpr (PF) pv_load(vlo, vhi, vb0 + slot);
                if (HAS1 && sgi >= 0 && U.kind == 1) {
                    if (need_mask) {
                        const int kb = U.mk0 + 64 * sgi + 4 * hi - (32 * wid + r32);
#pragma unroll
                        for (int i = 0; i < 16; ++i) { const int d = kb + (i & 3) + 8 * (i >> 2);
                            if (d < -128 || d > 128) p0[i] = NEG;
                            if (d + 32 < -128 || d + 32 > 128) p1[i] = NEG; }
                    }
                } else if (HAS2 && sgi >= 0 && U.kind == 2) {
                    const int kr = U.mk0 + sgi, r = U.mk1 + (wid >> 1);
                    const LAS float* bp = biasl + (BIAS_PAD + (kr - r + 7) * 31 + 15 - c_q + 4 * hi);
#pragma unroll
                    for (int g4 = 0; g4 < 4; ++g4) {
#pragma unroll
                        for (int i = 4 * g4; i < 4 * g4 + 4; ++i) {
                            { const int m = ((int)(mbits << (31 - i))) >> 31; const unsigned x = __float_as_uint(p0[i] + bp[(i & 3) + 8 * (i >> 2)]); p0[i] = __uint_as_float((x & (unsigned)m) | (0xff800000u & ~(unsigned)m)); }
                            { const int m = ((int)(mbits << (15 - i))) >> 31; const unsigned x = __float_as_uint(p1[i] + bp[32 + (i & 3) + 8 * (i >> 2)]); p1[i] = __uint_as_float((x & (unsigned)m) | (0xff800000u & ~(unsigned)m)); } }
                    }
                }
                float ma = ATT_MX3(p0[0], p0[1], p1[0]), mb = ATT_MX3(p0[2], p0[3], p1[1]); ma = ATT_MX3(ma, p1[2], p1[3]);
#pragma unroll
                for (int i = 4; i < 16; i += 4) { ma = ATT_MX3(ma, p0[i], p0[i + 1]); mb = ATT_MX3(mb, p0[i + 2], p0[i + 3]); ma = ATT_MX3(ma, p1[i], p1[i + 1]); mb = ATT_MX3(mb, p1[i + 2], p1[i + 3]); }
                float rm = __builtin_fmaxf(ma, mb);
                { auto rr = __builtin_amdgcn_permlane32_swap(__float_as_uint(rm), __float_as_uint(rm), false, false); rm = __builtin_fmaxf(__uint_as_float(rr[0]), __uint_as_float(rr[1])); }
                if (__any((t == 0) || (rm > THR))) {
                    const float dl = (t == 0) ? rm : __builtin_fmaxf(rm, 0.f);
                    mhat += dl;
#pragma unroll
                    for (int i = 0; i < 16; ++i) { p0[i] -= dl; p1[i] -= dl; }
#pragma unroll
                    for (int i = 0; i < 16; ++i) negm[i] = -mhat;
                    if (t != 0) {
                        const float f = __builtin_amdgcn_exp2f(-dl); lsum *= f;
                        if (hi == 0) wsf[r32] = f;
                        asm volatile("s_waitcnt lgkmcnt(0)" ::: "memory");
#pragma unroll
                        for (int i = 0; i < 16; ++i) { const float g = wsf[crow(i, hi)]; o[0][i] *= g; o[1][i] *= g; }
                    }
                }
#pragma unroll
                for (int i = 0; i < 16; ++i) { p0[i] = __builtin_amdgcn_exp2f(p0[i]); p1[i] = __builtin_amdgcn_exp2f(p1[i]); }
                f32x2 s2 = (f32x2){0.f, 0.f};
#pragma unroll
                for (int i = 0; i < 16; i += 2) { s2 += (f32x2){p0[i], p0[i + 1]}; s2 += (f32x2){p1[i], p1[i + 1]}; }
                lsum += s2.x + s2.y;
                u32x4 w0, w1, w2, w3;
                w0 = (u32x4){cvtpk(p0[0], p0[1]), cvtpk(p0[2], p0[3]), cvtpk(p0[4], p0[5]), cvtpk(p0[6], p0[7])};
                w1 = (u32x4){cvtpk(p0[8], p0[9]), cvtpk(p0[10], p0[11]), cvtpk(p0[12], p0[13]), cvtpk(p0[14], p0[15])};
                w2 = (u32x4){cvtpk(p1[0], p1[1]), cvtpk(p1[2], p1[3]), cvtpk(p1[4], p1[5]), cvtpk(p1[6], p1[7])};
                w3 = (u32x4){cvtpk(p1[8], p1[9]), cvtpk(p1[10], p1[11]), cvtpk(p1[12], p1[13]), cvtpk(p1[14], p1[15])};
                if constexpr (!PF) pv_load(vlo, vhi, vb0 + slot);
                pv_mma(o, vlo, vhi, __builtin_bit_cast(bf16x8, w0), __builtin_bit_cast(bf16x8, w1), __builtin_bit_cast(bf16x8, w2), __builtin_bit_cast(bf16x8, w3));
            }
        }
        if (has_next) ATT_LDQ(qr, Un);
        { auto rr = __builtin_amdgcn_permlane32_swap(__float_as_uint(lsum), __float_as_uint(lsum), false, false); lsum = __uint_as_float(rr[0]) + __uint_as_float(rr[1]); }
        if (U.has_sink) lsum += __builtin_amdgcn_exp2f(U.sink2 - mhat);
        if (hi == 0) wsf[32 + r32] = lsum;
        asm volatile("s_waitcnt lgkmcnt(0)" ::: "memory");
        LAS bf16* stg = (LAS bf16*)(shm + LDS_OST) + wid * 2048;
#pragma unroll
        for (int i = 0; i < 16; ++i) { const int orow = crow(i, hi); const float rl = __builtin_amdgcn_rcpf(wsf[32 + orow]);
#pragma unroll
            for (int d0 = 0; d0 < 2; ++d0) stg[orow * 64 + d0 * 32 + r32] = (bf16)f2bf(o[d0][i] * rl); }
        asm volatile("s_waitcnt lgkmcnt(0)" ::: "memory");
        bf16* Ow = U.o + (size_t)(wid * 32) * D;
#pragma unroll
        for (int i = 0; i < 4; ++i) { const int row = i * 8 + (lane >> 3), ch = lane & 7; const u32x4 v = *(const LAS u32x4*)(stg + row * 64 + ch * 8); *(u32x4*)(Ow + (size_t)row * D + ch * 8) = v; }
        asm volatile("s_waitcnt lgkmcnt(0)" ::: "memory");
        if (has_next) U = Un;
    }
    asm volatile("s_waitcnt vmcnt(0) lgkmcnt(0)\n\ts_barrier" ::: "memory");
#undef ATT_TROW
#undef ATT_DMA
#undef ATT_LDQ
}

template <int MODE, class DescFn>
__device__ __forceinline__ void attn_run_na(const Ctx& C, int nunits, const DescFn& desc) {
    if (nunits <= 0) return;
    const int lane = C.lane, n = lane & 31, hi = lane >> 5, wid = C.wave;
    const int jg = wid & 3, pr = wid >> 2;
    const int kc0 = (jg == 0) ? 0 : (jg == 1) ? 8 : (jg == 2) ? 24 : 32;
    const int qrl = 2 * pr + (n >> 4), qc = 16 * jg + (n & 15);
    const int tokrel = qrl * 64 + qc;
    LAS char* shm = (LAS char*)C.lds;
    const unsigned lds0 = (unsigned)(size_t)shm;
    LAS float* wsf = (LAS float*)(shm + LDS_WS) + wid * 64;
    LAS float* biasl = (LAS float*)(shm + LDS_BIAS);
    const unsigned kdst = lds0 + LDS_K + wid * 1024, vdst = lds0 + LDS_V + wid * 1024;
    const int vbl = (int)(lds0 + LDS_V) + ((lane >> 4) & 1) * 32 + (lane & 3) * 8 + (4 * hi + ((lane & 15) >> 2)) * 64;
    const float NEG = -__builtin_inff();
    unsigned cbits = 0u;
    { const int cs = min(max(qc - 8, 0), 48);
#pragma unroll
      for (int i = 0; i < 16; ++i) { const int kc = kc0 + crow(i, hi); if (kc >= cs && kc <= cs + 15) cbits |= 1u << i; } }
#define ATT_TROW(U, t) ((t) < (U).n0 ? (U).base0 + 64 * (t) : (U).base1 + 64 * ((t) - (U).n0))
#define ATT_DMA(U, t, slot) do { const size_t ro_ = (size_t)(ATT_TROW(U, t)) * (U).pitch; \
        glds16((U).kv + (U).kcol + (size_t)lane * (U).pitch + wid * 8 + ro_, (unsigned)__builtin_amdgcn_readfirstlane(kdst + (slot))); \
        glds16((U).kv + (U).vcol + (size_t)(16 * (wid & 3) + (lane >> 2)) * (U).pitch + (wid >> 2) * 32 + (lane & 3) * 8 + ro_, (unsigned)__builtin_amdgcn_readfirstlane(vdst + (slot))); } while (0)
#define ATT_LDQ(dst, U) do { _Pragma("unroll") for (int d0_ = 0; d0_ < 4; ++d0_) { const bf16* qp_ = (U).q + (size_t)tokrel * (U).pitch + d0_ * 16 + hi * 8; \
        asm volatile("global_load_dwordx4 %0, %1, off" : "=v"(dst[d0_]) : "v"(qp_) : "memory"); } } while (0)
    UnitDesc U, Un; desc(0, U); Un = U;
    bf16x8 qr[4];
    if (MODE != 1) ATT_LDQ(qr, U); else { for (int d0_ = 0; d0_ < 4; ++d0_) qr[d0_] = bf16x8{}; }
    ATT_DMA(U, 0, 0); ATT_DMA(U, 1, SLOTB);
    int gs = 0;
    const float* bias_have = nullptr;
    for (int ui = 0; ui < nunits; ++ui) {
        const bool has_next = ui + 1 < nunits;
        if (has_next) desc(ui + 1, Un);
        const int NTL = U.n0 + U.n1;
        if (U.rpb != bias_have) {
            asm volatile("s_waitcnt lgkmcnt(0)\n\ts_barrier" ::: "memory");
            for (int i = C.tid; i < 1024; i += NT) { const int j = i - BIAS_PAD; biasl[i] = (j >= 0 && j < 465) ? U.rpb[j] * LOG2E : 0.f; }
            asm volatile("s_waitcnt lgkmcnt(0)\n\ts_barrier" ::: "memory");
            bias_have = U.rpb;
        }
        const int rA = U.mk1 + 2 * pr;
        const int rq = rA + (n >> 4);
        const int rsq = min(max(rq - 4, 0), 24);
        float mhat = 0.f, lsum = 0.f; f32x16 o[2]; o[0] = f32x16{}; o[1] = f32x16{};
        f32x16 negm = f32x16{};
        bool first = true;
        for (int t = 0; t < NTL; ++t, ++gs) {
            const int slot = (gs & 3) * SLOTB, pslot = ((gs + 2) & 3) * SLOTB;
            if (MODE == 2) { if (gs < 2) { ATT_DMA(U, t + 2, pslot); } ATT_WAIT_BAR_Q(0, qr); }
            else if (t == 0) { ATT_WAIT_BAR_Q(0, qr); ATT_DMA(U, 2, pslot); }
            else if (t + 2 < NTL) { ATT_DMA(U, t + 2, pslot); ATT_WAIT_BAR(4); }
            else if (has_next) { ATT_DMA(Un, t + 2 - NTL, pslot); ATT_WAIT_BAR(4); }
            else if (t + 1 < NTL) { ATT_WAIT_BAR(2); }
            else { ATT_WAIT_BAR(0); }
            const int sgi = t - U.n0;
            const bool band = sgi >= 0;
            const int kr = U.mk0 + sgi;
            bool active = true;
            if (band) { const int rsa = min(max(rA - 4, 0), 24), rsb = min(max(rA + 1 - 4, 0), 24); active = (kr >= rsa) && (kr <= rsb + 7); }
            if (MODE == 1) active = false;
            if (active) {
                const int nblk = band ? 1 : 2;
                for (int bi = 0; bi < nblk; ++bi) {
                    const int kcb = band ? kc0 : 32 * bi;
                    const LAS char* kb = shm + LDS_K + slot + hi * 1024 + (kcb + n) * 16;
                    bf16x8 kf[4];
#pragma unroll
                    for (int d0 = 0; d0 < 4; ++d0) kf[d0] = *(const LAS bf16x8*)(kb + d0 * 2048);
                    f32x16 p = __builtin_amdgcn_mfma_f32_32x32x16_bf16(kf[0], qr[0], negm, 0, 0, 0);
#pragma unroll
                    for (int d0 = 1; d0 < 4; ++d0) p = __builtin_amdgcn_mfma_f32_32x32x16_bf16(kf[d0], qr[d0], p, 0, 0, 0);
                    s16x4 vlo[4], vhi[4];
                    { const int t0 = kcb, t1 = kcb + 8, t2 = kcb + 16, t3 = kcb + 24;
                      const int a0 = vbl + slot + (t0 >> 4) * 1024 + ((t0 >> 3) & 1) * 512, a1 = vbl + slot + (t1 >> 4) * 1024 + ((t1 >> 3) & 1) * 512;
                      const int a2 = vbl + slot + (t2 >> 4) * 1024 + ((t2 >> 3) & 1) * 512, a3 = vbl + slot + (t3 >> 4) * 1024 + ((t3 >> 3) & 1) * 512;
                      asm volatile("ds_read_b64_tr_b16 %0,%1" : "=&v"(vlo[0]) : "v"(a0) : "memory"); asm volatile("ds_read_b64_tr_b16 %0,%1" : "=&v"(vhi[0]) : "v"(a1) : "memory");
                      asm volatile("ds_read_b64_tr_b16 %0,%1" : "=&v"(vlo[1]) : "v"(a2) : "memory"); asm volatile("ds_read_b64_tr_b16 %0,%1" : "=&v"(vhi[1]) : "v"(a3) : "memory");
                      asm volatile("ds_read_b64_tr_b16 %0,%1 offset:4096" : "=&v"(vlo[2]) : "v"(a0) : "memory"); asm volatile("ds_read_b64_tr_b16 %0,%1 offset:4096" : "=&v"(vhi[2]) : "v"(a1) : "memory");
                      asm volatile("ds_read_b64_tr_b16 %0,%1 offset:4096" : "=&v"(vlo[3]) : "v"(a2) : "memory"); asm volatile("ds_read_b64_tr_b16 %0,%1 offset:4096" : "=&v"(vhi[3]) : "v"(a3) : "memory"); }
                    if (band) {
                        const bool rowok = (kr >= rsq) && (kr <= rsq + 7);
                        const unsigned mb = rowok ? cbits : 0u;
                        const LAS float* bp = biasl + (BIAS_PAD + (kr - rq + 7) * 31 + 15 - qc + kcb + 4 * hi);
#pragma unroll
                        for (int i = 0; i < 16; ++i) { const int m = ((int)(mb << (31 - i))) >> 31; const unsigned x = __float_as_uint(p[i] + bp[(i & 3) + 8 * (i >> 2)]);
                            p[i] = __uint_as_float((x & (unsigned)m) | (0xff800000u & ~(unsigned)m)); }
                    }
                    float ma = ATT_MX3(p[0], p[1], p[2]), mb2 = ATT_MX3(p[3], p[4], p[5]);
                    ma = ATT_MX3(ma, p[6], p[7]); mb2 = ATT_MX3(mb2, p[8], p[9]); ma = ATT_MX3(ma, p[10], p[11]); mb2 = ATT_MX3(mb2, p[12], p[13]); ma = ATT_MX3(ma, p[14], p[15]);
                    float rm = __builtin_fmaxf(ma, mb2);
                    { auto rr = __builtin_amdgcn_permlane32_swap(__float_as_uint(rm), __float_as_uint(rm), false, false); rm = __builtin_fmaxf(__uint_as_float(rr[0]), __uint_as_float(rr[1])); }
                    if (__any(first || (rm > THR))) {
                        const float dl = first ? rm : __builtin_fmaxf(rm, 0.f);
                        mhat += dl;
#pragma unroll
                        for (int i = 0; i < 16; ++i) p[i] -= dl;
#pragma unroll
                        for (int i = 0; i < 16; ++i) negm[i] = -mhat;
                        if (!first) {
                            const float f = __builtin_amdgcn_exp2f(-dl); lsum *= f;
                            if (hi == 0) wsf[n] = f;
                            asm volatile("s_waitcnt lgkmcnt(0)" ::: "memory");
#pragma unroll
                            for (int i = 0; i < 16; ++i) { const float g = wsf[crow(i, hi)]; o[0][i] *= g; o[1][i] *= g; }
                        }
                    }
                    first = false;
                    float sacc = 0.f;
#pragma unroll
                    for (int i = 0; i < 16; ++i) { p[i] = __builtin_amdgcn_exp2f(p[i]); sacc += p[i]; }
                    lsum += sacc;
                    const u32x4 w0 = (u32x4){cvtpk(p[0], p[1]), cvtpk(p[2], p[3]), cvtpk(p[4], p[5]), cvtpk(p[6], p[7])};
                    const u32x4 w1 = (u32x4){cvtpk(p[8], p[9]), cvtpk(p[10], p[11]), cvtpk(p[12], p[13]), cvtpk(p[14], p[15])};
                    asm volatile("s_waitcnt lgkmcnt(0)" ::: "memory"); __builtin_amdgcn_sched_barrier(0);
#define ATT_VF(k) (bf16x8){vlo[k][0], vlo[k][1], vlo[k][2], vlo[k][3], vhi[k][0], vhi[k][1], vhi[k][2], vhi[k][3]}
                    o[0] = __builtin_amdgcn_mfma_f32_32x32x16_bf16(__builtin_bit_cast(bf16x8, w0), ATT_VF(0), o[0], 0, 0, 0);
                    o[0] = __builtin_amdgcn_mfma_f32_32x32x16_bf16(__builtin_bit_cast(bf16x8, w1), ATT_VF(1), o[0], 0, 0, 0);
                    o[1] = __builtin_amdgcn_mfma_f32_32x32x16_bf16(__builtin_bit_cast(bf16x8, w0), ATT_VF(2), o[1], 0, 0, 0);
                    o[1] = __builtin_amdgcn_mfma_f32_32x32x16_bf16(__builtin_bit_cast(bf16x8, w1), ATT_VF(3), o[1], 0, 0, 0);
#undef ATT_VF
                }
            }
        }
        if (MODE == 1) { if (has_next) U = Un; continue; }
        if (has_next) ATT_LDQ(qr, Un);
        { auto rr = __builtin_amdgcn_permlane32_swap(__float_as_uint(lsum), __float_as_uint(lsum), false, false); lsum = __uint_as_float(rr[0]) + __uint_as_float(rr[1]); }
        if (hi == 0) wsf[32 + n] = lsum;
        asm volatile("s_waitcnt lgkmcnt(0)" ::: "memory");
        LAS bf16* stg = (LAS bf16*)(shm + LDS_OST) + wid * 2048;
#pragma unroll
        for (int i = 0; i < 16; ++i) { const int orow = crow(i, hi); const float rl = __builtin_amdgcn_rcpf(wsf[32 + orow]);
#pragma unroll
            for (int d0 = 0; d0 < 2; ++d0) stg[orow * 64 + d0 * 32 + n] = (bf16)f2bf(o[d0][i] * rl); }
        asm volatile("s_waitcnt lgkmcnt(0)" ::: "memory");
#pragma unroll
        for (int i = 0; i < 4; ++i) { const int sl = i * 8 + (lane >> 3), ch = lane & 7; const u32x4 v = *(const LAS u32x4*)(stg + sl * 64 + ch * 8);
            const int trel = (2 * pr + (sl >> 4)) * 64 + 16 * jg + (sl & 15);
            if (MODE == 0 || C.p.tpc == 77) *(u32x4*)(U.o + (size_t)trel * D + ch * 8) = v; }
        asm volatile("s_waitcnt lgkmcnt(0)" ::: "memory");
        if (has_next) U = Un;
    }
    asm volatile("s_waitcnt vmcnt(0) lgkmcnt(0)\n\ts_barrier" ::: "memory");
#undef ATT_TROW
#undef ATT_DMA
#undef ATT_LDQ
}
}

struct Desc0 {
    const bf16* QKV; bf16* O; const float* sink; int v;
    __device__ __forceinline__ void operator()(int i, att::UnitDesc& U) const {
        const int b = v >> 4, kvh = (v >> 3) & 1, qb = v & 7;
        const size_t qrow0 = (size_t)b * SEQ + 256 * qb;
        U.kv = QKV; U.rpb = nullptr; U.pitch = NQKV0; U.mk1 = 0;
        if (i < 4) {
            const int h = kvh * 4 + i;
            U.q = QKV + qrow0 * NQKV0 + h * 64; U.o = O + qrow0 * D + h * 64; U.kcol = 512 + kvh * 64; U.vcol = 640 + kvh * 64;
            U.base0 = b * SEQ; U.n0 = 32; U.base1 = NLAT + b * CTXL; U.n1 = 4; U.kind = 0; U.mk0 = 0; U.has_sink = 0; U.sink2 = 0.f;
        } else if (i < 8) {
            const int h = kvh * 4 + (i - 4);
            const int jlo = (qb == 0) ? 2 : 0, jhi = (qb == 7) ? 6 : 8;
            U.q = QKV + qrow0 * NQKV0 + 768 + h * 64; U.o = O + qrow0 * D + 512 + h * 64; U.kcol = 1280 + kvh * 64; U.vcol = 1408 + kvh * 64;
            U.base0 = NLAT + b * CTXL; U.n0 = 4; U.base1 = b * SEQ + 256 * qb - 128 + 64 * jlo; U.n1 = jhi - jlo; U.kind = 1; U.mk0 = -128 + 64 * jlo; U.has_sink = 1; U.sink2 = sink[h] * LOG2E;
        } else {
            const int h16 = v & 15, isA = h16 < 8, hh = h16 & 7, kh = hh >> 2;
            const size_t crow0 = (size_t)NLAT + (size_t)b * CTXL;
            U.q = QKV + crow0 * NQKV0 + (isA ? 0 : 768) + hh * 64; U.o = O + crow0 * D + h16 * 64;
            U.kcol = (isA ? 512 : 1280) + kh * 64; U.vcol = (isA ? 640 : 1408) + kh * 64;
            U.base0 = NLAT + b * CTXL; U.n0 = 4; U.base1 = 0; U.n1 = 0; U.kind = 0; U.mk0 = 0; U.has_sink = isA ? 0 : 1; U.sink2 = isA ? 0.f : sink[hh] * LOG2E;
        }
    }
};
__device__ __forceinline__ void phase_attn0_fast(const Ctx& C) {
    for (int v = C.vcu; v < 256; v += C.G) {
        Desc0 d{(const bf16*)(C.p.ws + WS_QKV), C.hb(), C.p.in[14], v};
        att::attn_run<true, false>(C, 9, d);
    }
}
struct Desc1 {
    const bf16* QKV; bf16* O; const float* rpb; int v;
    __device__ __forceinline__ void operator()(int rb, att::UnitDesc& U) const {
        const int x = v >> 5, j = v & 31, g = j >> 3, st = rb;
        const int h = 2 * x + (g >> 1), b = (g & 1) * 8 + st; rb = (j + st) & 7;
        const int rq0 = 4 * rb, krlo = min(max(rq0 - 4, 0), 24), krhi = min(max(rq0 + 3 - 4, 0), 24) + 7;
        const size_t qrow0 = (size_t)b * SEQ + 256 * rb;
        U.q = QKV + qrow0 * NQKV1 + h * 64; U.kv = QKV; U.o = O + qrow0 * D + h * 64; U.rpb = rpb + (size_t)h * 465; U.pitch = NQKV1; U.kcol = 1024 + h * 64; U.vcol = 2048 + h * 64;
        U.base0 = NLAT + b * CTXL; U.n0 = 4; U.base1 = b * SEQ + 64 * krlo; U.n1 = krhi - krlo + 1; U.kind = 2; U.mk0 = krlo; U.mk1 = rq0; U.has_sink = 0; U.sink2 = 0.f;
    }
};
__device__ __forceinline__ void phase_attn1_fast(const Ctx& C) {
    for (int v = C.vcu; v < 256; v += C.G) {
        Desc1 d{(const bf16*)(C.p.ws + WS_QKV), C.hb(), C.p.in[26], v};
        att::attn_run_na<0>(C, 8, d);
    }
}
#ifdef PROBE_ATT1
__device__ __forceinline__ void phase_attn1_probe(const Ctx& C) {
    for (int v = C.vcu; v < 256; v += C.G) {
        Desc1 d{(const bf16*)(C.p.ws + WS_QKV), C.hb(), C.p.in[26], v};
        att::attn_run_na<PROBE_ATT1>(C, 8, d);
    }
}
#endif

constexpr int S_MODS = 0, S_MOD0 = 1, S_IN0 = 2, S_ATT0 = 3, S_OUT0 = 4, S_THIN0A = 5, S_GU0 = 6, S_DN0 = 7, S_THIN0B = 8,
              S_IN1 = 9, S_ATT1 = 10, S_OUT1 = 11, S_THIN1A = 12, S_MOE = 13, S_FINAL = S_MOE + 2, S_END = S_FINAL + 1;
#ifndef REP_ATT0
#define REP_ATT0 1
#endif
#ifndef REP_ATT1
#define REP_ATT1 1
#endif
#ifndef REP_MOE
#define REP_MOE 1
#endif
#ifndef REP_FFN0
#define REP_FFN0 1
#endif
#ifndef REP_PROJ
#define REP_PROJ 1
#endif
#ifndef REP_PRO
#define REP_PRO 1
#endif
#define RPT1(...) __VA_ARGS__
#define RPT2(...) __VA_ARGS__ __VA_ARGS__
#define RPT_(n, ...) RPT##n(__VA_ARGS__)
#define RPT(n, ...) RPT_(n, __VA_ARGS__)
#ifndef MK_ONE_LAUNCH
#define MK_ONE_LAUNCH 1
#endif

__global__ void __launch_bounds__(NT, 2) k_run(Params p, int lo, int hi) {
    extern __shared__ __attribute__((aligned(16))) unsigned char lds_raw[];
    Ctx C; C.p = p; C.lds = (LAS unsigned char*)lds_raw;
    C.tid = threadIdx.x; C.lane = C.tid & 63; C.wave = __builtin_amdgcn_readfirstlane(C.tid >> 6);
    C.G = gridDim.x; { const int bx = blockIdx.x; C.vcu = (C.G % 8 == 0) ? (bx % 8) * (C.G / 8) + bx / 8 : bx; }
    volatile LAS unsigned* MISC = (volatile LAS unsigned*)(C.lds + MISC_OFF);
    if (C.tid < 32) MISC[C.tid] = 0u;
    for (int i = C.tid; i < 1024; i += NT) { const int pos = i >> 4, j = i & 15; const float ang = (float)pos * exp2f(-(float)j * (13.287712379549449f / 16.f)); float sn, cs; __sincosf(ang, &sn, &cs);
        ((LAS f32x2*)(C.lds + ROPE_OFF))[pos * 17 + j] = (f32x2){cs, sn}; }
    __syncthreads();
    const bool one = (hi - lo) > 1;
    XcdBarrier bar; bar.bar = (unsigned*)C.ctl() + CW_BAR; bar.x = 0; bar.st = nullptr;
    if (one) bar = xcd_barrier_post((unsigned*)C.ctl() + CW_BAR, MISC + 8);
#define IN(k) (lo <= (k) && (k) < hi)
#define SEAM(k, need) do { if (one) { filler(C, (k), (need), MISC); xcd_barrier(bar); } } while (0)
#define SEAMP() do { if (one) xcd_barrier(bar); } while (0)
    unsigned char* ws = p.ws;
    RPT(REP_PRO, if (IN(S_MODS)) { phase_mods(C); __syncthreads(); phase_colmax(C); phase_convert(C); SEAMP(); })
    if (IN(S_MOD0)) { phase_modulate0(C); phase_convert_q(C); SEAMP(); }
    RPT(REP_PROJ, if (IN(S_IN0)) { phase_fgemm_in0(C); SEAM(2, 0); })
    RPT(REP_ATT0, if (IN(S_ATT0)) { phase_attn0_fast(C); SEAMP(); })
    RPT(REP_PROJ, if (IN(S_OUT0)) { phase_fgemm(C, C.hb(), (const bf16*)(ws + WS_WOUT0), MTOT / 256, D / 256, D, (bf16*)(ws + WS_YA), D); SEAM(4, 0); })
    if (IN(S_THIN0A)) { phase_thin0a(C); SEAMP(); }
#ifdef PROBE_GU0
    if (IN(S_GU0)) { phase_fgemm_gu0_probe(C); SEAM(6, 0); }
#endif
    RPT(REP_FFN0, if (IN(S_GU0)) { phase_fgemm_gu0(C); SEAM(6, 0); }
    if (IN(S_DN0)) { phase_fgemm_dn0(C); SEAM(7, 0); })
    if (IN(S_THIN0B)) { phase_thin0b(C); SEAM(8, NFILL_L1); }
    RPT(REP_PROJ, if (IN(S_IN1)) { phase_fgemm_in1(C); SEAM(9, 0); })
    RPT(REP_ATT1, if (IN(S_ATT1)) { phase_attn1_fast(C); SEAMP(); })
#ifdef PROBE_ATT1
    if (IN(S_ATT1)) { phase_attn1_probe(C); SEAMP(); }
#endif
    RPT(REP_PROJ, if (IN(S_OUT1)) { phase_fgemm(C, C.hb(), (const bf16*)(ws + WS_WOUT1), NLAT / 256, D / 256, D, (bf16*)(ws + WS_YA), D); SEAMP(); })
    if (IN(S_THIN1A)) { phase_thin1a(C); SEAM(12, NFILL); }
    RPT(REP_MOE, if (IN(S_MOE)) { phase_moe_gu_fast(C); SEAMP(); }
    if (IN(S_MOE + 1)) { phase_moe_dn_fast(C); SEAMP(); })
    if (IN(S_FINAL)) phase_final(C);
#undef IN
#undef SEAM
#undef SEAMP
}

extern "C" void kernel_launch(void* const* d_in, const int* in_sizes, int n_in, void* d_out, int out_size, void* d_ws, size_t ws_size, hipStream_t stream) {
    static int grid = 0;
    if (grid == 0) {
        if (n_in != 31 || out_size != NLAT * D || ws_size < WS_MIN) { fprintf(stderr, "kernel_launch: unexpected problem (n_in %d out %d ws %zu)\n", n_in, out_size, ws_size); grid = -1; return; }
        int dev = 0, cus = 0;
        if (hipGetDevice(&dev) != hipSuccess || hipDeviceGetAttribute(&cus, hipDeviceAttributeMultiprocessorCount, dev) != hipSuccess) { grid = -1; return; }
        if (hipFuncSetAttribute((const void*)k_run, hipFuncAttributeMaxDynamicSharedMemorySize, LDS_BYTES) != hipSuccess) { grid = -1; return; }
        grid = cus;
    }
    if (grid < 0) return;
    (void)hipMemsetAsync((char*)d_ws + WS_CTL, 0, CTL_ZERO_BYTES, stream);
    Params p{};
    for (int i = 0; i < 31; ++i) p.in[i] = (const float*)d_in[i];
    p.out = (float*)d_out; p.ws = (unsigned char*)d_ws;
    p.tpc = 0; p.pad = 0;
#if MK_ONE_LAUNCH
    hipLaunchKernelGGL(k_run, dim3(grid), dim3(NT), LDS_BYTES, stream, p, 0, S_END);
#else
    for (int s = 0; s < S_END; ++s) hipLaunchKernelGGL(k_run, dim3(grid), dim3(NT), LDS_BYTES, stream, p, s, s + 1);
#endif
}
```

```cpp
#include <hip/hip_runtime.h>
#include <cstdint>
#include <cstdio>

#define GAS __attribute__((address_space(1)))
#define LAS __attribute__((address_space(3)))
typedef unsigned short bf16;
typedef float f32x4 __attribute__((ext_vector_type(4)));
typedef float f32x2 __attribute__((ext_vector_type(2)));
typedef unsigned u32x4 __attribute__((ext_vector_type(4)));
typedef unsigned u32x2 __attribute__((ext_vector_type(2)));

constexpr int D = 1024, NB = 16, SEQ = 2048, NLAT = NB * SEQ, CTXL = 256, NCTX = NB * CTXL, MTOT = NLAT + NCTX;
constexpr int NQKV0 = 1536, NQKV1 = 3072, FF0 = 2816, FFE = 3584, NE = 8, NMOD = 6;
constexpr int MAXTILES = 264;
constexpr int MAXCH = 4;
constexpr float EPS = 1e-6f;
constexpr float LOG2E = 1.4426950408889634f;
constexpr float QSCALE = 0.125f * LOG2E;
constexpr float W8GU_SCALE = 32.f, W8DN_SCALE = 64.f;
constexpr float W8DN0_SCALE = 64.f, ACT0_SCALE = 8.f;

constexpr size_t MiB = 1u << 20;
constexpr size_t WS_CTL = 0, CTL_ZERO_BYTES = 1 * MiB;
constexpr size_t WS_MODS = 1 * MiB;
constexpr size_t WS_RE = 2 * MiB;
constexpr size_t WS_RW = WS_RE + 256 * 1024;
constexpr size_t WS_RJ = WS_RW + 256 * 1024;
constexpr size_t WS_HS = WS_RJ + 256 * 1024;
constexpr size_t WS_TOKOF = 3 * MiB;
constexpr size_t WS_CTXS = 4 * MiB;
constexpr size_t WS_WIN1 = 20 * MiB, WS_WOUT1 = 26 * MiB;
constexpr size_t WS_W8GU = 28 * MiB, WS_W8DN = 84 * MiB;
constexpr size_t WS_H8 = 112 * MiB;
constexpr size_t WS_HB = 196 * MiB;
constexpr size_t WS_WIN0 = 268 * MiB, WS_WOUT0 = 271 * MiB, WS_WGU0 = 273 * MiB, WS_WDN0 = 284 * MiB;
constexpr size_t WS_OV = 290 * MiB;
constexpr size_t WS_QKV = WS_OV;
constexpr size_t WS_YA = WS_OV;
constexpr size_t WS_ACT0 = WS_OV;
constexpr size_t WS_YB = 488 * MiB;
constexpr size_t WS_ACT8 = 144 * MiB;
constexpr size_t WS_YS = 375 * MiB;
constexpr size_t WS_X3 = 507 * MiB;
constexpr size_t WS_MIN = 571 * MiB;
constexpr int CW_CNT = 64;
constexpr int CW_FILL = 128;
constexpr int CW_DONE = 192;
constexpr int CW_CM = 65536;
constexpr int CM_IN0 = CW_CM, CM_GU0 = CW_CM + 1536, CM_IN1 = CM_GU0 + 5632;
constexpr int CW_BAR = 4096;
constexpr int ROPE_OFF = 131072 + 1024;
constexpr int MISC_OFF = 131072 + 320;

constexpr int TOK_OFF = 131072 + 1024 + 9216;
constexpr int LDS_BYTES = TOK_OFF + 8192;
constexpr int NWAVES = 8, NT = 512;

struct Params {
    const float* in[31];
    float* out;
    unsigned char* ws;
    int tpc;
    int pad;
};

__device__ __forceinline__ unsigned f2bf(float f) { unsigned u = __builtin_bit_cast(unsigned, f); return (u + 0x7fffu + ((u >> 16) & 1u)) >> 16; }
__device__ __forceinline__ unsigned pk2(float lo, float hi) { return f2bf(lo) | (f2bf(hi) << 16); }
__device__ __forceinline__ unsigned pk4_fp8(float a, float b, float c, float d) { unsigned r = 0; r = __builtin_amdgcn_cvt_pk_fp8_f32(a, b, r, false); r = __builtin_amdgcn_cvt_pk_fp8_f32(c, d, r, true); return r; }
__device__ __forceinline__ float bflo(unsigned w) { return __builtin_bit_cast(float, w << 16); }
__device__ __forceinline__ float bfhi(unsigned w) { return __builtin_bit_cast(float, w & 0xffff0000u); }
__device__ __forceinline__ float bf2f(bf16 b) { return __builtin_bit_cast(float, (unsigned)b << 16); }
__device__ __forceinline__ float wave_sum(float v) {
#pragma unroll
    for (int o = 1; o < 64; o <<= 1) v += __shfl_xor(v, o);
    return v;
}
__device__ __forceinline__ float wave_max(float v) {
#pragma unroll
    for (int o = 1; o < 64; o <<= 1) v = fmaxf(v, __shfl_xor(v, o));
    return v;
}
__device__ __forceinline__ float silu_f(float v) { return v / (1.f + __expf(-v)); }

struct Row16 { f32x4 v[4]; };
__device__ __forceinline__ void ld_f32(Row16& r, const float* p, int lane) {
    const f32x4* q = (const f32x4*)p + lane;
#pragma unroll
    for (int j = 0; j < 4; ++j) r.v[j] = q[64 * j];
}
__device__ __forceinline__ void st_f32(const Row16& r, float* p, int lane) {
    f32x4* q = (f32x4*)p + lane;
#pragma unroll
    for (int j = 0; j < 4; ++j) q[64 * j] = r.v[j];
}
__device__ __forceinline__ void ld_bf(Row16& r, const bf16* p, int lane) {
    const u32x2* q = (const u32x2*)p + lane;
#pragma unroll
    for (int j = 0; j < 4; ++j) { const u32x2 w = q[64 * j]; r.v[j] = (f32x4){bflo(w.x), bfhi(w.x), bflo(w.y), bfhi(w.y)}; }
}
__device__ __forceinline__ void st_bf(const Row16& r, bf16* p, int lane) {
    u32x2* q = (u32x2*)p + lane;
#pragma unroll
    for (int j = 0; j < 4; ++j) { u32x2 w; w.x = pk2(r.v[j][0], r.v[j][1]); w.y = pk2(r.v[j][2], r.v[j][3]); q[64 * j] = w; }
}
__device__ __forceinline__ float row_rstd(const Row16& r) {
    float s = 0.f;
#pragma unroll
    for (int j = 0; j < 4; ++j) s += (r.v[j][0] * r.v[j][0] + r.v[j][1] * r.v[j][1]) + (r.v[j][2] * r.v[j][2] + r.v[j][3] * r.v[j][3]);
    return rsqrtf(wave_sum(s) * (1.f / D) + EPS);
}

#define XB_TMO      128
#define XB_XCNT(j)  (256  + 64 * (j))
#define XB_XSUB(j)  (1280 + 64 * (j))
#define XB_XGEN(j)  (2304 + 64 * (j))
#define XB_TOP      3328
#define XB_TOPGEN   3392
#define XCD_BAR_WORDS 3456
#define XB_SPIN_CAP (1u << 18)

__device__ __forceinline__ unsigned xb_ld(unsigned* p)              { return __hip_atomic_load(p, __ATOMIC_RELAXED, __HIP_MEMORY_SCOPE_AGENT); }
__device__ __forceinline__ unsigned xb_add(unsigned* p, unsigned v) { return __hip_atomic_fetch_add(p, v, __ATOMIC_RELAXED, __HIP_MEMORY_SCOPE_AGENT); }
__device__ __forceinline__ unsigned xb_xcc_id() { return (unsigned)__builtin_amdgcn_s_getreg((3 << 11) | 20) & 0xFu; }
#define XB_SPIN(cond, bar) do { unsigned _sp = 0; while (cond) { __builtin_amdgcn_s_sleep(1); \
    if ((++_sp & 255u) == 0u) { if (xb_ld(&(bar)[XB_TMO])) break; if (_sp > XB_SPIN_CAP) { atomicAdd(&(bar)[XB_TMO], 1u); break; } } } } while (0)

struct XcdBarrier {
    unsigned* bar; unsigned x;
    volatile LAS unsigned* st;
};

__device__ __forceinline__ XcdBarrier xcd_barrier_post(unsigned* bar, volatile LAS unsigned* st) {
    XcdBarrier b; b.bar = bar; b.x = xb_xcc_id(); b.st = st;
    if (threadIdx.x == 0) (void)xb_add(&bar[XB_XCNT(b.x)], 1u);
    return b;
}
__device__ __forceinline__ void xcd_barrier_complete(unsigned* bar, unsigned x, unsigned& nloc, unsigned& nx) {
    const unsigned G = gridDim.x * gridDim.y * gridDim.z;
    unsigned sum, cnt, mine, sp = 0u;
    for (;;) {
        sum = 0u; cnt = 0u; mine = 0u;
#pragma unroll
        for (unsigned j = 0; j < 16; ++j) { const unsigned c = xb_ld(&bar[XB_XCNT(j)]); sum += c; cnt += (c > 0u) ? 1u : 0u; mine = (j == x) ? c : mine; }
        if (sum == G) break;
        __builtin_amdgcn_s_sleep(1);
        if ((++sp & 255u) == 0u) { if (xb_ld(&bar[XB_TMO])) break; if (sp > XB_SPIN_CAP) { atomicAdd(&bar[XB_TMO], 1u); break; } }
    }
    nloc = mine > 0u ? mine : 1u; nx = cnt > 0u ? cnt : 1u;
}

__device__ __forceinline__ void xcd_barrier(const XcdBarrier& b) {
    asm volatile("s_waitcnt vmcnt(0)" ::: "memory");
    __syncthreads();
    if (threadIdx.x == 0) {
        unsigned* bar = b.bar;
        __builtin_amdgcn_s_waitcnt(0);
        unsigned nloc = b.st[0], nx = b.st[1];
        if (nloc == 0u) { xcd_barrier_complete(bar, b.x, nloc, nx); b.st[0] = nloc; b.st[1] = nx; }
        const unsigned old = xb_add(&bar[XB_XSUB(b.x)], 1u);
        const unsigned gen = old / nloc;
        if (old + 1u == (gen + 1u) * nloc) {
            __builtin_amdgcn_fence(__ATOMIC_RELEASE, "agent");
            asm volatile("s_waitcnt vmcnt(0)" ::: "memory");
            const unsigned og = xb_add(&bar[XB_TOP], 1u);
            const unsigned tg = og / nx;
            if (og + 1u == (tg + 1u) * nx) xb_add(&bar[XB_TOPGEN], 1u);
            else XB_SPIN(xb_ld(&bar[XB_TOPGEN]) == tg, bar);
            __builtin_amdgcn_fence(__ATOMIC_ACQUIRE, "agent");
            xb_add(&bar[XB_XGEN(b.x)], 1u);
            asm volatile("s_waitcnt vmcnt(0)" ::: "memory");
        } else {
            XB_SPIN(xb_ld(&bar[XB_XGEN(b.x)]) == gen, bar);
            __builtin_amdgcn_fence(__ATOMIC_ACQUIRE, "agent");
            asm volatile("s_waitcnt vmcnt(0)" ::: "memory");
        }
    }
    __syncthreads();
}

__device__ __forceinline__ void st_q8(const Row16& h, unsigned char* qrow, float* scale_out, int lane) {
    float am = 0.f;
#pragma unroll
    for (int j = 0; j < 4; ++j) am = fmaxf(fmaxf(am, fmaxf(fabsf(h.v[j][0]), fabsf(h.v[j][1]))), fmaxf(fabsf(h.v[j][2]), fabsf(h.v[j][3])));
    am = fmaxf(wave_max(am), 1e-20f);
    const float inv = 127.f / am;
    unsigned* q = (unsigned*)qrow + lane;
#pragma unroll
    for (int j = 0; j < 4; ++j) { const int a = (int)__builtin_rintf(h.v[j][0] * inv), b = (int)__builtin_rintf(h.v[j][1] * inv), c = (int)__builtin_rintf(h.v[j][2] * inv), d = (int)__builtin_rintf(h.v[j][3] * inv);
        q[64 * j] = (unsigned)(a & 255) | ((unsigned)(b & 255) << 8) | ((unsigned)(c & 255) << 16) | ((unsigned)d << 24); }
    if (lane == 0) *scale_out = am * (1.f / 127.f);
}
struct Ctx {
    Params p;
    LAS unsigned char* lds;
    int tid, lane, wave, vcu, G;
    __device__ __forceinline__ const float* mods(int layer, int r) const { return (const float*)(p.ws + WS_MODS) + ((size_t)layer * 17 + r) * (NMOD * D); }
    __device__ __forceinline__ bf16* hb() const { return (bf16*)(p.ws + WS_HB); }
    __device__ __forceinline__ unsigned* ctl() const { return (unsigned*)(p.ws + WS_CTL); }
};

struct TileTab { int tb[9]; int cnt[8]; };
__device__ __forceinline__ void load_tiletab(const Ctx& C, TileTab& T) {
    int acc = 0;
#pragma unroll
    for (int e = 0; e < NE; ++e) { const int c = __builtin_amdgcn_readfirstlane((int)__hip_atomic_load(C.ctl() + CW_CNT + e, __ATOMIC_RELAXED, __HIP_MEMORY_SCOPE_AGENT)); T.cnt[e] = c; T.tb[e] = acc; acc += (c + 255) >> 8; }
    T.tb[8] = acc;
}
__device__ __forceinline__ int tile_expert(const TileTab& T, int st) {
    int e = 0;
#pragma unroll
    for (int k = 1; k < NE; ++k) e += (st >= T.tb[k]) ? 1 : 0;
    return e;
}

__device__ __forceinline__ void phase_mods(const Ctx& C) {
    LAS float* sl = (LAS float*)C.lds;
    LAS float* part = (LAS float*)(C.lds + 17 * 1024 * 4);
    const float* cin = C.p.in[1]; const float* cctx = C.p.in[3];
    for (int i = C.tid; i < 17 * 1024; i += NT) { const float v = (i < 16 * 1024) ? cin[i] : cctx[i - 16 * 1024]; sl[i] = silu_f(v); }
    __syncthreads();
    const int nitems = 2 * (NMOD * D / 64);
    for (int it = C.vcu; it < nitems; it += C.G) {
        const int layer = it / (NMOD * D / 64), cb = it % (NMOD * D / 64);
        const float* W = C.p.in[layer == 0 ? 4 : 18]; const float* Bv = C.p.in[layer == 0 ? 5 : 19];
        const int col = cb * 64 + C.lane;
        float acc[17];
#pragma unroll
        for (int r = 0; r < 17; ++r) acc[r] = 0.f;
        const int k0 = C.wave * 128;
        float wa[8], wb[8];
#define MODS_LD(w, kb) do { const float* Wk_ = W + (size_t)(kb) * (NMOD * D) + col; _Pragma("unroll") for (int u = 0; u < 8; ++u) w[u] = Wk_[(size_t)u * (NMOD * D)]; } while (0)
#define MODS_FMA(w, kb) do { _Pragma("unroll") for (int u4 = 0; u4 < 2; ++u4) _Pragma("unroll") for (int r = 0; r < 17; ++r) { const f32x4 s = *(const LAS f32x4*)(sl + r * 1024 + (kb) + 4 * u4); \
            acc[r] += s[0] * w[4 * u4] + s[1] * w[4 * u4 + 1] + s[2] * w[4 * u4 + 2] + s[3] * w[4 * u4 + 3]; } } while (0)
        MODS_LD(wa, k0);
#pragma nounroll
        for (int kb = k0; kb < k0 + 128; kb += 16) {
            MODS_LD(wb, kb + 8);
            MODS_FMA(wa, kb);
            if (kb + 16 < k0 + 128) MODS_LD(wa, kb + 16);
            MODS_FMA(wb, kb + 8);
        }
#undef MODS_LD
#undef MODS_FMA
#pragma unroll
        for (int r = 0; r < 17; ++r) part[(C.wave * 17 + r) * 64 + C.lane] = acc[r];
        __syncthreads();
        for (int o = C.tid; o < 17 * 64; o += NT) {
            const int r = o / 64, c = o % 64; float s = 0.f;
#pragma unroll
            for (int w = 0; w < 8; ++w) s += part[(w * 17 + r) * 64 + c];
            ((float*)(C.p.ws + WS_MODS))[((size_t)layer * 17 + r) * (NMOD * D) + cb * 64 + c] = s + Bv[cb * 64 + c];
        }
        __syncthreads();
    }
}

__device__ __forceinline__ void modulate_row(const Row16& x, Row16& h, const float* g, const float* shift, const float* scale, int lane) {
    const float rs = row_rstd(x);
    Row16 gv, sh, sc; ld_f32(gv, g, lane); ld_f32(sh, shift, lane); ld_f32(sc, scale, lane);
#pragma unroll
    for (int j = 0; j < 4; ++j) h.v[j] = x.v[j] * rs * gv.v[j] * (1.f + sc.v[j]) + sh.v[j];
}
__device__ __forceinline__ void ld_lds(Row16& r, const LAS float* p, int lane) {
    const LAS f32x4* q = (const LAS f32x4*)p + lane;
#pragma unroll
    for (int j = 0; j < 4; ++j) r.v[j] = q[64 * j];
}
__device__ __forceinline__ void modulate_row_l(const Row16& x, Row16& h, const LAS float* g, const LAS float* shift, const LAS float* scale, int lane) {
    const float rs = row_rstd(x);
    Row16 gv, sh, sc; ld_lds(gv, g, lane); ld_lds(sh, shift, lane); ld_lds(sc, scale, lane);
#pragma unroll
    for (int j = 0; j < 4; ++j) h.v[j] = x.v[j] * rs * gv.v[j] * (1.f + sc.v[j]) + sh.v[j];
}
__device__ __forceinline__ void resid_row_l(Row16& x, const Row16& y, const LAS float* g, const LAS float* gate, int lane) {
    const float rs = row_rstd(y);
    Row16 gv, ga; ld_lds(gv, g, lane); ld_lds(ga, gate, lane);
#pragma unroll
    for (int j = 0; j < 4; ++j) x.v[j] = x.v[j] + ga.v[j] * (y.v[j] * rs * gv.v[j]);
}
__device__ __forceinline__ void stage5(const Ctx& C, int set, const float* v0, const float* v1, const float* v2, const float* v3, const float* v4, int base = 0) {
    LAS f32x4* P = (LAS f32x4*)(C.lds + base + set * 5 * D * 4);
    int tid_ = C.tid; asm volatile("" : "+v"(tid_));
    for (int i = tid_; i < 5 * D / 4; i += NT) { const int v = i / (D / 4), k = i % (D / 4); const float* src = (v == 0) ? v0 : (v == 1) ? v1 : (v == 2) ? v2 : (v == 3) ? v3 : v4; P[i] = ((const f32x4*)src)[k]; }
}
__device__ __forceinline__ int thin_row(const Ctx& C, int t) {
    return (t < 8) ? (C.vcu >> 4) * SEQ + (C.vcu & 15) * 128 + C.wave * 16 + 2 * t : NLAT + C.vcu * 16 + C.wave * 2;
}
__device__ __forceinline__ void resid_row(Row16& x, const Row16& y, const float* g, const float* gate, int lane) {
    const float rs = row_rstd(y);
    Row16 gv, ga; ld_f32(gv, g, lane); ld_f32(ga, gate, lane);
#pragma unroll
    for (int j = 0; j < 4; ++j) x.v[j] = x.v[j] + ga.v[j] * (y.v[j] * rs * gv.v[j]);
}

__device__ __forceinline__ void modulate0_generic(const Ctx& C) {
    const int gw = C.vcu * NWAVES + C.wave, NGW = C.G * NWAVES;
    Row16 x0, x1, nx0, nx1, h;
#define M0_LD(a0, a1, mm) do { const float* xin_ = ((mm) < NLAT) ? C.p.in[0] + (size_t)(mm) * D : C.p.in[2] + (size_t)((mm) - NLAT) * D; ld_f32(a0, xin_, C.lane); ld_f32(a1, xin_ + D, C.lane); } while (0)
    if (gw < MTOT / 2) M0_LD(x0, x1, 2 * gw);
    for (int mp = gw; mp < MTOT / 2; mp += NGW) {
        const int m = 2 * mp;
        const bool lat = m < NLAT; const int r = lat ? m / SEQ : 16;
        const float* md = C.mods(0, r);
        const bool more = mp + NGW < MTOT / 2;
        if (more) M0_LD(nx0, nx1, 2 * (mp + NGW));
        modulate_row(x0, h, C.p.in[6], md + 0 * D, md + 1 * D, C.lane);
        st_q8(h, C.p.ws + WS_HB + (size_t)m * D, (float*)(C.p.ws + WS_HS) + m, C.lane);
        modulate_row(x1, h, C.p.in[6], md + 0 * D, md + 1 * D, C.lane);
        st_q8(h, C.p.ws + WS_HB + (size_t)(m + 1) * D, (float*)(C.p.ws + WS_HS) + m + 1, C.lane);
        if (more) { x0 = nx0; x1 = nx1; }
    }
#undef M0_LD
}
__device__ __forceinline__ void phase_modulate0(const Ctx& C) {
    int ln = C.lane; asm volatile("" : "+v"(ln));
    if (C.G != 256) { modulate0_generic(C); return; }
    { const float* md = C.mods(0, C.vcu >> 4); const float* mc = C.mods(0, 16);
      stage5(C, 0, C.p.in[6], md, md + D, md, md); stage5(C, 1, C.p.in[6], mc, mc + D, mc, mc); }
    __syncthreads();
    Row16 x0, x1, nx0, nx1, h;
#define M0_LD(a0, a1, mm) do { const float* xin_ = ((mm) < NLAT) ? C.p.in[0] + (size_t)(mm) * D : C.p.in[2] + (size_t)((mm) - NLAT) * D; ld_f32(a0, xin_, ln); ld_f32(a1, xin_ + D, ln); } while (0)
    M0_LD(x0, x1, thin_row(C, 0));
#pragma nounroll
    for (int t = 0; t < 9; ++t) {
        const int m = thin_row(C, t);
        const LAS float* P = (const LAS float*)(C.lds + (t < 8 ? 0 : 5 * D * 4));
        if (t < 8) M0_LD(nx0, nx1, thin_row(C, t + 1));
        modulate_row_l(x0, h, P, P + D, P + 2 * D, ln);
        st_q8(h, C.p.ws + WS_HB + (size_t)m * D, (float*)(C.p.ws + WS_HS) + m, ln);
        modulate_row_l(x1, h, P, P + D, P + 2 * D, ln);
        st_q8(h, C.p.ws + WS_HB + (size_t)(m + 1) * D, (float*)(C.p.ws + WS_HS) + m + 1, ln);
        if (t < 8) { x0 = nx0; x1 = nx1; }
    }
#undef M0_LD
    __syncthreads();
}
__device__ __forceinline__ void thin0a_generic(const Ctx& C) {
    const int gw = C.vcu * NWAVES + C.wave, NGW = C.G * NWAVES;
    const bf16* Y = (const bf16*)(C.p.ws + WS_YA);
    Row16 x0, x1, y0, y1, nx0, nx1, ny0, ny1, h;
#define T0A_LD(a0, a1, b0, b1, mm) do { const float* xin_ = ((mm) < NLAT) ? C.p.in[0] + (size_t)(mm) * D : C.p.in[2] + (size_t)((mm) - NLAT) * D; \
        ld_f32(a0, xin_, C.lane); ld_f32(a1, xin_ + D, C.lane); ld_bf(b0, Y + (size_t)(mm) * D, C.lane); ld_bf(b1, Y + (size_t)((mm) + 1) * D, C.lane); } while (0)
    if (gw < MTOT / 2) T0A_LD(x0, x1, y0, y1, 2 * gw);
    for (int mp = gw; mp < MTOT / 2; mp += NGW) {
        const int m = 2 * mp;
        const bool lat = m < NLAT; const int r = lat ? m / SEQ : 16;
        const float* md = C.mods(0, r);
        const bool more = mp + NGW < MTOT / 2;
        if (more) T0A_LD(nx0, nx1, ny0, ny1, 2 * (mp + NGW));
        resid_row(x0, y0, C.p.in[7], md + 2 * D, C.lane);
        resid_row(x1, y1, C.p.in[7], md + 2 * D, C.lane);
        if (lat) { st_bf(x0, (bf16*)C.p.out + (size_t)m * D, C.lane); st_bf(x1, (bf16*)C.p.out + (size_t)(m + 1) * D, C.lane); }
        else { st_f32(x0, (float*)(C.p.ws + WS_CTXS) + (size_t)(m - NLAT) * D, C.lane); st_f32(x1, (float*)(C.p.ws + WS_CTXS) + (size_t)(m + 1 - NLAT) * D, C.lane); }
        modulate_row(x0, h, C.p.in[8], md + 3 * D, md + 4 * D, C.lane);
        st_q8(h, C.p.ws + WS_HB + (size_t)m * D, (float*)(C.p.ws + WS_HS) + m, C.lane);
        modulate_row(x1, h, C.p.in[8], md + 3 * D, md + 4 * D, C.lane);
        st_q8(h, C.p.ws + WS_HB + (size_t)(m + 1) * D, (float*)(C.p.ws + WS_HS) + m + 1, C.lane);
        if (more) { x0 = nx0; x1 = nx1; y0 = ny0; y1 = ny1; }
    }
#undef T0A_LD
}
__device__ __forceinline__ void phase_thin0a(const Ctx& C) {
    int ln = C.lane; asm volatile("" : "+v"(ln));
    const bf16* Y = (const bf16*)(C.p.ws + WS_YA);
    if (C.G != 256) { thin0a_generic(C); return; }
    { const float* md = C.mods(0, C.vcu >> 4); const float* mc = C.mods(0, 16);
      stage5(C, 0, C.p.in[7], md + 2 * D, C.p.in[8], md + 3 * D, md + 4 * D); stage5(C, 1, C.p.in[7], mc + 2 * D, C.p.in[8], mc + 3 * D, mc + 4 * D); }
    __syncthreads();
    Row16 x0, x1, y0, y1, nx0, nx1, ny0, ny1, h;
#define T0A_LD(a0, a1, b0, b1, mm) do { const float* xin_ = ((mm) < NLAT) ? C.p.in[0] + (size_t)(mm) * D : C.p.in[2] + (size_t)((mm) - NLAT) * D; \
        ld_f32(a0, xin_, ln); ld_f32(a1, xin_ + D, ln); ld_bf(b0, Y + (size_t)(mm) * D, ln); ld_bf(b1, Y + (size_t)((mm) + 1) * D, ln); } while (0)
    T0A_LD(x0, x1, y0, y1, thin_row(C, 0));
#pragma nounroll
    for (int t = 0; t < 9; ++t) {
        const int m = thin_row(C, t);
        const bool lat = t < 8;
        const LAS float* P = (const LAS float*)(C.lds + (lat ? 0 : 5 * D * 4));
        if (t < 8) T0A_LD(nx0, nx1, ny0, ny1, thin_row(C, t + 1));
        resid_row_l(x0, y0, P, P + D, ln);
        resid_row_l(x1, y1, P, P + D, ln);
        if (lat) { st_bf(x0, (bf16*)C.p.out + (size_t)m * D, ln); st_bf(x1, (bf16*)C.p.out + (size_t)(m + 1) * D, ln); }
        else { st_f32(x0, (float*)(C.p.ws + WS_CTXS) + (size_t)(m - NLAT) * D, ln); st_f32(x1, (float*)(C.p.ws + WS_CTXS) + (size_t)(m + 1 - NLAT) * D, ln); }
        modulate_row_l(x0, h, P + 2 * D, P + 3 * D, P + 4 * D, ln);
        st_q8(h, C.p.ws + WS_HB + (size_t)m * D, (float*)(C.p.ws + WS_HS) + m, ln);
        modulate_row_l(x1, h, P + 2 * D, P + 3 * D, P + 4 * D, ln);
        st_q8(h, C.p.ws + WS_HB + (size_t)(m + 1) * D, (float*)(C.p.ws + WS_HS) + m + 1, ln);
        if (t < 8) { x0 = nx0; x1 = nx1; y0 = ny0; y1 = ny1; }
    }
#undef T0A_LD
    __syncthreads();
}
__device__ __forceinline__ void thin0b_generic(const Ctx& C) {
    const int gw = C.vcu * NWAVES + C.wave, NGW = C.G * NWAVES;
    const bf16* Y = (const bf16*)(C.p.ws + WS_YB);
    Row16 x0, x1, y0, y1, nx0, nx1, ny0, ny1, h;
#define T0B_LD(a0, a1, b0, b1, mm) do { \
        if ((mm) < NLAT) { ld_bf(a0, (const bf16*)C.p.out + (size_t)(mm) * D, C.lane); ld_bf(a1, (const bf16*)C.p.out + (size_t)((mm) + 1) * D, C.lane); } \
        else { ld_f32(a0, (const float*)(C.p.ws + WS_CTXS) + (size_t)((mm) - NLAT) * D, C.lane); ld_f32(a1, (const float*)(C.p.ws + WS_CTXS) + (size_t)((mm) + 1 - NLAT) * D, C.lane); } \
        ld_bf(b0, Y + (size_t)(mm) * D, C.lane); ld_bf(b1, Y + (size_t)((mm) + 1) * D, C.lane); } while (0)
    if (gw < MTOT / 2) T0B_LD(x0, x1, y0, y1, 2 * gw);
    for (int mp = gw; mp < MTOT / 2; mp += NGW) {
        const int m = 2 * mp;
        const bool lat = m < NLAT; const int r = lat ? m / SEQ : 16;
        const float* md0 = C.mods(0, r); const float* md1 = C.mods(1, r);
        const bool more = mp + NGW < MTOT / 2;
        if (more) T0B_LD(nx0, nx1, ny0, ny1, 2 * (mp + NGW));
        resid_row(x0, y0, C.p.in[9], md0 + 5 * D, C.lane);
        resid_row(x1, y1, C.p.in[9], md0 + 5 * D, C.lane);
        if (lat) { st_bf(x0, (bf16*)C.p.out + (size_t)m * D, C.lane); st_bf(x1, (bf16*)C.p.out + (size_t)(m + 1) * D, C.lane); }
        modulate_row(x0, h, C.p.in[20], md1 + 0 * D, md1 + 1 * D, C.lane);
        st_q8(h, C.p.ws + WS_HB + (size_t)m * D, (float*)(C.p.ws + WS_HS) + m, C.lane);
        modulate_row(x1, h, C.p.in[20], md1 + 0 * D, md1 + 1 * D, C.lane);
        st_q8(h, C.p.ws + WS_HB + (size_t)(m + 1) * D, (float*)(C.p.ws + WS_HS) + m + 1, C.lane);
        if (more) { x0 = nx0; x1 = nx1; y0 = ny0; y1 = ny1; }
    }
#undef T0B_LD
}
__device__ __forceinline__ void phase_thin0b(const Ctx& C) {
    int ln = C.lane; asm volatile("" : "+v"(ln));
    const bf16* Y = (const bf16*)(C.p.ws + WS_YB);
    if (C.G != 256) { thin0b_generic(C); return; }
    { const float* m0 = C.mods(0, C.vcu >> 4); const float* m1 = C.mods(1, C.vcu >> 4); const float* c0 = C.mods(0, 16); const float* c1 = C.mods(1, 16);
      stage5(C, 0, C.p.in[9], m0 + 5 * D, C.p.in[20], m1, m1 + D); stage5(C, 1, C.p.in[9], c0 + 5 * D, C.p.in[20], c1, c1 + D); }
    __syncthreads();
    Row16 x0, x1, y0, y1, nx0, nx1, ny0, ny1, h;
#define T0B_LD(a0, a1, b0, b1, mm) do { \
        if ((mm) < NLAT) { ld_bf(a0, (const bf16*)C.p.out + (size_t)(mm) * D, ln); ld_bf(a1, (const bf16*)C.p.out + (size_t)((mm) + 1) * D, ln); } \
        else { ld_f32(a0, (const float*)(C.p.ws + WS_CTXS) + (size_t)((mm) - NLAT) * D, ln); ld_f32(a1, (const float*)(C.p.ws + WS_CTXS) + (size_t)((mm) + 1 - NLAT) * D, ln); } \
        ld_bf(b0, Y + (size_t)(mm) * D, ln); ld_bf(b1, Y + (size_t)((mm) + 1) * D, ln); } while (0)
    T0B_LD(x0, x1, y0, y1, thin_row(C, 0));
#pragma nounroll
    for (int t = 0; t < 9; ++t) {
        const int m = thin_row(C, t);
        const bool lat = t < 8;
        const LAS float* P = (const LAS float*)(C.lds + (lat ? 0 : 5 * D * 4));
        if (t < 8) T0B_LD(nx0, nx1, ny0, ny1, thin_row(C, t + 1));
        resid_row_l(x0, y0, P, P + D, ln);
        resid_row_l(x1, y1, P, P + D, ln);
        if (lat) { st_bf(x0, (bf16*)C.p.out + (size_t)m * D, ln); st_bf(x1, (bf16*)C.p.out + (size_t)(m + 1) * D, ln); }
        modulate_row_l(x0, h, P + 2 * D, P + 3 * D, P + 4 * D, ln);
        st_q8(h, C.p.ws + WS_HB + (size_t)m * D, (float*)(C.p.ws + WS_HS) + m, ln);
        modulate_row_l(x1, h, P + 2 * D, P + 3 * D, P + 4 * D, ln);
        st_q8(h, C.p.ws + WS_HB + (size_t)(m + 1) * D, (float*)(C.p.ws + WS_HS) + m + 1, ln);
        if (t < 8) { x0 = nx0; x1 = nx1; y0 = ny0; y1 = ny1; }
    }
#undef T0B_LD
    __syncthreads();
}
__device__ __forceinline__ void thin1a_generic(const Ctx& C) {
    const int gw = C.vcu * NWAVES + C.wave, NGW = C.G * NWAVES;
    const bf16* Y = (const bf16*)(C.p.ws + WS_YA);
    LAS int* lcnt = (LAS int*)C.lds;
    LAS int* lrec = (LAS int*)(C.lds + 256);
    if (C.tid < 16) lcnt[C.tid] = 0;
    __syncthreads();
    const float* wr = C.p.in[27];
    int* RE = (int*)(C.p.ws + WS_RE); float* RW = (float*)(C.p.ws + WS_RW); int* RJ = (int*)(C.p.ws + WS_RJ);
    int it = 0;
    LAS float* wl = (LAS float*)(C.lds + 16384);
    for (int i = C.tid; i < D * 8 / 4; i += NT) { const int col = i >> 1, hh = i & 1;
        ((LAS f32x4*)wl)[(((col >> 8) * 4 + (col & 3)) * 2 + hh) * 64 + ((col & 255) >> 2)] = ((const f32x4*)wr)[i]; }
    __syncthreads();
    auto route = [&](int m, const float (&lg)[8], int it) {
        int e0 = 0; float v0 = lg[0];
#pragma unroll
        for (int e = 1; e < 8; ++e) if (lg[e] > v0) { v0 = lg[e]; e0 = e; }
        int e1 = (e0 == 0) ? 1 : 0; float v1 = (e0 == 0) ? lg[1] : lg[0];
#pragma unroll
        for (int e = 1; e < 8; ++e) if (e != e0 && e != e1 && lg[e] > v1) { v1 = lg[e]; e1 = e; }
        const float w1v = 1.f / (1.f + __expf(v0 - v1)), w0v = 1.f - w1v;
        if (C.lane == 0) {
            const int s0 = __hip_atomic_fetch_add(&lcnt[e0], 1, __ATOMIC_RELAXED, __HIP_MEMORY_SCOPE_WORKGROUP), s1 = __hip_atomic_fetch_add(&lcnt[e1], 1, __ATOMIC_RELAXED, __HIP_MEMORY_SCOPE_WORKGROUP);
            LAS int* rec = lrec + (C.wave * 64 + (it & 63)) * 4; rec[0] = e0; rec[1] = e1; rec[2] = s0; rec[3] = s1;
            RE[2 * m] = e0; RE[2 * m + 1] = e1; RW[2 * m] = w0v; RW[2 * m + 1] = w1v;
        }
    };
    auto do_pair = [&](int m, Row16& xa, const Row16& ya, Row16& xb, const Row16& yb, const float* md, int it) {
        Row16 ha, hb;
        resid_row(xa, ya, C.p.in[21], md + 2 * D, C.lane); resid_row(xb, yb, C.p.in[21], md + 2 * D, C.lane);
        st_bf(xa, (bf16*)(C.p.ws + WS_X3) + (size_t)m * D, C.lane); st_bf(xb, (bf16*)(C.p.ws + WS_X3) + (size_t)(m + 1) * D, C.lane);
        modulate_row(xa, ha, C.p.in[22], md + 3 * D, md + 4 * D, C.lane); modulate_row(xb, hb, C.p.in[22], md + 3 * D, md + 4 * D, C.lane);
        { unsigned* h8 = (unsigned*)(C.p.ws + WS_H8 + (size_t)m * D) + C.lane;
#pragma unroll
          for (int j = 0; j < 4; ++j) { h8[64 * j] = pk4_fp8(ha.v[j][0], ha.v[j][1], ha.v[j][2], ha.v[j][3]); h8[D / 4 + 64 * j] = pk4_fp8(hb.v[j][0], hb.v[j][1], hb.v[j][2], hb.v[j][3]); } }
        float la[8], lb[8];
#pragma unroll
        for (int e = 0; e < 8; ++e) { la[e] = 0.f; lb[e] = 0.f; }
#pragma unroll
        for (int j = 0; j < 4; ++j)
#pragma unroll
            for (int i = 0; i < 4; ++i) {
                const f32x4 w0 = ((const LAS f32x4*)wl)[((j * 4 + i) * 2 + 0) * 64 + C.lane], w1 = ((const LAS f32x4*)wl)[((j * 4 + i) * 2 + 1) * 64 + C.lane];
                const float va = ha.v[j][i], vb = hb.v[j][i];
                la[0] += va * w0[0]; la[1] += va * w0[1]; la[2] += va * w0[2]; la[3] += va * w0[3]; la[4] += va * w1[0]; la[5] += va * w1[1]; la[6] += va * w1[2]; la[7] += va * w1[3];
                lb[0] += vb * w0[0]; lb[1] += vb * w0[1]; lb[2] += vb * w0[2]; lb[3] += vb * w0[3]; lb[4] += vb * w1[0]; lb[5] += vb * w1[1]; lb[6] += vb * w1[2]; lb[7] += vb * w1[3];
            }
#pragma unroll
        for (int e = 0; e < 8; ++e) { la[e] = wave_sum(la[e]); lb[e] = wave_sum(lb[e]); }
        route(m, la, it); route(m + 1, lb, it + 1);
    };
    Row16 x0, x1, y0, y1, nx0, nx1, ny0, ny1;
#define T1A_LD(a0, a1, b0, b1, mm) do { ld_bf(a0, (const bf16*)C.p.out + (size_t)(mm) * D, C.lane); ld_bf(a1, (const bf16*)C.p.out + (size_t)((mm) + 1) * D, C.lane); \
        ld_bf(b0, Y + (size_t)(mm) * D, C.lane); ld_bf(b1, Y + (size_t)((mm) + 1) * D, C.lane); } while (0)
    if (gw < NLAT / 2) T1A_LD(x0, x1, y0, y1, 2 * gw);
    for (int mp = gw; mp < NLAT / 2; mp += NGW, it += 2) {
        const int m = 2 * mp;
        const float* md = C.mods(1, m / SEQ);
        const bool more = mp + NGW < NLAT / 2;
        if (more) T1A_LD(nx0, nx1, ny0, ny1, 2 * (mp + NGW));
        do_pair(m, x0, y0, x1, y1, md, it);
        if (more) { x0 = nx0; x1 = nx1; y0 = ny0; y1 = ny1; }
    }
#undef T1A_LD
    __syncthreads();
    if (C.tid < 8) lcnt[8 + C.tid] = (int)__hip_atomic_fetch_add(C.ctl() + CW_CNT + C.tid, (unsigned)lcnt[C.tid], __ATOMIC_RELAXED, __HIP_MEMORY_SCOPE_AGENT);
    __syncthreads();
    int* TOKOF = (int*)(C.p.ws + WS_TOKOF);
    it = 0;
    for (int mp = gw; mp < NLAT / 2; mp += NGW)
      for (int q = 0; q < 2; ++q, ++it) { const int m = 2 * mp + q;
        if (C.lane == 0) {
            LAS int* rec = lrec + (C.wave * 64 + (it & 63)) * 4; const int e0 = rec[0], e1 = rec[1];
            const int j0 = lcnt[8 + e0] + rec[2], j1 = lcnt[8 + e1] + rec[3];
            RJ[2 * m] = j0; RJ[2 * m + 1] = j1;
            TOKOF[e0 * NLAT + j0] = m; TOKOF[e1 * NLAT + j1] = m;
        }
    }
}
__device__ __forceinline__ void phase_thin1a(const Ctx& C) {
    if (C.G != 256) { thin1a_generic(C); return; }
    int ln = C.lane; asm volatile("" : "+v"(ln));
    const int gw = C.vcu * NWAVES + C.wave, NGW = C.G * NWAVES;
    const bf16* Y = (const bf16*)(C.p.ws + WS_YA);
    LAS int* lcnt = (LAS int*)C.lds;
    LAS int* lrec = (LAS int*)(C.lds + 256);
    if (C.tid < 16) lcnt[C.tid] = 0;
    __syncthreads();
    const float* wr = C.p.in[27];
    int* RE = (int*)(C.p.ws + WS_RE); float* RW = (float*)(C.p.ws + WS_RW); int* RJ = (int*)(C.p.ws + WS_RJ);
    int it = 0;
    LAS float* wl = (LAS float*)(C.lds + 16384);
    for (int i = C.tid; i < D * 8 / 4; i += NT) { const int col = i >> 1, hh = i & 1;
        ((LAS f32x4*)wl)[(((col >> 8) * 4 + (col & 3)) * 2 + hh) * 64 + ((col & 255) >> 2)] = ((const f32x4*)wr)[i]; }
    constexpr int PB = 16384 + 32768;
    { const float* md = C.mods(1, C.vcu >> 4); stage5(C, 0, C.p.in[21], md + 2 * D, C.p.in[22], md + 3 * D, md + 4 * D, PB); }
    const LAS float* P = (const LAS float*)(C.lds + PB);
    __syncthreads();
    auto route = [&](int m, const float (&lg)[8], int it) {
        int e0 = 0; float v0 = lg[0];
#pragma unroll
        for (int e = 1; e < 8; ++e) if (lg[e] > v0) { v0 = lg[e]; e0 = e; }
        int e1 = (e0 == 0) ? 1 : 0; float v1 = (e0 == 0) ? lg[1] : lg[0];
#pragma unroll
        for (int e = 1; e < 8; ++e) if (e != e0 && e != e1 && lg[e] > v1) { v1 = lg[e]; e1 = e; }
        const float w1v = 1.f / (1.f + __expf(v0 - v1)), w0v = 1.f - w1v;
        if (ln == 0) {
            const int s0 = __hip_atomic_fetch_add(&lcnt[e0], 1, __ATOMIC_RELAXED, __HIP_MEMORY_SCOPE_WORKGROUP), s1 = __hip_atomic_fetch_add(&lcnt[e1], 1, __ATOMIC_RELAXED, __HIP_MEMORY_SCOPE_WORKGROUP);
            LAS int* rec = lrec + (C.wave * 64 + (it & 63)) * 4; rec[0] = e0; rec[1] = e1; rec[2] = s0; rec[3] = s1;
            RE[2 * m] = e0; RE[2 * m + 1] = e1; RW[2 * m] = w0v; RW[2 * m + 1] = w1v;
        }
    };
    auto do_pair = [&](int m, Row16& xa, const Row16& ya, Row16& xb, const Row16& yb, const float* md, int it) {
        Row16 ha, hb;
        resid_row_l(xa, ya, P, P + D, ln); resid_row_l(xb, yb, P, P + D, ln);
        st_bf(xa, (bf16*)(C.p.ws + WS_X3) + (size_t)m * D, ln); st_bf(xb, (bf16*)(C.p.ws + WS_X3) + (size_t)(m + 1) * D, ln);
        modulate_row_l(xa, ha, P + 2 * D, P + 3 * D, P + 4 * D, ln); modulate_row_l(xb, hb, P + 2 * D, P + 3 * D, P + 4 * D, ln);
        { unsigned* h8 = (unsigned*)(C.p.ws + WS_H8 + (size_t)m * D) + ln;
#pragma unroll
          for (int j = 0; j < 4; ++j) { h8[64 * j] = pk4_fp8(ha.v[j][0], ha.v[j][1], ha.v[j][2], ha.v[j][3]); h8[D / 4 + 64 * j] = pk4_fp8(hb.v[j][0], hb.v[j][1], hb.v[j][2], hb.v[j][3]); } }
        float la[8], lb[8];
#pragma unroll
        for (int e = 0; e < 8; ++e) { la[e] = 0.f; lb[e] = 0.f; }
#pragma unroll
        for (int j = 0; j < 4; ++j)
#pragma unroll
            for (int i = 0; i < 4; ++i) {
                const f32x4 w0 = ((const LAS f32x4*)wl)[((j * 4 + i) * 2 + 0) * 64 + ln], w1 = ((const LAS f32x4*)wl)[((j * 4 + i) * 2 + 1) * 64 + ln];
                const float va = ha.v[j][i], vb = hb.v[j][i];
                la[0] += va * w0[0]; la[1] += va * w0[1]; la[2] += va * w0[2]; la[3] += va * w0[3]; la[4] += va * w1[0]; la[5] += va * w1[1]; la[6] += va * w1[2]; la[7] += va * w1[3];
                lb[0] += vb * w0[0]; lb[1] += vb * w0[1]; lb[2] += vb * w0[2]; lb[3] += vb * w0[3]; lb[4] += vb * w1[0]; lb[5] += vb * w1[1]; lb[6] += vb * w1[2]; lb[7] += vb * w1[3];
            }
#pragma unroll
        for (int e = 0; e < 8; ++e) { la[e] = wave_sum(la[e]); lb[e] = wave_sum(lb[e]); }
        route(m, la, it); route(m + 1, lb, it + 1);
    };
    Row16 x0, x1, y0, y1, nx0, nx1, ny0, ny1;
#define T1A_LD(a0, a1, b0, b1, mm) do { ld_bf(a0, (const bf16*)C.p.out + (size_t)(mm) * D, ln); ld_bf(a1, (const bf16*)C.p.out + (size_t)((mm) + 1) * D, ln); \
        ld_bf(b0, Y + (size_t)(mm) * D, ln); ld_bf(b1, Y + (size_t)((mm) + 1) * D, ln); } while (0)
    { const int m0 = thin_row(C, 0); ld_bf(x0, (const bf16*)C.p.out + (size_t)m0 * D, ln); ld_bf(x1, (const bf16*)C.p.out + (size_t)(m0 + 1) * D, ln); }
#pragma nounroll
    for (int t = 0; t < 8; ++t, it += 2) {
        const int m = thin_row(C, t);
        ld_bf(y0, Y + (size_t)m * D, ln); ld_bf(y1, Y + (size_t)(m + 1) * D, ln);
        if (t < 7) { const int mn = thin_row(C, t + 1); ld_bf(nx0, (const bf16*)C.p.out + (size_t)mn * D, ln); ld_bf(nx1, (const bf16*)C.p.out + (size_t)(mn + 1) * D, ln); }
        do_pair(m, x0, y0, x1, y1, nullptr, it);
        if (t < 7) { x0 = nx0; x1 = nx1; }
    }
#undef T1A_LD
    __syncthreads();
    if (C.tid < 8) lcnt[8 + C.tid] = (int)__hip_atomic_fetch_add(C.ctl() + CW_CNT + C.tid, (unsigned)lcnt[C.tid], __ATOMIC_RELAXED, __HIP_MEMORY_SCOPE_AGENT);
    __syncthreads();
    int* TOKOF = (int*)(C.p.ws + WS_TOKOF);
    it = 0;
    for (int t = 0; t < 8; ++t)
      for (int q = 0; q < 2; ++q, ++it) { const int m = thin_row(C, t) + q;
        if (ln == 0) {
            LAS int* rec = lrec + (C.wave * 64 + (it & 63)) * 4; const int e0 = rec[0], e1 = rec[1];
            const int j0 = lcnt[8 + e0] + rec[2], j1 = lcnt[8 + e1] + rec[3];
            RJ[2 * m] = j0; RJ[2 * m + 1] = j1;
            TOKOF[e0 * NLAT + j0] = m; TOKOF[e1 * NLAT + j1] = m;
        }
    }
}
static_assert(FFE / 128 == 28 && D / 256 == 4, "K-split geometry");
constexpr int MOE_PTILE0 = (int)(((long long)WS_W8GU - (long long)WS_YS) / (256LL * D * 2));
static_assert(((long long)WS_W8GU - (long long)WS_YS) % (256LL * D * 2) == 0, "partial rows tile-aligned");
__device__ __forceinline__ void moe_split(const Ctx& C, int nT, int& tmt, int& nl) {
    tmt = ((nT * 4) / C.G) * C.G / 4; nl = nT - tmt;
    if ((C.G & 3) != 0 || nl > 8) { tmt = nT; nl = 0; }
}
__device__ __forceinline__ void phase_final(const Ctx& C) {
    const int gw = C.vcu * NWAVES + C.wave, NGW = C.G * NWAVES;
    TileTab T; load_tiletab(C, T);
    const bf16* YS = (const bf16*)(C.p.ws + WS_YS); const bf16* PART = (const bf16*)(C.p.ws + WS_W8GU);
    int tmt, nl; moe_split(C, T.tb[8], tmt, nl);
    const int* RE = (const int*)(C.p.ws + WS_RE); const float* RW = (const float*)(C.p.ws + WS_RW); const int* RJ = (const int*)(C.p.ws + WS_RJ);
    auto rows_of = [&](int m, size_t& p0, size_t& p1, float& w0, float& w1) {
        const int e0 = RE[2 * m], e1 = RE[2 * m + 1]; w0 = RW[2 * m]; w1 = RW[2 * m + 1];
        int b0 = 0, b1 = 0;
#pragma unroll
        for (int k = 0; k < NE; ++k) { b0 = (k == e0) ? T.tb[k] : b0; b1 = (k == e1) ? T.tb[k] : b1; }
        p0 = (size_t)b0 * 256 + RJ[2 * m]; p1 = (size_t)b1 * 256 + RJ[2 * m + 1]; };
    auto add_parts = [&](Row16& y, size_t p) {
        if ((int)(p >> 8) >= tmt) {
#pragma unroll
            for (int k = 0; k < 3; ++k) { Row16 t; ld_bf(t, PART + ((size_t)(8 * k + (int)(p >> 8) - tmt) * 256 + (p & 255)) * D, C.lane);
#pragma unroll
                for (int j = 0; j < 4; ++j) y.v[j] = y.v[j] + t.v[j]; } } };
    size_t pa0, pa1, pb0, pb1, qa0 = 0, qa1 = 0, qb0 = 0, qb1 = 0; float wa0, wa1, wb0, wb1, va0 = 0.f, va1 = 0.f, vb0 = 0.f, vb1 = 0.f;
    Row16 xa, xb, ya0, ya1, yb0, yb1, nxa, nxb, nya0, nya1, nyb0, nyb1;
#define FIN_LD(m_, P0, P1, Q0, Q1, W0, W1, V0, V1, XA, XB, A0, A1, B0_, B1_) do { rows_of((m_), P0, P1, W0, W1); rows_of((m_) + 1, Q0, Q1, V0, V1); \
        ld_bf(XA, (const bf16*)(C.p.ws + WS_X3) + (size_t)(m_) * D, C.lane); ld_bf(XB, (const bf16*)(C.p.ws + WS_X3) + (size_t)((m_) + 1) * D, C.lane); \
        ld_bf(A0, YS + P0 * D, C.lane); ld_bf(A1, YS + P1 * D, C.lane); ld_bf(B0_, YS + Q0 * D, C.lane); ld_bf(B1_, YS + Q1 * D, C.lane); } while (0)
    if (gw < NLAT / 2) FIN_LD(2 * gw, pa0, pa1, pb0, pb1, wa0, wa1, wb0, wb1, xa, xb, ya0, ya1, yb0, yb1);
    for (int mp = gw; mp < NLAT / 2; mp += NGW) {
        const int m = 2 * mp;
        const float* md = C.mods(1, m / SEQ);
        const bool more = mp + NGW < NLAT / 2;
        if (more) FIN_LD(2 * (mp + NGW), qa0, qa1, qb0, qb1, va0, va1, vb0, vb1, nxa, nxb, nya0, nya1, nyb0, nyb1);
        add_parts(ya0, pa0); add_parts(ya1, pa1); add_parts(yb0, pb0); add_parts(yb1, pb1);
#pragma unroll
        for (int j = 0; j < 4; ++j) { ya0.v[j] = ya0.v[j] * wa0 + ya1.v[j] * wa1; yb0.v[j] = yb0.v[j] * wb0 + yb1.v[j] * wb1; }
        resid_row(xa, ya0, C.p.in[23], md + 5 * D, C.lane);
        resid_row(xb, yb0, C.p.in[23], md + 5 * D, C.lane);
        st_f32(xa, C.p.out + (size_t)m * D, C.lane); st_f32(xb, C.p.out + (size_t)(m + 1) * D, C.lane);
        if (more) { pa0 = qa0; pa1 = qa1; pb0 = qb0; pb1 = qb1; wa0 = va0; wa1 = va1; wb0 = vb0; wb1 = vb1; xa = nxa; xb = nxb; ya0 = nya0; ya1 = nya1; yb0 = nyb0; yb1 = nyb1; }
    }
#undef FIN_LD
}

namespace pg8 {
typedef short bf16x8 __attribute__((ext_vector_type(8)));
typedef int i32x4 __attribute__((ext_vector_type(4)));
typedef int i32x8 __attribute__((ext_vector_type(8)));
constexpr int BM = 256, BK = 64, HALF = 128, HTB = HALF * BK * 2, STAGE_BYTES = 8 * HTB, NXCD = 8, WGM = 8;
#ifndef PG8_ROWMAJOR
#define PG8_ROWMAJOR 1
#endif
#if PG8_ROWMAJOR
__host__ __device__ __forceinline__ int lds_byte(int r, int c) { return r * 128 + ((((c >> 3) ^ (r & 7)) & 7) << 4) + (c & 7) * 2; }
__host__ __device__ __forceinline__ void stage_rc(int b, int& R, int& C) { R = b >> 7; C = ((((b >> 4) & 7) ^ (R & 7)) << 3) + ((b & 15) >> 1); }
#define PG8_HI(off) ((off) ^ 64)
#else
__host__ __device__ __forceinline__ int lds_byte(int r, int c) { const int st = (r >> 4) * 2 + (c >> 5), rr = r & 15, cc = c & 31, ob = rr * 64 + cc * 2; return st * 1024 + (ob ^ (((ob >> 9) & 1) << 5)); }
__host__ __device__ __forceinline__ void stage_rc(int b, int& R, int& C) { const int st = b / 1024, sb = b % 1024, swz = sb ^ (((sb >> 9) & 1) << 5); R = (st >> 1) * 16 + swz / 64; C = (st & 1) * 32 + (swz % 64) / 2; }
#define PG8_HI(off) ((off) + 1024)
#endif
__host__ __device__ __forceinline__ int perm32(int rho) { const int n = rho >> 4, i = rho & 15; return 8 * (i >> 2) + 4 * n + (i & 3); }
struct Unit { int pm, pn, xa, xb, koff, nkt; };
struct Gemm { const bf16* A; const bf16* Bt; int K; };
__device__ __forceinline__ unsigned cvt_pk_bf16(float lo, float hi) { unsigned r; asm volatile("v_cvt_pk_bf16_f32 %0, %1, %2" : "=v"(r) : "v"(lo), "v"(hi)); return r; }
__device__ __forceinline__ void static_map(int L, int nM, int nN, int& pm, int& pn) {
    const int nwg = nM * nN; int wgid = L; { const int q = nwg / NXCD, r = nwg % NXCD, xcd = wgid % NXCD, off = wgid / NXCD; wgid = (xcd < r ? xcd * (q + 1) : r * (q + 1) + (xcd - r) * q) + off; }
    const int nig = WGM * nN, gid = wgid / nig, fm = gid * WGM, gsz = (nM - fm) < WGM ? (nM - fm) : WGM;
    pm = fm + ((wgid % nig) % gsz); pn = (wgid % nig) / gsz;
}
template <class Epi, class Sched, bool ALIGN_EPI, int MODE = 0>
__device__ __forceinline__ void gemm_phase(LAS unsigned char* lds, const Gemm g, const Sched& S, const Epi& E) {
    const int tid = threadIdx.x, wid = __builtin_amdgcn_readfirstlane(tid >> 6), lane = tid & 63, wr = wid >> 2, wc = wid & 3, fr = lane & 15, fq = lane >> 4;
    constexpr bool F8 = MODE == 1, I8 = MODE == 2;
    constexpr int EB = (F8 || I8) ? 1 : 2;
    const int K = g.K, nt = K * EB / (BK * 2);
    unsigned voffB[2], cA2[2]; int RA[2];
#pragma unroll
    for (int i = 0; i < 2; ++i) { int R, C; stage_rc(tid * 16 + i * 8192, R, C); const int Rb = (R & ~31) + perm32(R & 31);
        RA[i] = R; cA2[i] = (unsigned)C * 2u; voffB[i] = (unsigned)(Rb * K * EB + C * 2); }
    const unsigned voffB0 = voffB[0];
    const size_t kstep = (size_t)(BK * 2);
    const size_t hstep = (size_t)HALF * K * EB;
    const size_t tstep = 2 * hstep;
    const unsigned ldsw = (unsigned)wid * 1024u;
    const int aoff = lds_byte(wr * 64 + fr, fq * 8), boff = lds_byte(wc * 32 + fr, fq * 8), aoffh = PG8_HI(aoff), boffh = PG8_HI(boff);
#define PG8_SA(b, h) (((b) * 2 + (h)) * HTB)
#define PG8_SB(b, h) ((4 + (b) * 2 + (h)) * HTB)
#define PG8_STAGE(bufoff, gbase, voff) do { _Pragma("unroll") for (int _i = 0; _i < 2; ++_i) \
        __builtin_amdgcn_global_load_lds((const unsigned*)((const char*)(gbase) + (voff)[_i]), (LAS unsigned*)(lds + (bufoff) + ldsw + _i * 8192), 16, 0, 0); } while (0)
#define PG8_STAGEB(bufoff, gbase) do { _Pragma("unroll") for (int _i = 0; _i < 2; ++_i) \
        __builtin_amdgcn_global_load_lds((const unsigned*)((const char*)(gbase) + (size_t)_i * 64 * K * EB + voffB0), (LAS unsigned*)(lds + (bufoff) + ldsw + _i * 8192), 16, 0, 0); } while (0)
#define PG8_LDA(dst, b, h) do { _Pragma("unroll") for (int m = 0; m < 4; ++m) { dst[m].lo = *(const LAS i32x4*)(lds + PG8_SA(b, h) + aoff + m * 2048); dst[m].hi = *(const LAS i32x4*)(lds + PG8_SA(b, h) + aoffh + m * 2048); } } while (0)
#define PG8_LDB(dst, b, h) do { _Pragma("unroll") for (int n = 0; n < 2; ++n) { dst[n].lo = *(const LAS i32x4*)(lds + PG8_SB(b, h) + boff + n * 2048); dst[n].hi = *(const LAS i32x4*)(lds + PG8_SB(b, h) + boffh + n * 2048); } } while (0)
#define PG8_H(x, k) __builtin_bit_cast(bf16x8, (k) == 0 ? (x).lo : (x).hi)
#define PG8_MMA(ai, bj, At, Bt) do { __builtin_amdgcn_s_setprio(1); \
        if constexpr (F8) { _Pragma("unroll") for (int m = 0; m < 4; ++m) _Pragma("unroll") for (int n = 0; n < 2; ++n) \
            asm volatile("v_mfma_scale_f32_16x16x128_f8f6f4 %0, %1, %2, %0, %3, %3 op_sel_hi:[0,0,0]" : "+v"(acc[ai][bj][m][n]) : "v"(Bt[n]), "v"(At[m]), "v"(sc127)); } \
        else if constexpr (I8) { _Pragma("unroll") for (int m = 0; m < 4; ++m) _Pragma("unroll") for (int n = 0; n < 2; ++n) _Pragma("unroll") for (int k = 0; k < 2; ++k) \
            acc[ai][bj][m][n] = __builtin_bit_cast(f32x4, __builtin_amdgcn_mfma_i32_16x16x64_i8((k) == 0 ? Bt[n].lo : Bt[n].hi, (k) == 0 ? At[m].lo : At[m].hi, __builtin_bit_cast(i32x4, acc[ai][bj][m][n]), 0, 0, 0)); } \
        else { _Pragma("unroll") for (int m = 0; m < 4; ++m) _Pragma("unroll") for (int n = 0; n < 2; ++n) _Pragma("unroll") for (int k = 0; k < 2; ++k) \
            acc[ai][bj][m][n] = __builtin_amdgcn_mfma_f32_16x16x32_bf16(PG8_H(Bt[n], k), PG8_H(At[m], k), acc[ai][bj][m][n], 0, 0, 0); } \
        __builtin_amdgcn_s_setprio(0); } while (0)
#define PG8_WAIT_V(n) asm volatile("s_waitcnt vmcnt(" #n ")" ::: "memory")
#define PG8_WAIT_L(n) asm volatile("s_waitcnt lgkmcnt(" #n ")" ::: "memory")
#define PG8_BAR __builtin_amdgcn_s_barrier()
#define PG8_SCHED __builtin_amdgcn_sched_barrier(0)
#define PG8_AOFFS(dst, u) do { _Pragma("unroll") for (int _h = 0; _h < 2; ++_h) _Pragma("unroll") for (int _i = 0; _i < 2; ++_i) dst[_h][_i] = S.a_off(u, _h * HALF + RA[_i]) + cA2[_i]; } while (0)
    Unit cur, nxt; int ui = 0;
    if (!S.next(0, cur)) return;
#define PG8_TOKDMA(u) do { _Pragma("unroll") for (int _h = 0; _h < 2; ++_h) _Pragma("unroll") for (int _i = 0; _i < 2; ++_i) \
        __builtin_amdgcn_global_load_lds((const unsigned*)S.a_tokp(u, _h * HALF + RA[_i]), (LAS unsigned*)(lds + TOK_OFF + (wid * 4 + _h * 2 + _i) * 256), 4, 0, 0); } while (0)
    if constexpr (Sched::GATHER) { Unit u1; if (S.next(1, u1)) PG8_TOKDMA(u1); }
    f32x4 acc[2][2][4][2];
#pragma unroll
    for (int a = 0; a < 2; ++a)
#pragma unroll
        for (int b = 0; b < 2; ++b)
#pragma unroll
            for (int m = 0; m < 4; ++m)
#pragma unroll
                for (int n = 0; n < 2; ++n) acc[a][b][m][n] = (f32x4){0.f, 0.f, 0.f, 0.f};
    const int sc127 = 0x7f7f7f7f;
    i32x8 At[4], B0[2], B1[2];
    const char* pA = (const char*)g.A;
    unsigned oA[2][2], nO[2][2];
    PG8_AOFFS(oA, cur);
    constexpr bool KS = Sched::KSPLIT;
    const char* cA = KS ? pA + (size_t)cur.koff * kstep : pA;
    const char* cB = (const char*)g.Bt + (size_t)cur.pn * tstep + (KS ? (size_t)cur.koff * kstep : 0);
    int ntc = KS ? cur.nkt : nt;
    PG8_STAGEB(PG8_SB(0, 0), cB); PG8_STAGEB(PG8_SB(0, 1), cB + hstep); PG8_STAGE(PG8_SA(0, 0), cA, oA[0]); PG8_STAGE(PG8_SA(0, 1), cA, oA[1]);
    if (wr == 1) PG8_BAR;
    PG8_WAIT_V(2); PG8_BAR;
    PG8_STAGEB(PG8_SB(1, 0), cB + kstep); PG8_STAGE(PG8_SA(1, 0), cA + kstep, oA[0]); PG8_STAGEB(PG8_SB(1, 1), cB + hstep + kstep);
    PG8_WAIT_V(6); PG8_BAR;
    for (;;) {
        const bool has_next = S.next(ui + 1, nxt);
        if (has_next) { if constexpr (!Sched::GATHER) PG8_AOFFS(nO, nxt); } else {
#pragma unroll
            for (int h = 0; h < 2; ++h)
#pragma unroll
                for (int i = 0; i < 2; ++i) nO[h][i] = oA[h][i]; }
        const char* nB = has_next ? (const char*)g.Bt + (size_t)nxt.pn * tstep + (KS ? (size_t)nxt.koff * kstep : 0) : cB;
        const char* nA = (KS && has_next) ? pA + (size_t)nxt.koff * kstep : cA;
#pragma nounroll
        for (int t = 0; t < ntc; t += 2) {
            const bool last = (t == ntc - 2);
            if constexpr (Sched::GATHER) { if (last && has_next) {
#pragma unroll
                for (int h = 0; h < 2; ++h)
#pragma unroll
                    for (int i = 0; i < 2; ++i) nO[h][i] = *(const LAS unsigned*)(lds + TOK_OFF + (wid * 4 + h * 2 + i) * 256 + lane * 4) * S.rowbytes + cA2[i]; } }
            const char* a1 = cA + (size_t)(t + 1) * kstep;
            const char* a2 = last ? nA : cA + (size_t)(t + 2) * kstep; const char* b2 = last ? nB : cB + (size_t)(t + 2) * kstep;
            const char* a3 = a2 + kstep; const char* b3 = b2 + kstep;
#define PG8_STAGE_A2(bufoff, gbase, h) do { if constexpr (Sched::GATHER) { if (last) { PG8_STAGE(bufoff, gbase, nO[h]); } else { PG8_STAGE(bufoff, gbase, oA[h]); } } \
                else { unsigned o2_[2]; o2_[0] = last ? nO[h][0] : oA[h][0]; o2_[1] = last ? nO[h][1] : oA[h][1]; PG8_STAGE(bufoff, gbase, o2_); } } while (0)
            PG8_LDB(B0, 0, 0); PG8_LDB(B1, 0, 1); PG8_SCHED; PG8_LDA(At, 0, 0); PG8_STAGE(PG8_SA(1, 1), a1, oA[1]);
            PG8_WAIT_V(8); PG8_WAIT_L(0); PG8_BAR; PG8_MMA(0, 0, At, B0); PG8_MMA(0, 1, At, B1); PG8_BAR; PG8_SCHED;
            PG8_LDA(At, 0, 1); PG8_STAGEB(PG8_SB(0, 0), b2); PG8_STAGEB(PG8_SB(0, 1), b2 + hstep); PG8_STAGE_A2(PG8_SA(0, 0), a2, 0);
            PG8_WAIT_V(8); PG8_WAIT_L(0); PG8_BAR; PG8_MMA(1, 0, At, B0); PG8_MMA(1, 1, At, B1); PG8_BAR; PG8_SCHED;
            PG8_LDB(B0, 1, 0); PG8_LDB(B1, 1, 1); PG8_SCHED; PG8_LDA(At, 1, 0); PG8_STAGE_A2(PG8_SA(0, 1), a2, 1);
            PG8_WAIT_V(8); PG8_WAIT_L(0); PG8_BAR; PG8_MMA(0, 0, At, B0); PG8_MMA(0, 1, At, B1); PG8_BAR; PG8_SCHED;
            PG8_LDA(At, 1, 1); PG8_STAGEB(PG8_SB(1, 0), b3); PG8_STAGEB(PG8_SB(1, 1), b3 + hstep); PG8_STAGE_A2(PG8_SA(1, 0), a3, 0);
            PG8_WAIT_V(8); PG8_WAIT_L(0); PG8_BAR; PG8_MMA(1, 0, At, B0); PG8_MMA(1, 1, At, B1); PG8_BAR; PG8_SCHED;
#undef PG8_STAGE_A2
        }
        if constexpr (Sched::GATHER) { Unit u2; if (S.next(ui + 2, u2)) PG8_TOKDMA(u2); }
        if constexpr (ALIGN_EPI) { if (wr == 0) PG8_BAR; }
        asm volatile("s_nop 15\n\ts_nop 15" ::: "memory");
        E(acc, cur, wr, wc, fr, fq);
        if (!has_next) break;
#pragma unroll
        for (int a = 0; a < 2; ++a)
#pragma unroll
            for (int b = 0; b < 2; ++b)
#pragma unroll
                for (int m = 0; m < 4; ++m)
#pragma unroll
                    for (int n = 0; n < 2; ++n) acc[a][b][m][n] = (f32x4){0.f, 0.f, 0.f, 0.f};
        cur = nxt; cB = nB; cA = nA; if constexpr (KS) ntc = nxt.nkt; ++ui;
#pragma unroll
        for (int h = 0; h < 2; ++h)
#pragma unroll
            for (int i = 0; i < 2; ++i) oA[h][i] = nO[h][i];
        if constexpr (ALIGN_EPI) { if (wr == 1) PG8_BAR; }
    }
    PG8_WAIT_V(0);
    if constexpr (!ALIGN_EPI) { if (wr == 0) PG8_BAR; }
    PG8_BAR;
#undef PG8_SA
#undef PG8_SB
#undef PG8_STAGE
#undef PG8_STAGEB
#undef PG8_LDA
#undef PG8_LDB
#undef PG8_MMA
#undef PG8_H
#undef PG8_WAIT_V
#undef PG8_WAIT_L
#undef PG8_BAR
#undef PG8_SCHED
#undef PG8_AOFFS
#undef PG8_TOKDMA
}

struct EpiStore {
    bf16* O; int ldc; float qscale; int qtiles;
    __device__ __forceinline__ void operator()(f32x4 (&acc)[2][2][4][2], const Unit& u, int wr, int wc, int fr, int fq) const {
        const int row0 = u.xa * BM + wr * 64 + fr, col0 = u.xb * BM + wc * 32 + 8 * fq;
        const float sc = (u.xb < qtiles) ? qscale : 1.f;
#pragma unroll
        for (int ai = 0; ai < 2; ++ai)
#pragma unroll
            for (int m = 0; m < 4; ++m) { bf16* rowp = O + (long long)(row0 + ai * HALF + m * 16) * ldc + col0;
#pragma unroll
                for (int bj = 0; bj < 2; ++bj) { const f32x4 v0 = acc[ai][bj][m][0] * sc, v1 = acc[ai][bj][m][1] * sc;
                    u32x4 w; w.x = cvt_pk_bf16(v0[0], v0[1]); w.y = cvt_pk_bf16(v0[2], v0[3]); w.z = cvt_pk_bf16(v1[0], v1[1]); w.w = cvt_pk_bf16(v1[2], v1[3]);
                    *(u32x4*)(rowp + bj * HALF) = w; } }
    }
};
__device__ __forceinline__ float silu_fast(float g) { return g * __builtin_amdgcn_rcpf(1.f + __builtin_amdgcn_exp2f(-g * LOG2E)); }
struct EpiSwigluF {
    bf16* O; int ldc;
    __device__ __forceinline__ void operator()(f32x4 (&acc)[2][2][4][2], const Unit& u, int wr, int wc, int fr, int fq) const {
        const int row0 = u.xa * BM + wr * 64 + fr, col0 = u.xb * HALF + wc * 32 + 8 * fq;
#pragma unroll
        for (int ai = 0; ai < 2; ++ai)
#pragma unroll
            for (int m = 0; m < 4; ++m) { bf16* rowp = O + (size_t)(row0 + ai * HALF + m * 16) * ldc + col0;
                const f32x4 g0 = acc[ai][0][m][0], g1 = acc[ai][0][m][1], u0 = acc[ai][1][m][0], u1 = acc[ai][1][m][1];
                u32x4 w; w.x = cvt_pk_bf16(silu_fast(g0[0]) * u0[0], silu_fast(g0[1]) * u0[1]); w.y = cvt_pk_bf16(silu_fast(g0[2]) * u0[2], silu_fast(g0[3]) * u0[3]);
                w.z = cvt_pk_bf16(silu_fast(g1[0]) * u1[0], silu_fast(g1[1]) * u1[1]); w.w = cvt_pk_bf16(silu_fast(g1[2]) * u1[2], silu_fast(g1[3]) * u1[3]);
                *(u32x4*)rowp = w; }
    }
};
#ifndef EPI_PK
#define EPI_PK 1
#endif
#if EPI_PK
__device__ __forceinline__ float mul1(float a, float b) { return a * b; }
#else
__device__ __forceinline__ float mul1(float a, float b) { float r; asm("v_mul_f32_e32 %0, %1, %2" : "=v"(r) : "v"(a), "v"(b)); return r; }
#endif
__device__ __forceinline__ f32x4 mul4(const f32x4 a, float b) { return (f32x4){mul1(a[0], b), mul1(a[1], b), mul1(a[2], b), mul1(a[3], b)}; }
#if EPI_PK
__device__ __forceinline__ float mul1s(float a, float b) { return a * b; }
#else
__device__ __forceinline__ float mul1s(float a, float b) { float r; asm("v_mul_f32_e32 %0, %2, %1" : "=v"(r) : "v"(a), "s"(b)); return r; }
#endif
__device__ __forceinline__ f32x4 mul4s(const f32x4 a, float b) { return (f32x4){mul1s(a[0], b), mul1s(a[1], b), mul1s(a[2], b), mul1s(a[3], b)}; }
__device__ __forceinline__ f32x4 mul4(const f32x4 a, const f32x4 b) { return (f32x4){mul1(a[0], b[0]), mul1(a[1], b[1]), mul1(a[2], b[2]), mul1(a[3], b[3])}; }
#if EPI_PK
__device__ __forceinline__ f32x4 swiglu4(const f32x4 g, const f32x4 a, const f32x4 uk) {
    f32x4 e; e[0] = __builtin_amdgcn_exp2f(a[0]); e[1] = __builtin_amdgcn_exp2f(a[1]); e[2] = __builtin_amdgcn_exp2f(a[2]); e[3] = __builtin_amdgcn_exp2f(a[3]);
    const f32x4 d = e + 1.f;
    f32x4 sg; sg[0] = __builtin_amdgcn_rcpf(d[0]); sg[1] = __builtin_amdgcn_rcpf(d[1]); sg[2] = __builtin_amdgcn_rcpf(d[2]); sg[3] = __builtin_amdgcn_rcpf(d[3]);
    return (g * sg) * uk;
}
#else
__device__ __forceinline__ f32x4 swiglu4(const f32x4 g, const f32x4 a, const f32x4 uk) {
    float o0 = a[0], o1 = a[1], o2 = a[2], o3 = a[3];
    asm("v_exp_f32_e32 %0, %0\n\tv_exp_f32_e32 %1, %1\n\tv_exp_f32_e32 %2, %2\n\tv_exp_f32_e32 %3, %3\n\t"
        "v_add_f32_e32 %0, 1.0, %0\n\tv_add_f32_e32 %1, 1.0, %1\n\tv_add_f32_e32 %2, 1.0, %2\n\tv_add_f32_e32 %3, 1.0, %3\n\t"
        "v_rcp_f32_e32 %0, %0\n\tv_rcp_f32_e32 %1, %1\n\tv_rcp_f32_e32 %2, %2\n\tv_rcp_f32_e32 %3, %3\n\t"
        "v_mul_f32_e32 %0, %0, %4\n\tv_mul_f32_e32 %1, %1, %5\n\tv_mul_f32_e32 %2, %2, %6\n\tv_mul_f32_e32 %3, %3, %7\n\t"
        "v_mul_f32_e32 %0, %0, %8\n\tv_mul_f32_e32 %1, %1, %9\n\tv_mul_f32_e32 %2, %2, %10\n\tv_mul_f32_e32 %3, %3, %11"
        : "+v"(o0), "+v"(o1), "+v"(o2), "+v"(o3)
        : "v"(g[0]), "v"(g[1]), "v"(g[2]), "v"(g[3]), "v"(uk[0]), "v"(uk[1]), "v"(uk[2]), "v"(uk[3]));
    return (f32x4){o0, o1, o2, o3};
}
#endif
__device__ __forceinline__ unsigned pk4_fp8c(const f32x4 v) { return pk4_fp8(__builtin_amdgcn_fmed3f(v[0], -448.f, 448.f), __builtin_amdgcn_fmed3f(v[1], -448.f, 448.f), __builtin_amdgcn_fmed3f(v[2], -448.f, 448.f), __builtin_amdgcn_fmed3f(v[3], -448.f, 448.f)); }
struct EpiSwiglu8 {
    unsigned char* O; int ldc; float insc, outsc;
    __device__ __forceinline__ void operator()(f32x4 (&acc)[2][2][4][2], const Unit& u, int wr, int wc, int fr, int fq) const {
        const int row0 = u.xa * BM + wr * 64 + fr, col0 = u.xb * HALF + wc * 32 + 8 * fq;
        const float k1 = -insc * LOG2E, k2 = insc * insc * outsc;
#pragma unroll
        for (int ai = 0; ai < 2; ++ai)
#pragma unroll
            for (int m = 0; m < 4; ++m) { unsigned char* rowp = O + (size_t)(row0 + ai * HALF + m * 16) * ldc + col0;
                const f32x4 g0 = acc[ai][0][m][0], g1 = acc[ai][0][m][1], u0 = acc[ai][1][m][0], u1 = acc[ai][1][m][1];
                u32x2 w; w.x = pk4_fp8c(swiglu4(g0, mul4s(g0, k1), mul4s(u0, k2))); w.y = pk4_fp8c(swiglu4(g1, mul4s(g1, k1), mul4s(u1, k2)));
                *(u32x2*)rowp = w; }
    }
};
struct EpiDeqSwiglu8 {
    unsigned char* O; int ldc; float outsc; const float* rs; const unsigned* cm;
    __device__ __forceinline__ void operator()(f32x4 (&acc)[2][2][4][2], const Unit& u, int wr, int wc, int fr, int fq) const {
        const int row0 = u.pm * BM + wr * 64 + fr, colb = u.pn * BM + wc * 32 + 8 * fq;
        f32x4 cg[2], cu[2];
#pragma unroll
        for (int n = 0; n < 2; ++n) { const u32x4 a = *(const u32x4*)(cm + colb + 4 * n), b = *(const u32x4*)(cm + colb + HALF + 4 * n);
            cg[n] = mul4s((f32x4){__uint_as_float(a.x), __uint_as_float(a.y), __uint_as_float(a.z), __uint_as_float(a.w)}, 1.f / 127.f);
            cu[n] = mul4s((f32x4){__uint_as_float(b.x), __uint_as_float(b.y), __uint_as_float(b.z), __uint_as_float(b.w)}, outsc / 127.f); }
        float r[2][4];
#pragma unroll
        for (int ai = 0; ai < 2; ++ai)
#pragma unroll
            for (int m = 0; m < 4; ++m) r[ai][m] = rs[row0 + ai * HALF + m * 16];
#pragma unroll
        for (int ai = 0; ai < 2; ++ai)
#pragma unroll
            for (int m = 0; m < 4; ++m) { unsigned char* rowp = O + (size_t)(u.xa * BM + wr * 64 + fr + ai * HALF + m * 16) * ldc + u.xb * HALF + wc * 32 + 8 * fq;
                const float rl = mul1(r[ai][m], -LOG2E), r2 = mul1(r[ai][m], r[ai][m]);
                u32x2 w;
#pragma unroll
                for (int n = 0; n < 2; ++n) { const i32x4 ga = __builtin_bit_cast(i32x4, acc[ai][0][m][n]), ua = __builtin_bit_cast(i32x4, acc[ai][1][m][n]);
                    const f32x4 t0 = mul4((f32x4){(float)ga[0], (float)ga[1], (float)ga[2], (float)ga[3]}, cg[n]);
                    const f32x4 uk = mul4(mul4((f32x4){(float)ua[0], (float)ua[1], (float)ua[2], (float)ua[3]}, cu[n]), r2);
                    const unsigned p = pk4_fp8c(swiglu4(t0, mul4(t0, rl), uk));
                    if (n == 0) w.x = p; else w.y = p; }
                *(u32x2*)rowp = w; }
    }
};
struct EpiQkv0 {
    bf16* O; const float* gq; const float* gk; const LAS f32x2* rope;
    __device__ __forceinline__ void operator()(f32x4 (&acc)[2][2][4][2], const Unit& u, int wr, int wc, int fr, int fq) const {
        const int s = 4 * u.xb + wc;
        const bool isv = (s == 10 || s == 11 || s == 22 || s == 23), isq = (s < 8) || (s >= 12 && s < 20), norm = s < 10, lat = u.xa < NLAT / 256;
        const float* g = (s < 8) ? gq : gk;
        f32x4 gv[2][2];
#pragma unroll
        for (int bj = 0; bj < 2; ++bj)
#pragma unroll
            for (int n = 0; n < 2; ++n) gv[bj][n] = norm ? *(const f32x4*)(g + 32 * bj + 8 * fq + 4 * n) : (f32x4){1.f, 1.f, 1.f, 1.f};
        const int row0 = u.xa * BM + wr * 64 + fr;
#pragma unroll
        for (int ai = 0; ai < 2; ++ai)
#pragma unroll
            for (int m = 0; m < 4; ++m) {
                const int row = row0 + ai * HALF + m * 16;
                f32x4 v[2][2];
#pragma unroll
                for (int bj = 0; bj < 2; ++bj)
#pragma unroll
                    for (int n = 0; n < 2; ++n) v[bj][n] = acc[ai][bj][m][n];
                if (norm) {
                    float ss = 0.f;
#pragma unroll
                    for (int bj = 0; bj < 2; ++bj)
#pragma unroll
                        for (int n = 0; n < 2; ++n) ss += (v[bj][n][0] * v[bj][n][0] + v[bj][n][1] * v[bj][n][1]) + (v[bj][n][2] * v[bj][n][2] + v[bj][n][3] * v[bj][n][3]);
                    ss += __shfl_xor(ss, 16); ss += __shfl_xor(ss, 32);
                    const float rs = rsqrtf(ss * (1.f / 64.f) + EPS);
#pragma unroll
                    for (int bj = 0; bj < 2; ++bj)
#pragma unroll
                        for (int n = 0; n < 2; ++n) v[bj][n] = v[bj][n] * rs * gv[bj][n];
                }
                if (lat && !isv) {
                    const int t = row & (SEQ - 1);
#pragma unroll
                    for (int bj = 0; bj < 2; ++bj) { const int pos = (bj == 0) ? (t >> 6) : (t & 63);
#pragma unroll
                        for (int n = 0; n < 2; ++n) { const f32x2 c0 = rope[pos * 17 + 4 * fq + 2 * n], c1 = rope[pos * 17 + 4 * fq + 2 * n + 1];
                            const float a0 = v[bj][n][0], a1 = v[bj][n][1], a2 = v[bj][n][2], a3 = v[bj][n][3];
                            v[bj][n][0] = a0 * c0.x - a1 * c0.y; v[bj][n][1] = a0 * c0.y + a1 * c0.x; v[bj][n][2] = a2 * c1.x - a3 * c1.y; v[bj][n][3] = a2 * c1.y + a3 * c1.x; } }
                }
                const float sc = isq ? QSCALE : 1.f;
                bf16* rowp = O + (size_t)row * NQKV0 + s * 64 + 8 * fq;
#pragma unroll
                for (int bj = 0; bj < 2; ++bj) { const f32x4 v0 = v[bj][0] * sc, v1 = v[bj][1] * sc;
                    u32x4 w; w.x = cvt_pk_bf16(v0[0], v0[1]); w.y = cvt_pk_bf16(v0[2], v0[3]); w.z = cvt_pk_bf16(v1[0], v1[1]); w.w = cvt_pk_bf16(v1[2], v1[3]);
                    *(u32x4*)(rowp + 32 * bj) = w; }
            }
    }
};
template <class Inner> struct EpiDeq {
    Inner in; const float* rs; const unsigned* cm;
    __device__ __forceinline__ void operator()(f32x4 (&acc)[2][2][4][2], const Unit& u, int wr, int wc, int fr, int fq) const {
        const int row0 = u.pm * BM + wr * 64 + fr, col0 = u.pn * BM + wc * 32 + 8 * fq;
        f32x4 cv[2][2];
#pragma unroll
        for (int bj = 0; bj < 2; ++bj)
#pragma unroll
            for (int n = 0; n < 2; ++n) { const u32x4 w = *(const u32x4*)(cm + col0 + bj * HALF + 4 * n);
                cv[bj][n] = (f32x4){__uint_as_float(w.x), __uint_as_float(w.y), __uint_as_float(w.z), __uint_as_float(w.w)} * (1.f / 127.f); }
#pragma unroll
        for (int ai = 0; ai < 2; ++ai)
#pragma unroll
            for (int m = 0; m < 4; ++m) { const float r = rs[row0 + ai * HALF + m * 16];
#pragma unroll
                for (int bj = 0; bj < 2; ++bj)
#pragma unroll
                    for (int n = 0; n < 2; ++n) { const i32x4 a = __builtin_bit_cast(i32x4, acc[ai][bj][m][n]);
                        acc[ai][bj][m][n] = (f32x4){(float)a[0], (float)a[1], (float)a[2], (float)a[3]} * r * cv[bj][n]; } }
        in(acc, u, wr, wc, fr, fq);
    }
};
struct SchedStatic {
    static constexpr bool GATHER = false, KSPLIT = false;
    int nM, nN, G, c; unsigned rowbytes;
    __device__ __forceinline__ bool next(int i, Unit& u) const { const long L = (long)i * G + c; if (L >= (long)nM * nN) return false; static_map((int)L, nM, nN, u.pm, u.pn); u.xa = u.pm; u.xb = u.pn; u.koff = 0; u.nkt = 0; return true; }
    __device__ __forceinline__ unsigned a_off(const Unit& u, int r) const { return (unsigned)(u.pm * BM + r) * rowbytes; }
};
struct SchedIn1 {
    static constexpr bool GATHER = false, KSPLIT = false;
    int G, c;
    __device__ __forceinline__ bool next(int i, Unit& u) const { const long L = (long)i * G + c; if (L >= 1536 + 128) return false;
        if (L < 1536) static_map((int)L, 128, 12, u.pm, u.pn); else { const int l2 = (int)L - 1536; u.pm = 128 + (l2 & 15); u.pn = 4 + (l2 >> 4); }
        u.xa = u.pm; u.xb = u.pn; u.koff = 0; u.nkt = 0; return true; }
    __device__ __forceinline__ unsigned a_off(const Unit& u, int r) const { return (unsigned)(u.pm * BM + r) * (unsigned)D; }
};
}
template <bool GATHER_> struct SchedMoeT {
    static constexpr bool GATHER = GATHER_, gather = GATHER_, KSPLIT = !GATHER_;
    TileTab T; int t0, nT, nN, G, c; const int* tokof; unsigned rowbytes;
    int um, tmt, nl, ptile0;
    __device__ __forceinline__ bool next(int i, pg8::Unit& u) const { const long L = (long)i * G + c;
        int lt, pn, kp = 0; u.koff = 0; u.nkt = 28;
        if (!KSPLIT || L < um) { if (L >= (KSPLIT ? (long)um : (long)nT * nN)) return false; pg8::static_map((int)L, KSPLIT ? tmt : nT, nN, lt, pn); }
        else { const int sx = (int)(L - um); if (sx >= nl * 16) return false; lt = tmt + (sx >> 4); pn = (sx >> 2) & 3; kp = sx & 3; u.koff = (kp < 2) ? 8 * kp : 16 + 6 * (kp - 2); u.nkt = (kp < 2) ? 8 : 6; }
        const int e = tile_expert(T, t0 + lt);
        int tbe = 0;
#pragma unroll
        for (int k = 0; k < NE; ++k) tbe = (k == e) ? T.tb[k] : tbe;
        u.pm = gather ? (t0 + lt - tbe) * 256 : lt; u.pn = e * nN + pn; u.xa = gather ? lt : (kp == 0 ? t0 + lt : ptile0 + 8 * (kp - 1) + (lt - tmt)); u.xb = pn; return true; }
    __device__ __forceinline__ unsigned a_off(const pg8::Unit& u, int r) const {
        if (gather) { const int e = u.pn / nN, j = u.pm + r; int ce = 0;
#pragma unroll
            for (int k = 0; k < NE; ++k) ce = (k == e) ? T.cnt[k] : ce;
            const int tok = tokof[e * NLAT + min(j, ce - 1)]; return (unsigned)tok * rowbytes; }
        return (unsigned)(u.pm * 256 + r) * rowbytes; }
    __device__ __forceinline__ const int* a_tokp(const pg8::Unit& u, int r) const {
        const int e = u.pn / nN, j = u.pm + r; int ce = 0;
#pragma unroll
        for (int k = 0; k < NE; ++k) ce = (k == e) ? T.cnt[k] : ce;
        return tokof + (e * NLAT + min(j, ce - 1)); }
};

struct ConvJob { const float* W; unsigned char* WT; const unsigned* cm; int K, N, gu, up, head, f8; float sc; };
__device__ __forceinline__ void conv_load(const ConvJob& J, float (&rg)[32], int item, int lane) {
    const int nblk = J.N / 32, kb = item / nblk, nb = item % nblk, k0 = 64 * kb, n0 = 32 * nb;
    const float* p = J.W + (size_t)(k0 + (lane >> 5)) * J.N + n0 + (lane & 31);
#pragma unroll
    for (int i = 0; i < 32; ++i) rg[i] = p[(size_t)(2 * i) * J.N];
}
__device__ __forceinline__ void conv_finish(const ConvJob& J, LAS float* scr, const float (&rg)[32], int item, int lane) {
    const int nblk = J.N / 32, kb = item / nblk, nb = item % nblk, k0 = 64 * kb, n0 = 32 * nb;
#pragma unroll
    for (int i = 0; i < 32; ++i) { const int kk = 2 * i + (lane >> 5); scr[kk * 33 + (lane & 31)] = rg[i]; }
    asm volatile("s_waitcnt lgkmcnt(0)" ::: "memory");
    const int c = lane & 7;
#pragma unroll
    for (int j = 0; j < 4; ++j) { const int n = n0 + (lane >> 3) + 8 * j; const LAS float* sp = scr + (8 * c) * 33 + (lane >> 3) + 8 * j;
        int row = n;
        if (J.gu) row = 256 * (n >> 7) + 128 * J.up + (n & 127);
        else if (J.head) { const int o = n & 255; row = (n & ~255) + 128 * ((o >> 5) & 1) + 32 * (o >> 6) + (o & 31); }
        const float v0 = sp[0 * 33] * J.sc, v1 = sp[1 * 33] * J.sc, v2 = sp[2 * 33] * J.sc, v3 = sp[3 * 33] * J.sc, v4 = sp[4 * 33] * J.sc, v5 = sp[5 * 33] * J.sc, v6 = sp[6 * 33] * J.sc, v7 = sp[7 * 33] * J.sc;
        if (J.f8 == 2) { const float qs = 127.f / fmaxf(__uint_as_float(J.cm[row]), 1e-30f) / J.sc;
            const int a0 = (int)__builtin_rintf(v0 * qs), a1 = (int)__builtin_rintf(v1 * qs), a2 = (int)__builtin_rintf(v2 * qs), a3 = (int)__builtin_rintf(v3 * qs), a4 = (int)__builtin_rintf(v4 * qs), a5 = (int)__builtin_rintf(v5 * qs), a6 = (int)__builtin_rintf(v6 * qs), a7 = (int)__builtin_rintf(v7 * qs);
            u32x2 o; o.x = (unsigned)(a0 & 255) | ((unsigned)(a1 & 255) << 8) | ((unsigned)(a2 & 255) << 16) | ((unsigned)a3 << 24);
            o.y = (unsigned)(a4 & 255) | ((unsigned)(a5 & 255) << 8) | ((unsigned)(a6 & 255) << 16) | ((unsigned)a7 << 24); *(u32x2*)(J.WT + (size_t)row * J.K + k0 + 8 * c) = o; }
        else if (J.f8) { u32x2 o; o.x = pk4_fp8(v0, v1, v2, v3); o.y = pk4_fp8(v4, v5, v6, v7); *(u32x2*)(J.WT + (size_t)row * J.K + k0 + 8 * c) = o; }
        else { u32x4 o; o.x = pk2(v0, v1); o.y = pk2(v2, v3); o.z = pk2(v4, v5); o.w = pk2(v6, v7); *(u32x4*)(J.WT + ((size_t)row * J.K + k0 + 8 * c) * 2) = o; } }
    asm volatile("s_waitcnt lgkmcnt(0)" ::: "memory");
}
__device__ __forceinline__ void conv_item(const ConvJob& J, LAS float* scr, int item, int lane) { float rg[32]; conv_load(J, rg, item, lane); conv_finish(J, scr, rg, item, lane); }
constexpr int I_IN0 = 16 * 48, I_OUT = 16 * 32, I_G0 = 16 * 88, I_D0 = 44 * 32, I_IN1 = 16 * 96, I_GE = 16 * 112, I_DE = 56 * 32;
constexpr int NCONV0 = I_OUT + I_D0;
constexpr int NCONVQ = I_IN0 + 2 * I_G0;
constexpr int NFILL_L1 = I_IN1 + I_OUT, NFILL = NFILL_L1 + 8 * (2 * I_GE + I_DE);
__device__ __forceinline__ void conv0_job(const Ctx& C, int& r, ConvJob& J) {
    unsigned char* ws = C.p.ws; J.gu = 0; J.up = 0; J.head = 0; J.f8 = 0; J.sc = 1.f; J.K = D; J.cm = nullptr;
    if (r < I_OUT) { J.W = C.p.in[11]; J.WT = ws + WS_WOUT0; J.N = D; return; } r -= I_OUT;
    J.W = C.p.in[17]; J.WT = ws + WS_WDN0; J.K = FF0; J.N = D; J.f8 = 1; J.sc = W8DN0_SCALE;
}
__device__ __forceinline__ void convq_job(const Ctx& C, int& r, ConvJob& J) {
    unsigned char* ws = C.p.ws; J.gu = 0; J.up = 0; J.head = 0; J.f8 = 2; J.sc = 1.f; J.K = D;
    if (r < I_IN0) { J.W = C.p.in[10]; J.WT = ws + WS_WIN0; J.N = NQKV0; J.head = 1; J.cm = C.ctl() + CM_IN0; return; } r -= I_IN0;
    J.WT = ws + WS_WGU0; J.N = FF0; J.gu = 1; J.cm = C.ctl() + CM_GU0;
    if (r < I_G0) { J.W = C.p.in[15]; return; } r -= I_G0;
    J.W = C.p.in[16]; J.up = 1;
}
__device__ __forceinline__ void fill_job(const Ctx& C, int& r, ConvJob& J) {
    unsigned char* ws = C.p.ws; J.gu = 0; J.up = 0; J.head = 0; J.f8 = 0; J.sc = 1.f; J.K = D; J.cm = nullptr;
    if (r < I_IN1) { J.W = C.p.in[24]; J.WT = ws + WS_WIN1; J.N = NQKV1; J.f8 = 2; J.cm = C.ctl() + CM_IN1; return; } r -= I_IN1;
    if (r < I_OUT) { J.W = C.p.in[25]; J.WT = ws + WS_WOUT1; J.N = D; return; } r -= I_OUT;
    const int e = r / (2 * I_GE + I_DE); r -= e * (2 * I_GE + I_DE); J.f8 = 1;
    if (r < I_GE) { J.W = C.p.in[28] + (size_t)e * D * FFE; J.WT = ws + WS_W8GU + (size_t)e * 2 * FFE * D; J.N = FFE; J.gu = 1; J.sc = W8GU_SCALE; return; } r -= I_GE;
    if (r < I_GE) { J.W = C.p.in[29] + (size_t)e * D * FFE; J.WT = ws + WS_W8GU + (size_t)e * 2 * FFE * D; J.N = FFE; J.gu = 1; J.up = 1; J.sc = W8GU_SCALE; return; } r -= I_GE;
    J.W = C.p.in[30] + (size_t)e * FFE * D; J.WT = ws + WS_W8DN + (size_t)e * D * FFE; J.K = FFE; J.N = D; J.sc = W8DN_SCALE;
}
__device__ __forceinline__ void phase_convert(const Ctx& C) {
    LAS float* scr = (LAS float*)(C.lds + C.wave * 16384);
    const int gw = C.vcu * NWAVES + C.wave, NGW = C.G * NWAVES;
    for (int it = gw; it < NCONV0; it += NGW) { int r = it; ConvJob J; conv0_job(C, r, J); conv_item(J, scr, r, C.lane); }
}
__device__ __forceinline__ void phase_convert_q(const Ctx& C) {
    LAS float* scr = (LAS float*)(C.lds + C.wave * 16384);
    const int gw = C.vcu * NWAVES + C.wave, NGW = C.G * NWAVES;
    for (int it = gw; it < NCONVQ; it += NGW) { int r = it; ConvJob J; convq_job(C, r, J); conv_item(J, scr, r, C.lane); }
}
__device__ __forceinline__ void phase_colmax(const Ctx& C) {
    const int gw = C.vcu * NWAVES + C.wave, NGW = C.G * NWAVES;
    constexpr int B0 = (NQKV0 / 64) * 32, B1 = (FF0 / 64) * 32, B3 = (NQKV1 / 64) * 32;
    for (int it = gw; it < B0 + 2 * B1 + B3; it += NGW) {
        int r = it; const float* W; int N, kind, up = 0; unsigned* cm;
        if (r < B0) { W = C.p.in[10]; N = NQKV0; kind = 1; cm = C.ctl() + CM_IN0; }
        else if ((r -= B0) < B1) { W = C.p.in[15]; N = FF0; kind = 2; cm = C.ctl() + CM_GU0; }
        else if ((r -= B1) < B1) { W = C.p.in[16]; N = FF0; kind = 2; up = 1; cm = C.ctl() + CM_GU0; }
        else { r -= B1; W = C.p.in[24]; N = NQKV1; kind = 0; cm = C.ctl() + CM_IN1; }
        const int cb = r >> 5, kc = r & 31, n = cb * 64 + C.lane;
        const float* p = W + (size_t)(kc * 32) * N + n;
        float m = 0.f;
#pragma unroll
        for (int k = 0; k < 32; ++k) m = fmaxf(m, fabsf(p[(size_t)k * N]));
        int row = n;
        if (kind == 2) row = 256 * (n >> 7) + 128 * up + (n & 127);
        else if (kind == 1) { const int o = n & 255; row = (n & ~255) + 128 * ((o >> 5) & 1) + 32 * (o >> 6) + (o & 31); }
        __hip_atomic_fetch_max(cm + row, __float_as_uint(m), __ATOMIC_RELAXED, __HIP_MEMORY_SCOPE_AGENT);
    }
}
__device__ __forceinline__ void filler(const Ctx& C, int seam, int need, volatile LAS unsigned* misc) {
    __syncthreads();
    if (misc[0] != 0u) return;
    unsigned* done = C.ctl() + CW_DONE + 64 * seam; unsigned* head = C.ctl() + CW_FILL;
    if (C.tid == 0) __hip_atomic_fetch_add(done, 1u, __ATOMIC_RELAXED, __HIP_MEMORY_SCOPE_AGENT);
    LAS float* scr = (LAS float*)(C.lds + C.wave * 16384);
    bool force = need > 0;
    for (;;) {
        if (C.tid == 0) {
            unsigned first = ~0u;
            bool go = force;
            if (!go) go = __hip_atomic_load(done, __ATOMIC_RELAXED, __HIP_MEMORY_SCOPE_AGENT) < (unsigned)C.G;
            if (go) { first = __hip_atomic_fetch_add(head, (unsigned)(2 * NWAVES), __ATOMIC_RELAXED, __HIP_MEMORY_SCOPE_AGENT); if (first >= (unsigned)NFILL) { first = ~0u; misc[0] = 1u; } }
            misc[1] = first;
        }
        __syncthreads();
        const unsigned first = misc[1];
        __syncthreads();
        if (first == ~0u) break;
        const unsigned ia = first + (unsigned)C.wave, ib = ia + (unsigned)NWAVES;
        if (ib < (unsigned)NFILL) { int ra = (int)ia, rb = (int)ib; ConvJob JA, JB; fill_job(C, ra, JA); fill_job(C, rb, JB);
            float ga[32], gb[32]; conv_load(JA, ga, ra, C.lane); conv_load(JB, gb, rb, C.lane); conv_finish(JA, scr, ga, ra, C.lane); conv_finish(JB, scr, gb, rb, C.lane); }
        else if (ia < (unsigned)NFILL) { int r = (int)ia; ConvJob J; fill_job(C, r, J); conv_item(J, scr, r, C.lane); }
        force = (int)first + 2 * NWAVES < need;
    }
}
__device__ __forceinline__ void phase_fgemm(const Ctx& C, const bf16* A, const bf16* Bt, int nM, int nN, int K, bf16* O, int ldo) {
    pg8::Gemm g{A, Bt, K}; pg8::SchedStatic S{nM, nN, C.G, (int)blockIdx.x, (unsigned)K * 2u}; pg8::EpiStore E{O, ldo, 1.f, 0};
    pg8::gemm_phase<pg8::EpiStore, pg8::SchedStatic, true>(C.lds, g, S, E);
}
__device__ __forceinline__ void phase_fgemm_in0(const Ctx& C) {
    pg8::Gemm g{(const bf16*)(C.p.ws + WS_HB), (const bf16*)(C.p.ws + WS_WIN0), D}; pg8::SchedStatic S{MTOT / 256, NQKV0 / 256, C.G, (int)blockIdx.x, (unsigned)D};
    typedef pg8::EpiDeq<pg8::EpiQkv0> Epi;
    Epi E{pg8::EpiQkv0{(bf16*)(C.p.ws + WS_QKV), C.p.in[12], C.p.in[13], (const LAS f32x2*)(C.lds + ROPE_OFF)}, (const float*)(C.p.ws + WS_HS), C.ctl() + CM_IN0};
    pg8::gemm_phase<Epi, pg8::SchedStatic, true, 2>(C.lds, g, S, E);
}
__device__ __forceinline__ void phase_fgemm_gu0(const Ctx& C) {
    pg8::Gemm g{(const bf16*)(C.p.ws + WS_HB), (const bf16*)(C.p.ws + WS_WGU0), D}; pg8::SchedStatic S{MTOT / 256, 2 * FF0 / 256, C.G, (int)blockIdx.x, (unsigned)D};
    typedef pg8::EpiDeqSwiglu8 Epi;
    Epi E{C.p.ws + WS_ACT0, FF0, ACT0_SCALE, (const float*)(C.p.ws + WS_HS), C.ctl() + CM_GU0};
    pg8::gemm_phase<Epi, pg8::SchedStatic, true, 2>(C.lds, g, S, E);
}
#ifdef PROBE_GU0
template <class Inner> struct EpiIf { Inner in; int on;
    __device__ __forceinline__ void operator()(f32x4 (&acc)[2][2][4][2], const pg8::Unit& u, int wr, int wc, int fr, int fq) const { if (on) in(acc, u, wr, wc, fr, fq); } };
__device__ __forceinline__ void phase_fgemm_gu0_probe(const Ctx& C) {
    pg8::Gemm g{(const bf16*)(C.p.ws + WS_HB), (const bf16*)(C.p.ws + WS_WGU0), D}; pg8::SchedStatic S{MTOT / 256, 2 * FF0 / 256, C.G, (int)blockIdx.x, (unsigned)D};
    typedef EpiIf<pg8::EpiDeq<pg8::EpiSwiglu8>> Epi;
    Epi E{pg8::EpiDeq<pg8::EpiSwiglu8>{pg8::EpiSwiglu8{C.p.ws + WS_ACT0, FF0, 1.f, ACT0_SCALE}, (const float*)(C.p.ws + WS_HS), C.ctl() + CM_GU0}, (PROBE_GU0 == 1) ? 1 : (C.p.tpc == 77)};
    pg8::gemm_phase<Epi, pg8::SchedStatic, true, 2>(C.lds, g, S, E);
}
#endif
__device__ __forceinline__ void phase_fgemm_dn0(const Ctx& C) {
    pg8::Gemm g{(const bf16*)(C.p.ws + WS_ACT0), (const bf16*)(C.p.ws + WS_WDN0), FF0}; pg8::SchedStatic S{MTOT / 256, D / 256, C.G, (int)blockIdx.x, (unsigned)FF0};
    pg8::EpiStore E{(bf16*)(C.p.ws + WS_YB), D, 1.f / (W8DN0_SCALE * ACT0_SCALE), 1 << 20};
    pg8::gemm_phase<pg8::EpiStore, pg8::SchedStatic, true, 1>(C.lds, g, S, E);
}
__device__ __forceinline__ void phase_fgemm_in1(const Ctx& C) {
    pg8::Gemm g{(const bf16*)(C.p.ws + WS_HB), (const bf16*)(C.p.ws + WS_WIN1), D}; pg8::SchedIn1 S{C.G, (int)blockIdx.x};
    typedef pg8::EpiDeq<pg8::EpiStore> Epi;
    Epi E{pg8::EpiStore{(bf16*)(C.p.ws + WS_QKV), NQKV1, QSCALE, 4}, (const float*)(C.p.ws + WS_HS), C.ctl() + CM_IN1};
    pg8::gemm_phase<Epi, pg8::SchedIn1, true, 2>(C.lds, g, S, E);
}
__device__ __forceinline__ void phase_moe_gu_fast(const Ctx& C) {
    SchedMoeT<true> S; load_tiletab(C, S.T);
    S.t0 = 0; S.nT = S.T.tb[8]; S.nN = 2 * FFE / 256; S.G = C.G; S.c = (int)blockIdx.x; S.tokof = (const int*)(C.p.ws + WS_TOKOF); S.rowbytes = D; S.um = 0; S.tmt = 0; S.nl = 0; S.ptile0 = 0;
    pg8::Gemm g{(const bf16*)(C.p.ws + WS_H8), (const bf16*)(C.p.ws + WS_W8GU), D}; pg8::EpiSwiglu8 E{C.p.ws + WS_ACT8, FFE, 1.f / W8GU_SCALE, 1.f};
    pg8::gemm_phase<pg8::EpiSwiglu8, SchedMoeT<true>, true, 1>(C.lds, g, S, E);
}
__device__ __forceinline__ void phase_moe_dn_fast(const Ctx& C) {
    SchedMoeT<false> S; load_tiletab(C, S.T);
    S.t0 = 0; S.nT = S.T.tb[8]; S.nN = D / 256; S.G = C.G; S.c = (int)blockIdx.x; S.tokof = nullptr; S.rowbytes = FFE;
    moe_split(C, S.nT, S.tmt, S.nl); S.um = S.tmt * 4; S.ptile0 = MOE_PTILE0;
    pg8::Gemm g{(const bf16*)(C.p.ws + WS_ACT8), (const bf16*)(C.p.ws + WS_W8DN), FFE}; pg8::EpiStore E{(bf16*)(C.p.ws + WS_YS), D, 1.f / W8DN_SCALE, 1 << 20};
    pg8::gemm_phase<pg8::EpiStore, SchedMoeT<false>, true, 1>(C.lds, g, S, E);
}
namespace att {
typedef short bf16x8 __attribute__((ext_vector_type(8)));
typedef short s16x4 __attribute__((ext_vector_type(4)));
typedef float f32x16 __attribute__((ext_vector_type(16)));
constexpr int NSLOT = 4, SLOTB = 8192, LDS_K = 0, LDS_V = NSLOT * SLOTB, LDS_WS = 2 * NSLOT * SLOTB, LDS_OST = LDS_WS + 8 * 64 * 4, LDS_BIAS = LDS_OST + 8 * 4096, LDS_END = LDS_BIAS + 4096;
constexpr int BIAS_PAD = 64;
constexpr float THR = 8.f;
static_assert(LDS_END <= 131072, "attention LDS");
__device__ __forceinline__ int crow(int r, int hi) { return (r & 3) + 8 * (r >> 2) + 4 * hi; }
__device__ __forceinline__ void glds16(const void* gsrc, unsigned lds_dst) { unsigned keep;
    asm volatile("s_mov_b32 %0, m0\n\ts_mov_b32 m0, %2\n\ts_nop 0\n\tglobal_load_lds_dwordx4 %1, off\n\ts_mov_b32 m0, %0" : "=&s"(keep) : "v"(gsrc), "s"(lds_dst) : "memory"); }
#define ATT_WAIT_BAR(N) asm volatile("s_waitcnt vmcnt(" #N ") lgkmcnt(0)\n\ts_barrier" ::: "memory")
#define ATT_WAIT_BAR_Q(N, q) asm volatile("s_waitcnt vmcnt(" #N ") lgkmcnt(0)\n\ts_barrier" : "+v"(q[0]), "+v"(q[1]), "+v"(q[2]), "+v"(q[3]) :: "memory")
#define ATT_MX3(a, b, c) __builtin_fmaxf(__builtin_fmaxf((a), (b)), (c))
__device__ __forceinline__ unsigned cvtpk(float lo, float hi) { typedef float f2 __attribute__((ext_vector_type(2))); typedef __bf16 b2 __attribute__((ext_vector_type(2))); f2 v = {lo, hi}; b2 b = __builtin_convertvector(v, b2); return __builtin_bit_cast(unsigned, b); }
template <bool PF>
__device__ __forceinline__ void qkt(f32x16& p0, f32x16& p1, const LAS char* kslot, const bf16x8* qr, const f32x16& negm, int r32, int hi) {
    const LAS char* kb = kslot + hi * 1024 + r32 * 16;
    if constexpr (!PF) {
#pragma unroll
        for (int d0 = 0; d0 < 4; ++d0) {
            const bf16x8 b0 = *(const LAS bf16x8*)(kb + d0 * 2048);
            const bf16x8 b1 = *(const LAS bf16x8*)(kb + d0 * 2048 + 512);
            if (d0 == 0) { p0 = __builtin_amdgcn_mfma_f32_32x32x16_bf16(b0, qr[0], negm, 0, 0, 0); p1 = __builtin_amdgcn_mfma_f32_32x32x16_bf16(b1, qr[0], negm, 0, 0, 0); }
            else { p0 = __builtin_amdgcn_mfma_f32_32x32x16_bf16(b0, qr[d0], p0, 0, 0, 0); p1 = __builtin_amdgcn_mfma_f32_32x32x16_bf16(b1, qr[d0], p1, 0, 0, 0); } }
        return;
    }
    bf16x8 kf[8];
#pragma unroll
    for (int d0 = 0; d0 < 4; ++d0) { kf[2 * d0] = *(const LAS bf16x8*)(kb + d0 * 2048); kf[2 * d0 + 1] = *(const LAS bf16x8*)(kb + d0 * 2048 + 512); }
    __builtin_amdgcn_sched_barrier(0);
    p0 = __builtin_amdgcn_mfma_f32_32x32x16_bf16(kf[0], qr[0], negm, 0, 0, 0); p1 = __builtin_amdgcn_mfma_f32_32x32x16_bf16(kf[1], qr[0], negm, 0, 0, 0);
#pragma unroll
    for (int d0 = 1; d0 < 4; ++d0) { p0 = __builtin_amdgcn_mfma_f32_32x32x16_bf16(kf[2 * d0], qr[d0], p0, 0, 0, 0); p1 = __builtin_amdgcn_mfma_f32_32x32x16_bf16(kf[2 * d0 + 1], qr[d0], p1, 0, 0, 0); }
    __builtin_amdgcn_sched_barrier(0);
}
__device__ __forceinline__ void pv_load(s16x4 (&lo)[8], s16x4 (&hi)[8], int vb) {
#pragma unroll
    for (int d0 = 0; d0 < 2; ++d0)
#pragma unroll
        for (int ks = 0; ks < 4; ++ks) {
            asm volatile("ds_read_b64_tr_b16 %0,%1 offset:%c2" : "=&v"(lo[d0 * 4 + ks]) : "v"(vb), "i"(d0 * 4096 + ks * 1024) : "memory");
            asm volatile("ds_read_b64_tr_b16 %0,%1 offset:%c2" : "=&v"(hi[d0 * 4 + ks]) : "v"(vb), "i"(d0 * 4096 + ks * 1024 + 512) : "memory"); }
}
__device__ __forceinline__ void pv_mma(f32x16* o, const s16x4 (&lo)[8], const s16x4 (&hi)[8], bf16x8 pa0, bf16x8 pa1, bf16x8 pa2, bf16x8 pa3) {
    asm volatile("s_waitcnt lgkmcnt(0)" ::: "memory"); __builtin_amdgcn_sched_barrier(0);
#define ATT_PK(k) (bf16x8){lo[k][0], lo[k][1], lo[k][2], lo[k][3], hi[k][0], hi[k][1], hi[k][2], hi[k][3]}
#pragma unroll
    for (int d0 = 0; d0 < 2; ++d0) {
        o[d0] = __builtin_amdgcn_mfma_f32_32x32x16_bf16(pa0, ATT_PK(d0 * 4 + 0), o[d0], 0, 0, 0);
        o[d0] = __builtin_amdgcn_mfma_f32_32x32x16_bf16(pa1, ATT_PK(d0 * 4 + 1), o[d0], 0, 0, 0);
        o[d0] = __builtin_amdgcn_mfma_f32_32x32x16_bf16(pa2, ATT_PK(d0 * 4 + 2), o[d0], 0, 0, 0);
        o[d0] = __builtin_amdgcn_mfma_f32_32x32x16_bf16(pa3, ATT_PK(d0 * 4 + 3), o[d0], 0, 0, 0);
    }
#undef ATT_PK
}
struct UnitDesc {
    const bf16* q;
    const bf16* kv;
    bf16* o;
    const float* rpb;
    int pitch, kcol, vcol;
    int base0, n0, base1, n1;
    int kind;
    int mk0, mk1;
    int has_sink; float sink2;
};
template <bool HAS1, bool HAS2, class DescFn>
__device__ __forceinline__ void attn_run(const Ctx& C, int nunits, const DescFn& desc) {
    if (nunits <= 0) return;
    const int lane = C.lane, r32 = lane & 31, hi = lane >> 5, wid = C.wave;
    LAS char* shm = (LAS char*)C.lds;
    const unsigned lds0 = (unsigned)(size_t)shm;
    LAS float* wsf = (LAS float*)(shm + LDS_WS) + wid * 64;
    LAS float* biasl = (LAS float*)(shm + LDS_BIAS);
    const unsigned kdst = lds0 + LDS_K + wid * 1024, vdst = lds0 + LDS_V + wid * 1024;
    const int vb0 = (int)(lds0 + LDS_V) + ((lane >> 4) & 1) * 32 + (lane & 3) * 8 + (4 * hi + ((lane & 15) >> 2)) * 64;
    const float NEG = -__builtin_inff();
#define ATT_TROW(U, t) ((t) < (U).n0 ? (U).base0 + 64 * (t) : (U).base1 + 64 * ((t) - (U).n0))
#define ATT_DMA(U, t, slot) do { const size_t ro_ = (size_t)(ATT_TROW(U, t)) * (U).pitch; \
        glds16((U).kv + (U).kcol + (size_t)lane * (U).pitch + wid * 8 + ro_, (unsigned)__builtin_amdgcn_readfirstlane(kdst + (slot))); \
        glds16((U).kv + (U).vcol + (size_t)(16 * (wid & 3) + (lane >> 2)) * (U).pitch + (wid >> 2) * 32 + (lane & 3) * 8 + ro_, (unsigned)__builtin_amdgcn_readfirstlane(vdst + (slot))); } while (0)
#define ATT_LDQ(dst, U) do { _Pragma("unroll") for (int d0_ = 0; d0_ < 4; ++d0_) { const bf16* qp_ = (U).q + (size_t)(wid * 32 + r32) * (U).pitch + d0_ * 16 + hi * 8; \
        asm volatile("global_load_dwordx4 %0, %1, off" : "=v"(dst[d0_]) : "v"(qp_) : "memory"); } } while (0)
    UnitDesc U, Un; desc(0, U); Un = U;
    bf16x8 qr[4];
    ATT_LDQ(qr, U);
    ATT_DMA(U, 0, 0); ATT_DMA(U, 1, SLOTB);
    int gs = 0;
    const float* bias_have = nullptr;
    for (int ui = 0; ui < nunits; ++ui) {
        const bool has_next = ui + 1 < nunits;
        if (has_next) desc(ui + 1, Un);
        const int NTL = U.n0 + U.n1;
        unsigned mbits = 0xffffffffu;
        int c_q = 0;
        if (HAS2 && U.kind == 2) {
            if (U.rpb != bias_have) {
                asm volatile("s_waitcnt lgkmcnt(0)\n\ts_barrier" ::: "memory");
                for (int i = C.tid; i < 1024; i += NT) { const int j = i - BIAS_PAD; biasl[i] = (j >= 0 && j < 465) ? U.rpb[j] * LOG2E : 0.f; }
                asm volatile("s_waitcnt lgkmcnt(0)\n\ts_barrier" ::: "memory");
                bias_have = U.rpb;
            }
            c_q = 32 * (wid & 1) + r32; const int cs = min(max(c_q - 8, 0), 48);
            mbits = 0u;
#pragma unroll
            for (int i = 0; i < 16; ++i) { const int kc = 4 * hi + (i & 3) + 8 * (i >> 2);
                if (kc >= cs && kc <= cs + 15) mbits |= 1u << i;
                if (kc + 32 >= cs && kc + 32 <= cs + 15) mbits |= 1u << (16 + i); }
        }
        float mhat = 0.f, lsum = 0.f; f32x16 o[2]; o[0] = f32x16{}; o[1] = f32x16{};
        f32x16 negm = f32x16{};
        for (int t = 0; t < NTL; ++t, ++gs) {
            const int slot = (gs & 3) * SLOTB, pslot = ((gs + 2) & 3) * SLOTB;
            if (t == 0) { ATT_WAIT_BAR_Q(0, qr); ATT_DMA(U, 2, pslot); }
            else if (t + 2 < NTL) { ATT_DMA(U, t + 2, pslot); ATT_WAIT_BAR(4); }
            else if (has_next) { ATT_DMA(Un, t + 2 - NTL, pslot); ATT_WAIT_BAR(4); }
            else if (t + 1 < NTL) { ATT_WAIT_BAR(2); }
            else { ATT_WAIT_BAR(0); }
            const int sgi = t - U.n0;
            bool active = true, need_mask = false;
            if (sgi >= 0) {
                if (HAS1 && U.kind == 1) { const int klo = U.mk0 + 64 * sgi; active = (klo + 63 >= 32 * wid - 128) && (klo <= 32 * wid + 31 + 128);
                    need_mask = !((klo - 32 * wid - 31 >= -128) && (klo + 63 - 32 * wid <= 128)); }
                else if (HAS2 && U.kind == 2) { const int kr = U.mk0 + sgi, r = U.mk1 + (wid >> 1), rs = min(max(r - 4, 0), 24); active = (kr >= rs) && (kr <= rs + 7); }
            }
            if (active) {
                f32x16 p0, p1;
                constexpr bool PF = !HAS2;
                qkt<PF>(p0, p1, shm + LDS_K + slot, qr, negm, r32, hi);
                s16x4 vlo[8], vhi[8];
                if constexpr (PF) pv_load(vlo, vhi, vb0 + slot);
                if (HAS1 && sgi >= 0 && U.kind == 1) {
                    if (need_mask) {
                        const int kb = U.mk0 + 64 * sgi + 4 * hi - (32 * wid + r32);
#pragma unroll
                        for (int i = 0; i < 16; ++i) { const int d = kb + (i & 3) + 8 * (i >> 2);
                            if (d < -128 || d > 128) p0[i] = NEG;
                            if (d + 32 < -128 || d + 32 > 128) p1[i] = NEG; }
                    }
                } else if (HAS2 && sgi >= 0 && U.kind == 2) {
                    const int kr = U.mk0 + sgi, r = U.mk1 + (wid >> 1);
                    const LAS float* bp = biasl + (BIAS_PAD + (kr - r + 7) * 31 + 15 - c_q + 4 * hi);
#pragma unroll
                    for (int g4 = 0; g4 < 4; ++g4) {
#pragma unroll
                        for (int i = 4 * g4; i < 4 * g4 + 4; ++i) {
                            { const int m = ((int)(mbits << (31 - i))) >> 31; const unsigned x = __float_as_uint(p0[i] + bp[(i & 3) + 8 * (i >> 2)]); p0[i] = __uint_as_float((x & (unsigned)m) | (0xff800000u & ~(unsigned)m)); }
                            { const int m = ((int)(mbits << (15 - i))) >> 31; const unsigned x = __float_as_uint(p1[i] + bp[32 + (i & 3) + 8 * (i >> 2)]); p1[i] = __uint_as_float((x & (unsigned)m) | (0xff800000u & ~(unsigned)m)); } }
                    }
                }
                float ma = ATT_MX3(p0[0], p0[1], p1[0]), mb = ATT_MX3(p0[2], p0[3], p1[1]); ma = ATT_MX3(ma, p1[2], p1[3]);
#pragma unroll
                for (int i = 4; i < 16; i += 4) { ma = ATT_MX3(ma, p0[i], p0[i + 1]); mb = ATT_MX3(mb, p0[i + 2], p0[i + 3]); ma = ATT_MX3(ma, p1[i], p1[i + 1]); mb = ATT_MX3(mb, p1[i + 2], p1[i + 3]); }
                float rm = __builtin_fmaxf(ma, mb);
                { auto rr = __builtin_amdgcn_permlane32_swap(__float_as_uint(rm), __float_as_uint(rm), false, false); rm = __builtin_fmaxf(__uint_as_float(rr[0]), __uint_as_float(rr[1])); }
                if (__any((t == 0) || (rm > THR))) {
                    const float dl = (t == 0) ? rm : __builtin_fmaxf(rm, 0.f);
                    mhat += dl;
#pragma unroll
                    for (int i = 0; i < 16; ++i) { p0[i] -= dl; p1[i] -= dl; }
#pragma unroll
                    for (int i = 0; i < 16; ++i) negm[i] = -mhat;
                    if (t != 0) {
                        const float f = __builtin_amdgcn_exp2f(-dl); lsum *= f;
                        if (hi == 0) wsf[r32] = f;
                        asm volatile("s_waitcnt lgkmcnt(0)" ::: "memory");
#pragma unroll
                        for (int i = 0; i < 16; ++i) { const float g = wsf[crow(i, hi)]; o[0][i] *= g; o[1][i] *= g; }
                    }
                }
#pragma unroll
                for (int i = 0; i < 16; ++i) { p0[i] = __builtin_amdgcn_exp2f(p0[i]); p1[i] = __builtin_amdgcn_exp2f(p1[i]); }
                f32x2 s2 = (f32x2){0.f, 0.f};
#pragma unroll
                for (int i = 0; i < 16; i += 2) { s2 += (f32x2){p0[i], p0[i + 1]}; s2 += (f32x2){p1[i], p1[i + 1]}; }
                lsum += s2.x + s2.y;
                u32x4 w0, w1, w2, w3;
                w0 = (u32x4){cvtpk(p0[0], p0[1]), cvtpk(p0[2], p0[3]), cvtpk(p0[4], p0[5]), cvtpk(p0[6], p0[7])};
                w1 = (u32x4){cvtpk(p0[8], p0[9]), cvtpk(p0[10], p0[11]), cvtpk(p0[12], p0[13]), cvtpk(p0[14], p0[15])};
                w2 = (u32x4){cvtpk(p1[0], p1[1]), cvtpk(p1[2], p1[3]), cvtpk(p1[4], p1[5]), cvtpk(p1[6], p1[7])};
                w3 = (u32x4){cvtpk(p1[8], p1[9]), cvtpk(p1[10], p1[11]), cvtpk(p1[12], p1[13]), cvtpk(p1[14], p1[15])};
                if constexpr (!PF) pv_load(vlo, vhi, vb0 + slot);
                pv_mma(o, vlo, vhi, __builtin_bit_cast(bf16x8, w0), __builtin_bit_cast(bf16x8, w1), __builtin_bit_cast(bf16x8, w2), __builtin_bit_cast(bf16x8, w3));
            }
        }
        if (has_next) ATT_LDQ(qr, Un);
        { auto rr = __builtin_amdgcn_permlane32_swap(__float_as_uint(lsum), __float_as_uint(lsum), false, false); lsum = __uint_as_float(rr[0]) + __uint_as_float(rr[1]); }
        if (U.has_sink) lsum += __builtin_amdgcn_exp2f(U.sink2 - mhat);
        if (hi == 0) wsf[32 + r32] = lsum;
        asm volatile("s_waitcnt lgkmcnt(0)" ::: "memory");
        LAS bf16* stg = (LAS bf16*)(shm + LDS_OST) + wid * 2048;
#pragma unroll
        for (int i = 0; i < 16; ++i) { const int orow = crow(i, hi); const float rl = __builtin_amdgcn_rcpf(wsf[32 + orow]);
#pragma unroll
            for (int d0 = 0; d0 < 2; ++d0) stg[orow * 64 + d0 * 32 + r32] = (bf16)f2bf(o[d0][i] * rl); }
        asm volatile("s_waitcnt lgkmcnt(0)" ::: "memory");
        bf16* Ow = U.o + (size_t)(wid * 32) * D;
#pragma unroll
        for (int i = 0; i < 4; ++i) { const int row = i * 8 + (lane >> 3), ch = lane & 7; const u32x4 v = *(const LAS u32x4*)(stg + row * 64 + ch * 8); *(u32x4*)(Ow + (size_t)row * D + ch * 8) = v; }
        asm volatile("s_waitcnt lgkmcnt(0)" ::: "memory");
        if (has_next) U = Un;
    }
    asm volatile("s_waitcnt vmcnt(0) lgkmcnt(0)\n\ts_barrier" ::: "memory");
#undef ATT_TROW
#undef ATT_DMA
#undef ATT_LDQ
}

template <int MODE, class DescFn>
__device__ __forceinline__ void attn_run_na(const Ctx& C, int nunits, const DescFn& desc) {
    if (nunits <= 0) return;
    const int lane = C.lane, n = lane & 31, hi = lane >> 5, wid = C.wave;
    const int jg = wid & 3, pr = wid >> 2;
    const int kc0 = (jg == 0) ? 0 : (jg == 1) ? 8 : (jg == 2) ? 24 : 32;
    const int qrl = 2 * pr + (n >> 4), qc = 16 * jg + (n & 15);
    const int tokrel = qrl * 64 + qc;
    LAS char* shm = (LAS char*)C.lds;
    const unsigned lds0 = (unsigned)(size_t)shm;
    LAS float* wsf = (LAS float*)(shm + LDS_WS) + wid * 64;
    LAS float* biasl = (LAS float*)(shm + LDS_BIAS);
    const unsigned kdst = lds0 + LDS_K + wid * 1024, vdst = lds0 + LDS_V + wid * 1024;
    const int vbl = (int)(lds0 + LDS_V) + ((lane >> 4) & 1) * 32 + (lane & 3) * 8 + (4 * hi + ((lane & 15) >> 2)) * 64;
    const float NEG = -__builtin_inff();
    unsigned cbits = 0u;
    { const int cs = min(max(qc - 8, 0), 48);
#pragma unroll
      for (int i = 0; i < 16; ++i) { const int kc = kc0 + crow(i, hi); if (kc >= cs && kc <= cs + 15) cbits |= 1u << i; } }
#define ATT_TROW(U, t) ((t) < (U).n0 ? (U).base0 + 64 * (t) : (U).base1 + 64 * ((t) - (U).n0))
#define ATT_DMA(U, t, slot) do { const size_t ro_ = (size_t)(ATT_TROW(U, t)) * (U).pitch; \
        glds16((U).kv + (U).kcol + (size_t)lane * (U).pitch + wid * 8 + ro_, (unsigned)__builtin_amdgcn_readfirstlane(kdst + (slot))); \
        glds16((U).kv + (U).vcol + (size_t)(16 * (wid & 3) + (lane >> 2)) * (U).pitch + (wid >> 2) * 32 + (lane & 3) * 8 + ro_, (unsigned)__builtin_amdgcn_readfirstlane(vdst + (slot))); } while (0)
#define ATT_LDQ(dst, U) do { _Pragma("unroll") for (int d0_ = 0; d0_ < 4; ++d0_) { const bf16* qp_ = (U).q + (size_t)tokrel * (U).pitch + d0_ * 16 + hi * 8; \
        asm volatile("global_load_dwordx4 %0, %1, off" : "=v"(dst[d0_]) : "v"(qp_) : "memory"); } } while (0)
    UnitDesc U, Un; desc(0, U); Un = U;
    bf16x8 qr[4];
    if (MODE != 1) ATT_LDQ(qr, U); else { for (int d0_ = 0; d0_ < 4; ++d0_) qr[d0_] = bf16x8{}; }
    ATT_DMA(U, 0, 0); ATT_DMA(U, 1, SLOTB);
    int gs = 0;
    const float* bias_have = nullptr;
    for (int ui = 0; ui < nunits; ++ui) {
        const bool has_next = ui + 1 < nunits;
        if (has_next) desc(ui + 1, Un);
        const int NTL = U.n0 + U.n1;
        if (U.rpb != bias_have) {
            asm volatile("s_waitcnt lgkmcnt(0)\n\ts_barrier" ::: "memory");
            for (int i = C.tid; i < 1024; i += NT) { const int j = i - BIAS_PAD; biasl[i] = (j >= 0 && j < 465) ? U.rpb[j] * LOG2E : 0.f; }
            asm volatile("s_waitcnt lgkmcnt(0)\n\ts_barrier" ::: "memory");
            bias_have = U.rpb;
        }
        const int rA = U.mk1 + 2 * pr;
        const int rq = rA + (n >> 4);
        const int rsq = min(max(rq - 4, 0), 24);
        float mhat = 0.f, lsum = 0.f; f32x16 o[2]; o[0] = f32x16{}; o[1] = f32x16{};
        f32x16 negm = f32x16{};
        bool first = true;
        for (int t = 0; t < NTL; ++t, ++gs) {
            const int slot = (gs & 3) * SLOTB, pslot = ((gs + 2) & 3) * SLOTB;
            if (MODE == 2) { if (gs < 2) { ATT_DMA(U, t + 2, pslot); } ATT_WAIT_BAR_Q(0, qr); }
            else if (t == 0) { ATT_WAIT_BAR_Q(0, qr); ATT_DMA(U, 2, pslot); }
            else if (t + 2 < NTL) { ATT_DMA(U, t + 2, pslot); ATT_WAIT_BAR(4); }
            else if (has_next) { ATT_DMA(Un, t + 2 - NTL, pslot); ATT_WAIT_BAR(4); }
            else if (t + 1 < NTL) { ATT_WAIT_BAR(2); }
            else { ATT_WAIT_BAR(0); }
            const int sgi = t - U.n0;
            const bool band = sgi >= 0;
            const int kr = U.mk0 + sgi;
            bool active = true;
            if (band) { const int rsa = min(max(rA - 4, 0), 24), rsb = min(max(rA + 1 - 4, 0), 24); active = (kr >= rsa) && (kr <= rsb + 7); }
            if (MODE == 1) active = false;
            if (active) {
                const int nblk = band ? 1 : 2;
                for (int bi = 0; bi < nblk; ++bi) {
                    const int kcb = band ? kc0 : 32 * bi;
                    const LAS char* kb = shm + LDS_K + slot + hi * 1024 + (kcb + n) * 16;
                    bf16x8 kf[4];
#pragma unroll
                    for (int d0 = 0; d0 < 4; ++d0) kf[d0] = *(const LAS bf16x8*)(kb + d0 * 2048);
                    f32x16 p = __builtin_amdgcn_mfma_f32_32x32x16_bf16(kf[0], qr[0], negm, 0, 0, 0);
#pragma unroll
                    for (int d0 = 1; d0 < 4; ++d0) p = __builtin_amdgcn_mfma_f32_32x32x16_bf16(kf[d0], qr[d0], p, 0, 0, 0);
                    s16x4 vlo[4], vhi[4];
                    { const int t0 = kcb, t1 = kcb + 8, t2 = kcb + 16, t3 = kcb + 24;
                      const int a0 = vbl + slot + (t0 >> 4) * 1024 + ((t0 >> 3) & 1) * 512, a1 = vbl + slot + (t1 >> 4) * 1024 + ((t1 >> 3) & 1) * 512;
                      const int a2 = vbl + slot + (t2 >> 4) * 1024 + ((t2 >> 3) & 1) * 512, a3 = vbl + slot + (t3 >> 4) * 1024 + ((t3 >> 3) & 1) * 512;
                      asm volatile("ds_read_b64_tr_b16 %0,%1" : "=&v"(vlo[0]) : "v"(a0) : "memory"); asm volatile("ds_read_b64_tr_b16 %0,%1" : "=&v"(vhi[0]) : "v"(a1) : "memory");
                      asm volatile("ds_read_b64_tr_b16 %0,%1" : "=&v"(vlo[1]) : "v"(a2) : "memory"); asm volatile("ds_read_b64_tr_b16 %0,%1" : "=&v"(vhi[1]) : "v"(a3) : "memory");
                      asm volatile("ds_read_b64_tr_b16 %0,%1 offset:4096" : "=&v"(vlo[2]) : "v"(a0) : "memory"); asm volatile("ds_read_b64_tr_b16 %0,%1 offset:4096" : "=&v"(vhi[2]) : "v"(a1) : "memory");
                      asm volatile("ds_read_b64_tr_b16 %0,%1 offset:4096" : "=&v"(vlo[3]) : "v"(a2) : "memory"); asm volatile("ds_read_b64_tr_b16 %0,%1 offset:4096" : "=&v"(vhi[3]) : "v"(a3) : "memory"); }
                    if (band) {
                        const bool rowok = (kr >= rsq) && (kr <= rsq + 7);
                        const unsigned mb = rowok ? cbits : 0u;
                        const LAS float* bp = biasl + (BIAS_PAD + (kr - rq + 7) * 31 + 15 - qc + kcb + 4 * hi);
#pragma unroll
                        for (int i = 0; i < 16; ++i) { const int m = ((int)(mb << (31 - i))) >> 31; const unsigned x = __float_as_uint(p[i] + bp[(i & 3) + 8 * (i >> 2)]);
                            p[i] = __uint_as_float((x & (unsigned)m) | (0xff800000u & ~(unsigned)m)); }
                    }
                    float ma = ATT_MX3(p[0], p[1], p[2]), mb2 = ATT_MX3(p[3], p[4], p[5]);
                    ma = ATT_MX3(ma, p[6], p[7]); mb2 = ATT_MX3(mb2, p[8], p[9]); ma = ATT_MX3(ma, p[10], p[11]); mb2 = ATT_MX3(mb2, p[12], p[13]); ma = ATT_MX3(ma, p[14], p[15]);
                    float rm = __builtin_fmaxf(ma, mb2);
                    { auto rr = __builtin_amdgcn_permlane32_swap(__float_as_uint(rm), __float_as_uint(rm), false, false); rm = __builtin_fmaxf(__uint_as_float(rr[0]), __uint_as_float(rr[1])); }
                    if (__any(first || (rm > THR))) {
                        const float dl = first ? rm : __builtin_fmaxf(rm, 0.f);
                        mhat += dl;
#pragma unroll
                        for (int i = 0; i < 16; ++i) p[i] -= dl;
#pragma unroll
                        for (int i = 0; i < 16; ++i) negm[i] = -mhat;
                        if (!first) {
                            const float f = __builtin_amdgcn_exp2f(-dl); lsum *= f;
                            if (hi == 0) wsf[n] = f;
                            asm volatile("s_waitcnt lgkmcnt(0)" ::: "memory");
#pragma unroll
                            for (int i = 0; i < 16; ++i) { const float g = wsf[crow(i, hi)]; o[0][i] *= g; o[1][i] *= g; }
                        }
                    }
                    first = false;
                    float sacc = 0.f;
#pragma unroll
                    for (int i = 0; i < 16; ++i) { p[i] = __builtin_amdgcn_exp2f(p[i]); sacc += p[i]; }
                    lsum += sacc;
                    const u32x4 w0 = (u32x4){cvtpk(p[0], p[1]), cvtpk(p[2], p[3]), cvtpk(p[4], p[5]), cvtpk(p[6], p[7])};
                    const u32x4 w1 = (u32x4){cvtpk(p[8], p[9]), cvtpk(p[10], p[11]), cvtpk(p[12], p[13]), cvtpk(p[14], p[15])};
                    asm volatile("s_waitcnt lgkmcnt(0)" ::: "memory"); __builtin_amdgcn_sched_barrier(0);
#define ATT_VF(k) (bf16x8){vlo[k][0], vlo[k][1], vlo[k][2], vlo[k][3], vhi[k][0], vhi[k][1], vhi[k][2], vhi[k][3]}
                    o[0] = __builtin_amdgcn_mfma_f32_32x32x16_bf16(__builtin_bit_cast(bf16x8, w0), ATT_VF(0), o[0], 0, 0, 0);
                    o[0] = __builtin_amdgcn_mfma_f32_32x32x16_bf16(__builtin_bit_cast(bf16x8, w1), ATT_VF(1), o[0], 0, 0, 0);
                    o[1] = __builtin_amdgcn_mfma_f32_32x32x16_bf16(__builtin_bit_cast(bf16x8, w0), ATT_VF(2), o[1], 0, 0, 0);
                    o[1] = __builtin_amdgcn_mfma_f32_32x32x16_bf16(__builtin_bit_cast(bf16x8, w1), ATT_VF(3), o[1], 0, 0, 0);
#undef ATT_VF
                }
            }
        }
        if (MODE == 1) { if (has_next) U = Un; continue; }
        if (has_next) ATT_LDQ(qr, Un);
        { auto rr = __builtin_amdgcn_permlane32_swap(__float_as_uint(lsum), __float_as_uint(lsum), false, false); lsum = __uint_as_float(rr[0]) + __uint_as_float(rr[1]); }
        if (hi == 0) wsf[32 + n] = lsum;
        asm volatile("s_waitcnt lgkmcnt(0)" ::: "memory");
        LAS bf16* stg = (LAS bf16*)(shm + LDS_OST) + wid * 2048;
#pragma unroll
        for (int i = 0; i < 16; ++i) { const int orow = crow(i, hi); const float rl = __builtin_amdgcn_rcpf(wsf[32 + orow]);
#pragma unroll
            for (int d0 = 0; d0 < 2; ++d0) stg[orow * 64 + d0 * 32 + n] = (bf16)f2bf(o[d0][i] * rl); }
        asm volatile("s_waitcnt lgkmcnt(0)" ::: "memory");
#pragma unroll
        for (int i = 0; i < 4; ++i) { const int sl = i * 8 + (lane >> 3), ch = lane & 7; const u32x4 v = *(const LAS u32x4*)(stg + sl * 64 + ch * 8);
            const int trel = (2 * pr + (sl >> 4)) * 64 + 16 * jg + (sl & 15);
            if (MODE == 0 || C.p.tpc == 77) *(u32x4*)(U.o + (size_t)trel * D + ch * 8) = v; }
        asm volatile("s_waitcnt lgkmcnt(0)" ::: "memory");
        if (has_next) U = Un;
    }
    asm volatile("s_waitcnt vmcnt(0) lgkmcnt(0)\n\ts_barrier" ::: "memory");
#undef ATT_TROW
#undef ATT_DMA
#undef ATT_LDQ
}
}

struct Desc0 {
    const bf16* QKV; bf16* O; const float* sink; int v;
    __device__ __forceinline__ void operator()(int i, att::UnitDesc& U) const {
        const int b = v >> 4, kvh = (v >> 3) & 1, qb = v & 7;
        const size_t qrow0 = (size_t)b * SEQ + 256 * qb;
        U.kv = QKV; U.rpb = nullptr; U.pitch = NQKV0; U.mk1 = 0;
        if (i < 4) {
            const int h = kvh * 4 + i;
            U.q = QKV + qrow0 * NQKV0 + h * 64; U.o = O + qrow0 * D + h * 64; U.kcol = 512 + kvh * 64; U.vcol = 640 + kvh * 64;
            U.base0 = b * SEQ; U.n0 = 32; U.base1 = NLAT + b * CTXL; U.n1 = 4; U.kind = 0; U.mk0 = 0; U.has_sink = 0; U.sink2 = 0.f;
        } else if (i < 8) {
            const int h = kvh * 4 + (i - 4);
            const int jlo = (qb == 0) ? 2 : 0, jhi = (qb == 7) ? 6 : 8;
            U.q = QKV + qrow0 * NQKV0 + 768 + h * 64; U.o = O + qrow0 * D + 512 + h * 64; U.kcol = 1280 + kvh * 64; U.vcol = 1408 + kvh * 64;
            U.base0 = NLAT + b * CTXL; U.n0 = 4; U.base1 = b * SEQ + 256 * qb - 128 + 64 * jlo; U.n1 = jhi - jlo; U.kind = 1; U.mk0 = -128 + 64 * jlo; U.has_sink = 1; U.sink2 = sink[h] * LOG2E;
        } else {
            const int h16 = v & 15, isA = h16 < 8, hh = h16 & 7, kh = hh >> 2;
            const size_t crow0 = (size_t)NLAT + (size_t)b * CTXL;
            U.q = QKV + crow0 * NQKV0 + (isA ? 0 : 768) + hh * 64; U.o = O + crow0 * D + h16 * 64;
            U.kcol = (isA ? 512 : 1280) + kh * 64; U.vcol = (isA ? 640 : 1408) + kh * 64;
            U.base0 = NLAT + b * CTXL; U.n0 = 4; U.base1 = 0; U.n1 = 0; U.kind = 0; U.mk0 = 0; U.has_sink = isA ? 0 : 1; U.sink2 = isA ? 0.f : sink[hh] * LOG2E;
        }
    }
};
__device__ __forceinline__ void phase_attn0_fast(const Ctx& C) {
    for (int v = C.vcu; v < 256; v += C.G) {
        Desc0 d{(const bf16*)(C.p.ws + WS_QKV), C.hb(), C.p.in[14], v};
        att::attn_run<true, false>(C, 9, d);
    }
}
struct Desc1 {
    const bf16* QKV; bf16* O; const float* rpb; int v;
    __device__ __forceinline__ void operator()(int rb, att::UnitDesc& U) const {
        const int x = v >> 5, j = v & 31, g = j >> 3, st = rb;
        const int h = 2 * x + (g >> 1), b = (g & 1) * 8 + st; rb = (j + st) & 7;
        const int rq0 = 4 * rb, krlo = min(max(rq0 - 4, 0), 24), krhi = min(max(rq0 + 3 - 4, 0), 24) + 7;
        const size_t qrow0 = (size_t)b * SEQ + 256 * rb;
        U.q = QKV + qrow0 * NQKV1 + h * 64; U.kv = QKV; U.o = O + qrow0 * D + h * 64; U.rpb = rpb + (size_t)h * 465; U.pitch = NQKV1; U.kcol = 1024 + h * 64; U.vcol = 2048 + h * 64;
        U.base0 = NLAT + b * CTXL; U.n0 = 4; U.base1 = b * SEQ + 64 * krlo; U.n1 = krhi - krlo + 1; U.kind = 2; U.mk0 = krlo; U.mk1 = rq0; U.has_sink = 0; U.sink2 = 0.f;
    }
};
__device__ __forceinline__ void phase_attn1_fast(const Ctx& C) {
    for (int v = C.vcu; v < 256; v += C.G) {
        Desc1 d{(const bf16*)(C.p.ws + WS_QKV), C.hb(), C.p.in[26], v};
        att::attn_run_na<0>(C, 8, d);
    }
}
#ifdef PROBE_ATT1
__device__ __forceinline__ void phase_attn1_probe(const Ctx& C) {
    for (int v = C.vcu; v < 256; v += C.G) {
        Desc1 d{(const bf16*)(C.p.ws + WS_QKV), C.hb(), C.p.in[26], v};
        att::attn_run_na<PROBE_ATT1>(C, 8, d);
    }
}
#endif

constexpr int S_MODS = 0, S_MOD0 = 1, S_IN0 = 2, S_ATT0 = 3, S_OUT0 = 4, S_THIN0A = 5, S_GU0 = 6, S_DN0 = 7, S_THIN0B = 8,
              S_IN1 = 9, S_ATT1 = 10, S_OUT1 = 11, S_THIN1A = 12, S_MOE = 13, S_FINAL = S_MOE + 2, S_END = S_FINAL + 1;
#ifndef REP_ATT0
#define REP_ATT0 1
#endif
#ifndef REP_ATT1
#define REP_ATT1 1
#endif
#ifndef REP_MOE
#define REP_MOE 1
#endif
#ifndef REP_FFN0
#define REP_FFN0 1
#endif
#ifndef REP_PROJ
#define REP_PROJ 1
#endif
#ifndef REP_PRO
#define REP_PRO 1
#endif
#define RPT1(...) __VA_ARGS__
#define RPT2(...) __VA_ARGS__ __VA_ARGS__
#define RPT_(n, ...) RPT##n(__VA_ARGS__)
#define RPT(n, ...) RPT_(n, __VA_ARGS__)
#ifndef MK_ONE_LAUNCH
#define MK_ONE_LAUNCH 1
#endif

__global__ void __launch_bounds__(NT, 2) k_run(Params p, int lo, int hi) {
    extern __shared__ __attribute__((aligned(16))) unsigned char lds_raw[];
    Ctx C; C.p = p; C.lds = (LAS unsigned char*)lds_raw;
    C.tid = threadIdx.x; C.lane = C.tid & 63; C.wave = __builtin_amdgcn_readfirstlane(C.tid >> 6);
    C.G = gridDim.x; { const int bx = blockIdx.x; C.vcu = (C.G % 8 == 0) ? (bx % 8) * (C.G / 8) + bx / 8 : bx; }
    volatile LAS unsigned* MISC = (volatile LAS unsigned*)(C.lds + MISC_OFF);
    if (C.tid < 32) MISC[C.tid] = 0u;
    for (int i = C.tid; i < 1024; i += NT) { const int pos = i >> 4, j = i & 15; const float ang = (float)pos * exp2f(-(float)j * (13.287712379549449f / 16.f)); float sn, cs; __sincosf(ang, &sn, &cs);
        ((LAS f32x2*)(C.lds + ROPE_OFF))[pos * 17 + j] = (f32x2){cs, sn}; }
    __syncthreads();
    const bool one = (hi - lo) > 1;
    XcdBarrier bar; bar.bar = (unsigned*)C.ctl() + CW_BAR; bar.x = 0; bar.st = nullptr;
    if (one) bar = xcd_barrier_post((unsigned*)C.ctl() + CW_BAR, MISC + 8);
#define IN(k) (lo <= (k) && (k) < hi)
#define SEAM(k, need) do { if (one) { filler(C, (k), (need), MISC); xcd_barrier(bar); } } while (0)
#define SEAMP() do { if (one) xcd_barrier(bar); } while (0)
    unsigned char* ws = p.ws;
    RPT(REP_PRO, if (IN(S_MODS)) { phase_mods(C); __syncthreads(); phase_colmax(C); phase_convert(C); SEAMP(); })
    if (IN(S_MOD0)) { phase_modulate0(C); phase_convert_q(C); SEAMP(); }
    RPT(REP_PROJ, if (IN(S_IN0)) { phase_fgemm_in0(C); SEAM(2, 0); })
    RPT(REP_ATT0, if (IN(S_ATT0)) { phase_attn0_fast(C); SEAMP(); })
    RPT(REP_PROJ, if (IN(S_OUT0)) { phase_fgemm(C, C.hb(), (const bf16*)(ws + WS_WOUT0), MTOT / 256, D / 256, D, (bf16*)(ws + WS_YA), D); SEAM(4, 0); })
    if (IN(S_THIN0A)) { phase_thin0a(C); SEAMP(); }
#ifdef PROBE_GU0
    if (IN(S_GU0)) { phase_fgemm_gu0_probe(C); SEAM(6, 0); }
#endif
    RPT(REP_FFN0, if (IN(S_GU0)) { phase_fgemm_gu0(C); SEAM(6, 0); }
    if (IN(S_DN0)) { phase_fgemm_dn0(C); SEAM(7, 0); })
    if (IN(S_THIN0B)) { phase_thin0b(C); SEAM(8, NFILL_L1); }
    RPT(REP_PROJ, if (IN(S_IN1)) { phase_fgemm_in1(C); SEAM(9, 0); })
    RPT(REP_ATT1, if (IN(S_ATT1)) { phase_attn1_fast(C); SEAMP(); })
#ifdef PROBE_ATT1
    if (IN(S_ATT1)) { phase_attn1_probe(C); SEAMP(); }
#endif
    RPT(REP_PROJ, if (IN(S_OUT1)) { phase_fgemm(C, C.hb(), (const bf16*)(ws + WS_WOUT1), NLAT / 256, D / 256, D, (bf16*)(ws + WS_YA), D); SEAMP(); })
    if (IN(S_THIN1A)) { phase_thin1a(C); SEAM(12, NFILL); }
    RPT(REP_MOE, if (IN(S_MOE)) { phase_moe_gu_fast(C); SEAMP(); }
    if (IN(S_MOE + 1)) { phase_moe_dn_fast(C); SEAMP(); })
    if (IN(S_FINAL)) phase_final(C);
#undef IN
#undef SEAM
#undef SEAMP
}

extern "C" void kernel_launch(void* const* d_in, const int* in_sizes, int n_in, void* d_out, int out_size, void* d_ws, size_t ws_size, hipStream_t stream) {
    static int grid = 0;
    if (grid == 0) {
        if (n_in != 31 || out_size != NLAT * D || ws_size < WS_MIN) { fprintf(stderr, "kernel_launch: unexpected problem (n_in %d out %d ws %zu)\n", n_in, out_size, ws_size); grid = -1; return; }
        int dev = 0, cus = 0;
        if (hipGetDevice(&dev) != hipSuccess || hipDeviceGetAttribute(&cus, hipDeviceAttributeMultiprocessorCount, dev) != hipSuccess) { grid = -1; return; }
        if (hipFuncSetAttribute((const void*)k_run, hipFuncAttributeMaxDynamicSharedMemorySize, LDS_BYTES) != hipSuccess) { grid = -1; return; }
        grid = cus;
    }
    if (grid < 0) return;
    (void)hipMemsetAsync((char*)d_ws + WS_CTL, 0, CTL_ZERO_BYTES, stream);
    Params p{};
    for (int i = 0; i < 31; ++i) p.in[i] = (const float*)d_in[i];
    p.out = (float*)d_out; p.ws = (unsigned char*)d_ws;
    p.tpc = 0; p.pad = 0;
#if MK_ONE_LAUNCH
    hipLaunchKernelGGL(k_run, dim3(grid), dim3(NT), LDS_BYTES, stream, p, 0, S_END);
#else
    for (int s = 0; s < S_END; ++s) hipLaunchKernelGGL(k_run, dim3(grid), dim3(NT), LDS_BYTES, stream, p, s, s + 1);
#endif
}
```

```cpp
#include <hip/hip_runtime.h>
#include <cstdint>
#include <cstdio>

#define GAS __attribute__((address_space(1)))
#define LAS __attribute__((address_space(3)))
typedef unsigned short bf16;
typedef float f32x4 __attribute__((ext_vector_type(4)));
typedef float f32x2 __attribute__((ext_vector_type(2)));
typedef unsigned u32x4 __attribute__((ext_vector_type(4)));
typedef unsigned u32x2 __attribute__((ext_vector_type(2)));

constexpr int D = 1024, NB = 16, SEQ = 2048, NLAT = NB * SEQ, CTXL = 256, NCTX = NB * CTXL, MTOT = NLAT + NCTX;
constexpr int NQKV0 = 1536, NQKV1 = 3072, FF0 = 2816, FFE = 3584, NE = 8, NMOD = 6;
constexpr int MAXTILES = 264;
constexpr int MAXCH = 4;
constexpr float EPS = 1e-6f;
constexpr float LOG2E = 1.4426950408889634f;
constexpr float QSCALE = 0.125f * LOG2E;
constexpr float W8GU_SCALE = 32.f, W8DN_SCALE = 64.f;
constexpr float W8DN0_SCALE = 64.f, ACT0_SCALE = 8.f;

constexpr size_t MiB = 1u << 20;
constexpr size_t WS_CTL = 0, CTL_ZERO_BYTES = 1 * MiB;
constexpr size_t WS_MODS = 1 * MiB;
constexpr size_t WS_RE = 2 * MiB;
constexpr size_t WS_RW = WS_RE + 256 * 1024;
constexpr size_t WS_RJ = WS_RW + 256 * 1024;
constexpr size_t WS_HS = WS_RJ + 256 * 1024;
constexpr size_t WS_TOKOF = 3 * MiB;
constexpr size_t WS_CTXS = 4 * MiB;
constexpr size_t WS_WIN1 = 20 * MiB, WS_WOUT1 = 26 * MiB;
constexpr size_t WS_W8GU = 28 * MiB, WS_W8DN = 84 * MiB;
constexpr size_t WS_H8 = 112 * MiB;
constexpr size_t WS_HB = 196 * MiB;
constexpr size_t WS_WIN0 = 268 * MiB, WS_WOUT0 = 271 * MiB, WS_WGU0 = 273 * MiB, WS_WDN0 = 284 * MiB;
constexpr size_t WS_OV = 290 * MiB;
constexpr size_t WS_QKV = WS_OV;
constexpr size_t WS_YA = WS_OV;
constexpr size_t WS_ACT0 = WS_OV;
constexpr size_t WS_YB = 488 * MiB;
constexpr size_t WS_ACT8 = 144 * MiB;
constexpr size_t WS_YS = 375 * MiB;
constexpr size_t WS_X3 = 507 * MiB;
constexpr size_t WS_MIN = 571 * MiB;
constexpr int CW_CNT = 64;
constexpr int CW_FILL = 128;
constexpr int CW_DONE = 192;
constexpr int CW_CM = 65536;
constexpr int CM_IN0 = CW_CM, CM_GU0 = CW_CM + 1536, CM_IN1 = CM_GU0 + 5632;
constexpr int CW_BAR = 4096;
constexpr int ROPE_OFF = 131072 + 1024;
constexpr int MISC_OFF = 131072 + 320;

constexpr int TOK_OFF = 131072 + 1024 + 9216;
constexpr int LDS_BYTES = TOK_OFF + 8192;
constexpr int NWAVES = 8, NT = 512;

struct Params {
    const float* in[31];
    float* out;
    unsigned char* ws;
    int tpc;
    int pad;
};

__device__ __forceinline__ unsigned f2bf(float f) { unsigned u = __builtin_bit_cast(unsigned, f); return (u + 0x7fffu + ((u >> 16) & 1u)) >> 16; }
__device__ __forceinline__ unsigned pk2(float lo, float hi) { return f2bf(lo) | (f2bf(hi) << 16); }
__device__ __forceinline__ unsigned pk4_fp8(float a, float b, float c, float d) { unsigned r = 0; r = __builtin_amdgcn_cvt_pk_fp8_f32(a, b, r, false); r = __builtin_amdgcn_cvt_pk_fp8_f32(c, d, r, true); return r; }
__device__ __forceinline__ float bflo(unsigned w) { return __builtin_bit_cast(float, w << 16); }
__device__ __forceinline__ float bfhi(unsigned w) { return __builtin_bit_cast(float, w & 0xffff0000u); }
__device__ __forceinline__ float bf2f(bf16 b) { return __builtin_bit_cast(float, (unsigned)b << 16); }
__device__ __forceinline__ float wave_sum(float v) {
#pragma unroll
    for (int o = 1; o < 64; o <<= 1) v += __shfl_xor(v, o);
    return v;
}
__device__ __forceinline__ float wave_max(float v) {
#pragma unroll
    for (int o = 1; o < 64; o <<= 1) v = fmaxf(v, __shfl_xor(v, o));
    return v;
}
__device__ __forceinline__ float silu_f(float v) { return v / (1.f + __expf(-v)); }

struct Row16 { f32x4 v[4]; };
__device__ __forceinline__ void ld_f32(Row16& r, const float* p, int lane) {
    const f32x4* q = (const f32x4*)p + lane;
#pragma unroll
    for (int j = 0; j < 4; ++j) r.v[j] = q[64 * j];
}
__device__ __forceinline__ void st_f32(const Row16& r, float* p, int lane) {
    f32x4* q = (f32x4*)p + lane;
#pragma unroll
    for (int j = 0; j < 4; ++j) q[64 * j] = r.v[j];
}
__device__ __forceinline__ void ld_bf(Row16& r, const bf16* p, int lane) {
    const u32x2* q = (const u32x2*)p + lane;
#pragma unroll
    for (int j = 0; j < 4; ++j) { const u32x2 w = q[64 * j]; r.v[j] = (f32x4){bflo(w.x), bfhi(w.x), bflo(w.y), bfhi(w.y)}; }
}
__device__ __forceinline__ void st_bf(const Row16& r, bf16* p, int lane) {
    u32x2* q = (u32x2*)p + lane;
#pragma unroll
    for (int j = 0; j < 4; ++j) { u32x2 w; w.x = pk2(r.v[j][0], r.v[j][1]); w.y = pk2(r.v[j][2], r.v[j][3]); q[64 * j] = w; }
}
__device__ __forceinline__ float row_rstd(const Row16& r) {
    float s = 0.f;
#pragma unroll
    for (int j = 0; j < 4; ++j) s += (r.v[j][0] * r.v[j][0] + r.v[j][1] * r.v[j][1]) + (r.v[j][2] * r.v[j][2] + r.v[j][3] * r.v[j][3]);
    return rsqrtf(wave_sum(s) * (1.f / D) + EPS);
}

#define XB_TMO      128
#define XB_XCNT(j)  (256  + 64 * (j))
#define XB_XSUB(j)  (1280 + 64 * (j))
#define XB_XGEN(j)  (2304 + 64 * (j))
#define XB_TOP      3328
#define XB_TOPGEN   3392
#define XCD_BAR_WORDS 3456
#define XB_SPIN_CAP (1u << 18)

__device__ __forceinline__ unsigned xb_ld(unsigned* p)              { return __hip_atomic_load(p, __ATOMIC_RELAXED, __HIP_MEMORY_SCOPE_AGENT); }
__device__ __forceinline__ unsigned xb_add(unsigned* p, unsigned v) { return __hip_atomic_fetch_add(p, v, __ATOMIC_RELAXED, __HIP_MEMORY_SCOPE_AGENT); }
__device__ __forceinline__ unsigned xb_xcc_id() { return (unsigned)__builtin_amdgcn_s_getreg((3 << 11) | 20) & 0xFu; }
#define XB_SPIN(cond, bar) do { unsigned _sp = 0; while (cond) { __builtin_amdgcn_s_sleep(1); \
    if ((++_sp & 255u) == 0u) { if (xb_ld(&(bar)[XB_TMO])) break; if (_sp > XB_SPIN_CAP) { atomicAdd(&(bar)[XB_TMO], 1u); break; } } } } while (0)

struct XcdBarrier {
    unsigned* bar; unsigned x;
    volatile LAS unsigned* st;
};

__device__ __forceinline__ XcdBarrier xcd_barrier_post(unsigned* bar, volatile LAS unsigned* st) {
    XcdBarrier b; b.bar = bar; b.x = xb_xcc_id(); b.st = st;
    if (threadIdx.x == 0) (void)xb_add(&bar[XB_XCNT(b.x)], 1u);
    return b;
}
__device__ __forceinline__ void xcd_barrier_complete(unsigned* bar, unsigned x, unsigned& nloc, unsigned& nx) {
    const unsigned G = gridDim.x * gridDim.y * gridDim.z;
    unsigned sum, cnt, mine, sp = 0u;
    for (;;) {
        sum = 0u; cnt = 0u; mine = 0u;
#pragma unroll
        for (unsigned j = 0; j < 16; ++j) { const unsigned c = xb_ld(&bar[XB_XCNT(j)]); sum += c; cnt += (c > 0u) ? 1u : 0u; mine = (j == x) ? c : mine; }
        if (sum == G) break;
        __builtin_amdgcn_s_sleep(1);
        if ((++sp & 255u) == 0u) { if (xb_ld(&bar[XB_TMO])) break; if (sp > XB_SPIN_CAP) { atomicAdd(&bar[XB_TMO], 1u); break; } }
    }
    nloc = mine > 0u ? mine : 1u; nx = cnt > 0u ? cnt : 1u;
}

__device__ __forceinline__ void xcd_barrier(const XcdBarrier& b) {
    asm volatile("s_waitcnt vmcnt(0)" ::: "memory");
    __syncthreads();
    if (threadIdx.x == 0) {
        unsigned* bar = b.bar;
        __builtin_amdgcn_s_waitcnt(0);
        unsigned nloc = b.st[0], nx = b.st[1];
        if (nloc == 0u) { xcd_barrier_complete(bar, b.x, nloc, nx); b.st[0] = nloc; b.st[1] = nx; }
        const unsigned old = xb_add(&bar[XB_XSUB(b.x)], 1u);
        const unsigned gen = old / nloc;
        if (old + 1u == (gen + 1u) * nloc) {
            __builtin_amdgcn_fence(__ATOMIC_RELEASE, "agent");
            asm volatile("s_waitcnt vmcnt(0)" ::: "memory");
            const unsigned og = xb_add(&bar[XB_TOP], 1u);
            const unsigned tg = og / nx;
            if (og + 1u == (tg + 1u) * nx) xb_add(&bar[XB_TOPGEN], 1u);
            else XB_SPIN(xb_ld(&bar[XB_TOPGEN]) == tg, bar);
            __builtin_amdgcn_fence(__ATOMIC_ACQUIRE, "agent");
            xb_add(&bar[XB_XGEN(b.x)], 1u);
            asm volatile("s_waitcnt vmcnt(0)" ::: "memory");
        } else {
            XB_SPIN(xb_ld(&bar[XB_XGEN(b.x)]) == gen, bar);
            __builtin_amdgcn_fence(__ATOMIC_ACQUIRE, "agent");
            asm volatile("s_waitcnt vmcnt(0)" ::: "memory");
        }
    }
    __syncthreads();
}

__device__ __forceinline__ void st_q8(const Row16& h, unsigned char* qrow, float* scale_out, int lane) {
    float am = 0.f;
#pragma unroll
    for (int j = 0; j < 4; ++j) am = fmaxf(fmaxf(am, fmaxf(fabsf(h.v[j][0]), fabsf(h.v[j][1]))), fmaxf(fabsf(h.v[j][2]), fabsf(h.v[j][3])));
    am = fmaxf(wave_max(am), 1e-20f);
    const float inv = 127.f / am;
    unsigned* q = (unsigned*)qrow + lane;
#pragma unroll
    for (int j = 0; j < 4; ++j) { const int a = (int)__builtin_rintf(h.v[j][0] * inv), b = (int)__builtin_rintf(h.v[j][1] * inv), c = (int)__builtin_rintf(h.v[j][2] * inv), d = (int)__builtin_rintf(h.v[j][3] * inv);
        q[64 * j] = (unsigned)(a & 255) | ((unsigned)(b & 255) << 8) | ((unsigned)(c & 255) << 16) | ((unsigned)d << 24); }
    if (lane == 0) *scale_out = am * (1.f / 127.f);
}
struct Ctx {
    Params p;
    LAS unsigned char* lds;
    int tid, lane, wave, vcu, G;
    __device__ __forceinline__ const float* mods(int layer, int r) const { return (const float*)(p.ws + WS_MODS) + ((size_t)layer * 17 + r) * (NMOD * D); }
    __device__ __forceinline__ bf16* hb() const { return (bf16*)(p.ws + WS_HB); }
    __device__ __forceinline__ unsigned* ctl() const { return (unsigned*)(p.ws + WS_CTL); }
};

struct TileTab { int tb[9]; int cnt[8]; };
__device__ __forceinline__ void load_tiletab(const Ctx& C, TileTab& T) {
    int acc = 0;
#pragma unroll
    for (int e = 0; e < NE; ++e) { const int c = __builtin_amdgcn_readfirstlane((int)__hip_atomic_load(C.ctl() + CW_CNT + e, __ATOMIC_RELAXED, __HIP_MEMORY_SCOPE_AGENT)); T.cnt[e] = c; T.tb[e] = acc; acc += (c + 255) >> 8; }
    T.tb[8] = acc;
}
__device__ __forceinline__ int tile_expert(const TileTab& T, int st) {
    int e = 0;
#pragma unroll
    for (int k = 1; k < NE; ++k) e += (st >= T.tb[k]) ? 1 : 0;
    return e;
}

__device__ __forceinline__ void phase_mods(const Ctx& C) {
    LAS float* sl = (LAS float*)C.lds;
    LAS float* part = (LAS float*)(C.lds + 17 * 1024 * 4);
    const float* cin = C.p.in[1]; const float* cctx = C.p.in[3];
    for (int i = C.tid; i < 17 * 1024; i += NT) { const float v = (i < 16 * 1024) ? cin[i] : cctx[i - 16 * 1024]; sl[i] = silu_f(v); }
    __syncthreads();
    const int nitems = 2 * (NMOD * D / 64);
    for (int it = C.vcu; it < nitems; it += C.G) {
        const int layer = it / (NMOD * D / 64), cb = it % (NMOD * D / 64);
        const float* W = C.p.in[layer == 0 ? 4 : 18]; const float* Bv = C.p.in[layer == 0 ? 5 : 19];
        const int col = cb * 64 + C.lane;
        float acc[17];
#pragma unroll
        for (int r = 0; r < 17; ++r) acc[r] = 0.f;
        const int k0 = C.wave * 128;
        float wa[8], wb[8];
#define MODS_LD(w, kb) do { const float* Wk_ = W + (size_t)(kb) * (NMOD * D) + col; _Pragma("unroll") for (int u = 0; u < 8; ++u) w[u] = Wk_[(size_t)u * (NMOD * D)]; } while (0)
#define MODS_FMA(w, kb) do { _Pragma("unroll") for (int u4 = 0; u4 < 2; ++u4) _Pragma("unroll") for (int r = 0; r < 17; ++r) { const f32x4 s = *(const LAS f32x4*)(sl + r * 1024 + (kb) + 4 * u4); \
            acc[r] += s[0] * w[4 * u4] + s[1] * w[4 * u4 + 1] + s[2] * w[4 * u4 + 2] + s[3] * w[4 * u4 + 3]; } } while (0)
        MODS_LD(wa, k0);
#pragma nounroll
        for (int kb = k0; kb < k0 + 128; kb += 16) {
            MODS_LD(wb, kb + 8);
            MODS_FMA(wa, kb);
            if (kb + 16 < k0 + 128) MODS_LD(wa, kb + 16);
            MODS_FMA(wb, kb + 8);
        }
#undef MODS_LD
#undef MODS_FMA
#pragma unroll
        for (int r = 0; r < 17; ++r) part[(C.wave * 17 + r) * 64 + C.lane] = acc[r];
        __syncthreads();
        for (int o = C.tid; o < 17 * 64; o += NT) {
            const int r = o / 64, c = o % 64; float s = 0.f;
#pragma unroll
            for (int w = 0; w < 8; ++w) s += part[(w * 17 + r) * 64 + c];
            ((float*)(C.p.ws + WS_MODS))[((size_t)layer * 17 + r) * (NMOD * D) + cb * 64 + c] = s + Bv[cb * 64 + c];
        }
        __syncthreads();
    }
}

__device__ __forceinline__ void modulate_row(const Row16& x, Row16& h, const float* g, const float* shift, const float* scale, int lane) {
    const float rs = row_rstd(x);
    Row16 gv, sh, sc; ld_f32(gv, g, lane); ld_f32(sh, shift, lane); ld_f32(sc, scale, lane);
#pragma unroll
    for (int j = 0; j < 4; ++j) h.v[j] = x.v[j] * rs * gv.v[j] * (1.f + sc.v[j]) + sh.v[j];
}
__device__ __forceinline__ void ld_lds(Row16& r, const LAS float* p, int lane) {
    const LAS f32x4* q = (const LAS f32x4*)p + lane;
#pragma unroll
    for (int j = 0; j < 4; ++j) r.v[j] = q[64 * j];
}
__device__ __forceinline__ void modulate_row_l(const Row16& x, Row16& h, const LAS float* g, const LAS float* shift, const LAS float* scale, int lane) {
    const float rs = row_rstd(x);
    Row16 gv, sh, sc; ld_lds(gv, g, lane); ld_lds(sh, shift, lane); ld_lds(sc, scale, lane);
#pragma unroll
    for (int j = 0; j < 4; ++j) h.v[j] = x.v[j] * rs * gv.v[j] * (1.f + sc.v[j]) + sh.v[j];
}
__device__ __forceinline__ void resid_row_l(Row16& x, const Row16& y, const LAS float* g, const LAS float* gate, int lane) {
    const float rs = row_rstd(y);
    Row16 gv, ga; ld_lds(gv, g, lane); ld_lds(ga, gate, lane);
#pragma unroll
    for (int j = 0; j < 4; ++j) x.v[j] = x.v[j] + ga.v[j] * (y.v[j] * rs * gv.v[j]);
}
__device__ __forceinline__ void stage5(const Ctx& C, int set, const float* v0, const float* v1, const float* v2, const float* v3, const float* v4, int base = 0) {
    LAS f32x4* P = (LAS f32x4*)(C.lds + base + set * 5 * D * 4);
    int tid_ = C.tid; asm volatile("" : "+v"(tid_));
    for (int i = tid_; i < 5 * D / 4; i += NT) { const int v = i / (D / 4), k = i % (D / 4); const float* src = (v == 0) ? v0 : (v == 1) ? v1 : (v == 2) ? v2 : (v == 3) ? v3 : v4; P[i] = ((const f32x4*)src)[k]; }
}
__device__ __forceinline__ int thin_row(const Ctx& C, int t) {
    return (t < 8) ? (C.vcu >> 4) * SEQ + (C.vcu & 15) * 128 + C.wave * 16 + 2 * t : NLAT + C.vcu * 16 + C.wave * 2;
}
__device__ __forceinline__ void resid_row(Row16& x, const Row16& y, const float* g, const float* gate, int lane) {
    const float rs = row_rstd(y);
    Row16 gv, ga; ld_f32(gv, g, lane); ld_f32(ga, gate, lane);
#pragma unroll
    for (int j = 0; j < 4; ++j) x.v[j] = x.v[j] + ga.v[j] * (y.v[j] * rs * gv.v[j]);
}

__device__ __forceinline__ void modulate0_generic(const Ctx& C) {
    const int gw = C.vcu * NWAVES + C.wave, NGW = C.G * NWAVES;
    Row16 x0, x1, nx0, nx1, h;
#define M0_LD(a0, a1, mm) do { const float* xin_ = ((mm) < NLAT) ? C.p.in[0] + (size_t)(mm) * D : C.p.in[2] + (size_t)((mm) - NLAT) * D; ld_f32(a0, xin_, C.lane); ld_f32(a1, xin_ + D, C.lane); } while (0)
    if (gw < MTOT / 2) M0_LD(x0, x1, 2 * gw);
    for (int mp = gw; mp < MTOT / 2; mp += NGW) {
        const int m = 2 * mp;
        const bool lat = m < NLAT; const int r = lat ? m / SEQ : 16;
        const float* md = C.mods(0, r);
        const bool more = mp + NGW < MTOT / 2;
        if (more) M0_LD(nx0, nx1, 2 * (mp + NGW));
        modulate_row(x0, h, C.p.in[6], md + 0 * D, md + 1 * D, C.lane);
        st_q8(h, C.p.ws + WS_HB + (size_t)m * D, (float*)(C.p.ws + WS_HS) + m, C.lane);
        modulate_row(x1, h, C.p.in[6], md + 0 * D, md + 1 * D, C.lane);
        st_q8(h, C.p.ws + WS_HB + (size_t)(m + 1) * D, (float*)(C.p.ws + WS_HS) + m + 1, C.lane);
        if (more) { x0 = nx0; x1 = nx1; }
    }
#undef M0_LD
}
__device__ __forceinline__ void phase_modulate0(const Ctx& C) {
    int ln = C.lane; asm volatile("" : "+v"(ln));
    if (C.G != 256) { modulate0_generic(C); return; }
    { const float* md = C.mods(0, C.vcu >> 4); const float* mc = C.mods(0, 16);
      stage5(C, 0, C.p.in[6], md, md + D, md, md); stage5(C, 1, C.p.in[6], mc, mc + D, mc, mc); }
    __syncthreads();
    Row16 x0, x1, nx0, nx1, h;
#define M0_LD(a0, a1, mm) do { const float* xin_ = ((mm) < NLAT) ? C.p.in[0] + (size_t)(mm) * D : C.p.in[2] + (size_t)((mm) - NLAT) * D; ld_f32(a0, xin_, ln); ld_f32(a1, xin_ + D, ln); } while (0)
    M0_LD(x0, x1, thin_row(C, 0));
#pragma nounroll
    for (int t = 0; t < 9; ++t) {
        const int m = thin_row(C, t);
        const LAS float* P = (const LAS float*)(C.lds + (t < 8 ? 0 : 5 * D * 4));
        if (t < 8) M0_LD(nx0, nx1, thin_row(C, t + 1));
        modulate_row_l(x0, h, P, P + D, P + 2 * D, ln);
        st_q8(h, C.p.ws + WS_HB + (size_t)m * D, (float*)(C.p.ws + WS_HS) + m, ln);
        modulate_row_l(x1, h, P, P + D, P + 2 * D, ln);
        st_q8(h, C.p.ws + WS_HB + (size_t)(m + 1) * D, (float*)(C.p.ws + WS_HS) + m + 1, ln);
        if (t < 8) { x0 = nx0; x1 = nx1; }
    }
#undef M0_LD
    __syncthreads();
}
__device__ __forceinline__ void thin0a_generic(const Ctx& C) {
    const int gw = C.vcu * NWAVES + C.wave, NGW = C.G * NWAVES;
    const bf16* Y = (const bf16*)(C.p.ws + WS_YA);
    Row16 x0, x1, y0, y1, nx0, nx1, ny0, ny1, h;
#define T0A_LD(a0, a1, b0, b1, mm) do { const float* xin_ = ((mm) < NLAT) ? C.p.in[0] + (size_t)(mm) * D : C.p.in[2] + (size_t)((mm) - NLAT) * D; \
        ld_f32(a0, xin_, C.lane); ld_f32(a1, xin_ + D, C.lane); ld_bf(b0, Y + (size_t)(mm) * D, C.lane); ld_bf(b1, Y + (size_t)((mm) + 1) * D, C.lane); } while (0)
    if (gw < MTOT / 2) T0A_LD(x0, x1, y0, y1, 2 * gw);
    for (int mp = gw; mp < MTOT / 2; mp += NGW) {
        const int m = 2 * mp;
        const bool lat = m < NLAT; const int r = lat ? m / SEQ : 16;
        const float* md = C.mods(0, r);
        const bool more = mp + NGW < MTOT / 2;
        if (more) T0A_LD(nx0, nx1, ny0, ny1, 2 * (mp + NGW));
        resid_row(x0, y0, C.p.in[7], md + 2 * D, C.lane);
        resid_row(x1, y1, C.p.in[7], md + 2 * D, C.lane);
        if (lat) { st_bf(x0, (bf16*)C.p.out + (size_t)m * D, C.lane); st_bf(x1, (bf16*)C.p.out + (size_t)(m + 1) * D, C.lane); }
        else { st_f32(x0, (float*)(C.p.ws + WS_CTXS) + (size_t)(m - NLAT) * D, C.lane); st_f32(x1, (float*)(C.p.ws + WS_CTXS) + (size_t)(m + 1 - NLAT) * D, C.lane); }
        modulate_row(x0, h, C.p.in[8], md + 3 * D, md + 4 * D, C.lane);
        st_q8(h, C.p.ws + WS_HB + (size_t)m * D, (float*)(C.p.ws + WS_HS) + m, C.lane);
        modulate_row(x1, h, C.p.in[8], md + 3 * D, md + 4 * D, C.lane);
        st_q8(h, C.p.ws + WS_HB + (size_t)(m + 1) * D, (float*)(C.p.ws + WS_HS) + m + 1, C.lane);
        if (more) { x0 = nx0; x1 = nx1; y0 = ny0; y1 = ny1; }
    }
#undef T0A_LD
}
__device__ __forceinline__ void phase_thin0a(const Ctx& C) {
    int ln = C.lane; asm volatile("" : "+v"(ln));
    const bf16* Y = (const bf16*)(C.p.ws + WS_YA);
    if (C.G != 256) { thin0a_generic(C); return; }
    { const float* md = C.mods(0, C.vcu >> 4); const float* mc = C.mods(0, 16);
      stage5(C, 0, C.p.in[7], md + 2 * D, C.p.in[8], md + 3 * D, md + 4 * D); stage5(C, 1, C.p.in[7], mc + 2 * D, C.p.in[8], mc + 3 * D, mc + 4 * D); }
    __syncthreads();
    Row16 x0, x1, y0, y1, nx0, nx1, ny0, ny1, h;
#define T0A_LD(a0, a1, b0, b1, mm) do { const float* xin_ = ((mm) < NLAT) ? C.p.in[0] + (size_t)(mm) * D : C.p.in[2] + (size_t)((mm) - NLAT) * D; \
        ld_f32(a0, xin_, ln); ld_f32(a1, xin_ + D, ln); ld_bf(b0, Y + (size_t)(mm) * D, ln); ld_bf(b1, Y + (size_t)((mm) + 1) * D, ln); } while (0)
    T0A_LD(x0, x1, y0, y1, thin_row(C, 0));
#pragma nounroll
    for (int t = 0; t < 9; ++t) {
        const int m = thin_row(C, t);
        const bool lat = t < 8;
        const LAS float* P = (const LAS float*)(C.lds + (lat ? 0 : 5 * D * 4));
        if (t < 8) T0A_LD(nx0, nx1, ny0, ny1, thin_row(C, t + 1));
        resid_row_l(x0, y0, P, P + D, ln);
        resid_row_l(x1, y1, P, P + D, ln);
        if (lat) { st_bf(x0, (bf16*)C.p.out + (size_t)m * D, ln); st_bf(x1, (bf16*)C.p.out + (size_t)(m + 1) * D, ln); }
        else { st_f32(x0, (float*)(C.p.ws + WS_CTXS) + (size_t)(m - NLAT) * D, ln); st_f32(x1, (float*)(C.p.ws + WS_CTXS) + (size_t)(m + 1 - NLAT) * D, ln); }
        modulate_row_l(x0, h, P + 2 * D, P + 3 * D, P + 4 * D, ln);
        st_q8(h, C.p.ws + WS_HB + (size_t)m * D, (float*)(C.p.ws + WS_HS) + m, ln);
        modulate_row_l(x1, h, P + 2 * D, P + 3 * D, P + 4 * D, ln);
        st_q8(h, C.p.ws + WS_HB + (size_t)(m + 1) * D, (float*)(C.p.ws + WS_HS) + m + 1, ln);
        if (t < 8) { x0 = nx0; x1 = nx1; y0 = ny0; y1 = ny1; }
    }
#undef T0A_LD
    __syncthreads();
}
__device__ __forceinline__ void thin0b_generic(const Ctx& C) {
    const int gw = C.vcu * NWAVES + C.wave, NGW = C.G * NWAVES;
    const bf16* Y = (const bf16*)(C.p.ws + WS_YB);
    Row16 x0, x1, y0, y1, nx0, nx1, ny0, ny1, h;
#define T0B_LD(a0, a1, b0, b1, mm) do { \
        if ((mm) < NLAT) { ld_bf(a0, (const bf16*)C.p.out + (size_t)(mm) * D, C.lane); ld_bf(a1, (const bf16*)C.p.out + (size_t)((mm) + 1) * D, C.lane); } \
        else { ld_f32(a0, (const float*)(C.p.ws + WS_CTXS) + (size_t)((mm) - NLAT) * D, C.lane); ld_f32(a1, (const float*)(C.p.ws + WS_CTXS) + (size_t)((mm) + 1 - NLAT) * D, C.lane); } \
        ld_bf(b0, Y + (size_t)(mm) * D, C.lane); ld_bf(b1, Y + (size_t)((mm) + 1) * D, C.lane); } while (0)
    if (gw < MTOT / 2) T0B_LD(x0, x1, y0, y1, 2 * gw);
    for (int mp = gw; mp < MTOT / 2; mp += NGW) {
        const int m = 2 * mp;
        const bool lat = m < NLAT; const int r = lat ? m / SEQ : 16;
        const float* md0 = C.mods(0, r); const float* md1 = C.mods(1, r);
        const bool more = mp + NGW < MTOT / 2;
        if (more) T0B_LD(nx0, nx1, ny0, ny1, 2 * (mp + NGW));
        resid_row(x0, y0, C.p.in[9], md0 + 5 * D, C.lane);
        resid_row(x1, y1, C.p.in[9], md0 + 5 * D, C.lane);
        if (lat) { st_bf(x0, (bf16*)C.p.out + (size_t)m * D, C.lane); st_bf(x1, (bf16*)C.p.out + (size_t)(m + 1) * D, C.lane); }
        modulate_row(x0, h, C.p.in[20], md1 + 0 * D, md1 + 1 * D, C.lane);
        st_q8(h, C.p.ws + WS_HB + (size_t)m * D, (float*)(C.p.ws + WS_HS) + m, C.lane);
        modulate_row(x1, h, C.p.in[20], md1 + 0 * D, md1 + 1 * D, C.lane);
        st_q8(h, C.p.ws + WS_HB + (size_t)(m + 1) * D, (float*)(C.p.ws + WS_HS) + m + 1, C.lane);
        if (more) { x0 = nx0; x1 = nx1; y0 = ny0; y1 = ny1; }
    }
#undef T0B_LD
}
__device__ __forceinline__ void phase_thin0b(const Ctx& C) {
    int ln = C.lane; asm volatile("" : "+v"(ln));
    const bf16* Y = (const bf16*)(C.p.ws + WS_YB);
    if (C.G != 256) { thin0b_generic(C); return; }
    { const float* m0 = C.mods(0, C.vcu >> 4); const float* m1 = C.mods(1, C.vcu >> 4); const float* c0 = C.mods(0, 16); const float* c1 = C.mods(1, 16);
      stage5(C, 0, C.p.in[9], m0 + 5 * D, C.p.in[20], m1, m1 + D); stage5(C, 1, C.p.in[9], c0 + 5 * D, C.p.in[20], c1, c1 + D); }
    __syncthreads();
    Row16 x0, x1, y0, y1, nx0, nx1, ny0, ny1, h;
#define T0B_LD(a0, a1, b0, b1, mm) do { \
        if ((mm) < NLAT) { ld_bf(a0, (const bf16*)C.p.out + (size_t)(mm) * D, ln); ld_bf(a1, (const bf16*)C.p.out + (size_t)((mm) + 1) * D, ln); } \
        else { ld_f32(a0, (const float*)(C.p.ws + WS_CTXS) + (size_t)((mm) - NLAT) * D, ln); ld_f32(a1, (const float*)(C.p.ws + WS_CTXS) + (size_t)((mm) + 1 - NLAT) * D, ln); } \
        ld_bf(b0, Y + (size_t)(mm) * D, ln); ld_bf(b1, Y + (size_t)((mm) + 1) * D, ln); } while (0)
    T0B_LD(x0, x1, y0, y1, thin_row(C, 0));
#pragma nounroll
    for (int t = 0; t < 9; ++t) {
        const int m = thin_row(C, t);
        const bool lat = t < 8;
        const LAS float* P = (const LAS float*)(C.lds + (lat ? 0 : 5 * D * 4));
        if (t < 8) T0B_LD(nx0, nx1, ny0, ny1, thin_row(C, t + 1));
        resid_row_l(x0, y0, P, P + D, ln);
        resid_row_l(x1, y1, P, P + D, ln);
        if (lat) { st_bf(x0, (bf16*)C.p.out + (size_t)m * D, ln); st_bf(x1, (bf16*)C.p.out + (size_t)(m + 1) * D, ln); }
        modulate_row_l(x0, h, P + 2 * D, P + 3 * D, P + 4 * D, ln);
        st_q8(h, C.p.ws + WS_HB + (size_t)m * D, (float*)(C.p.ws + WS_HS) + m, ln);
        modulate_row_l(x1, h, P + 2 * D, P + 3 * D, P + 4 * D, ln);
        st_q8(h, C.p.ws + WS_HB + (size_t)(m + 1) * D, (float*)(C.p.ws + WS_HS) + m + 1, ln);
        if (t < 8) { x0 = nx0; x1 = nx1; y0 = ny0; y1 = ny1; }
    }
#undef T0B_LD
    __syncthreads();
}
__device__ __forceinline__ void thin1a_generic(const Ctx& C) {
    const int gw = C.vcu * NWAVES + C.wave, NGW = C.G * NWAVES;
    const bf16* Y = (const bf16*)(C.p.ws + WS_YA);
    LAS int* lcnt = (LAS int*)C.lds;
    LAS int* lrec = (LAS int*)(C.lds + 256);
    if (C.tid < 16) lcnt[C.tid] = 0;
    __syncthreads();
    const float* wr = C.p.in[27];
    int* RE = (int*)(C.p.ws + WS_RE); float* RW = (float*)(C.p.ws + WS_RW); int* RJ = (int*)(C.p.ws + WS_RJ);
    int it = 0;
    LAS float* wl = (LAS float*)(C.lds + 16384);
    for (int i = C.tid; i < D * 8 / 4; i += NT) { const int col = i >> 1, hh = i & 1;
        ((LAS f32x4*)wl)[(((col >> 8) * 4 + (col & 3)) * 2 + hh) * 64 + ((col & 255) >> 2)] = ((const f32x4*)wr)[i]; }
    __syncthreads();
    auto route = [&](int m, const float (&lg)[8], int it) {
        int e0 = 0; float v0 = lg[0];
#pragma unroll
        for (int e = 1; e < 8; ++e) if (lg[e] > v0) { v0 = lg[e]; e0 = e; }
        int e1 = (e0 == 0) ? 1 : 0; float v1 = (e0 == 0) ? lg[1] : lg[0];
#pragma unroll
        for (int e = 1; e < 8; ++e) if (e != e0 && e != e1 && lg[e] > v1) { v1 = lg[e]; e1 = e; }
        const float w1v = 1.f / (1.f + __expf(v0 - v1)), w0v = 1.f - w1v;
        if (C.lane == 0) {
            const int s0 = __hip_atomic_fetch_add(&lcnt[e0], 1, __ATOMIC_RELAXED, __HIP_MEMORY_SCOPE_WORKGROUP), s1 = __hip_atomic_fetch_add(&lcnt[e1], 1, __ATOMIC_RELAXED, __HIP_MEMORY_SCOPE_WORKGROUP);
            LAS int* rec = lrec + (C.wave * 64 + (it & 63)) * 4; rec[0] = e0; rec[1] = e1; rec[2] = s0; rec[3] = s1;
            RE[2 * m] = e0; RE[2 * m + 1] = e1; RW[2 * m] = w0v; RW[2 * m + 1] = w1v;
        }
    };
    auto do_pair = [&](int m, Row16& xa, const Row16& ya, Row16& xb, const Row16& yb, const float* md, int it) {
        Row16 ha, hb;
        resid_row(xa, ya, C.p.in[21], md + 2 * D, C.lane); resid_row(xb, yb, C.p.in[21], md + 2 * D, C.lane);
        st_bf(xa, (bf16*)(C.p.ws + WS_X3) + (size_t)m * D, C.lane); st_bf(xb, (bf16*)(C.p.ws + WS_X3) + (size_t)(m + 1) * D, C.lane);
        modulate_row(xa, ha, C.p.in[22], md + 3 * D, md + 4 * D, C.lane); modulate_row(xb, hb, C.p.in[22], md + 3 * D, md + 4 * D, C.lane);
        { unsigned* h8 = (unsigned*)(C.p.ws + WS_H8 + (size_t)m * D) + C.lane;
#pragma unroll
          for (int j = 0; j < 4; ++j) { h8[64 * j] = pk4_fp8(ha.v[j][0], ha.v[j][1], ha.v[j][2], ha.v[j][3]); h8[D / 4 + 64 * j] = pk4_fp8(hb.v[j][0], hb.v[j][1], hb.v[j][2], hb.v[j][3]); } }
        float la[8], lb[8];
#pragma unroll
        for (int e = 0; e < 8; ++e) { la[e] = 0.f; lb[e] = 0.f; }
#pragma unroll
        for (int j = 0; j < 4; ++j)
#pragma unroll
            for (int i = 0; i < 4; ++i) {
                const f32x4 w0 = ((const LAS f32x4*)wl)[((j * 4 + i) * 2 + 0) * 64 + C.lane], w1 = ((const LAS f32x4*)wl)[((j * 4 + i) * 2 + 1) * 64 + C.lane];
                const float va = ha.v[j][i], vb = hb.v[j][i];
                la[0] += va * w0[0]; la[1] += va * w0[1]; la[2] += va * w0[2]; la[3] += va * w0[3]; la[4] += va * w1[0]; la[5] += va * w1[1]; la[6] += va * w1[2]; la[7] += va * w1[3];
                lb[0] += vb * w0[0]; lb[1] += vb * w0[1]; lb[2] += vb * w0[2]; lb[3] += vb * w0[3]; lb[4] += vb * w1[0]; lb[5] += vb * w1[1]; lb[6] += vb * w1[2]; lb[7] += vb * w1[3];
            }
#pragma unroll
        for (int e = 0; e < 8; ++e) { la[e] = wave_sum(la[e]); lb[e] = wave_sum(lb[e]); }
        route(m, la, it); route(m + 1, lb, it + 1);
    };
    Row16 x0, x1, y0, y1, nx0, nx1, ny0, ny1;
#define T1A_LD(a0, a1, b0, b1, mm) do { ld_bf(a0, (const bf16*)C.p.out + (size_t)(mm) * D, C.lane); ld_bf(a1, (const bf16*)C.p.out + (size_t)((mm) + 1) * D, C.lane); \
        ld_bf(b0, Y + (size_t)(mm) * D, C.lane); ld_bf(b1, Y + (size_t)((mm) + 1) * D, C.lane); } while (0)
    if (gw < NLAT / 2) T1A_LD(x0, x1, y0, y1, 2 * gw);
    for (int mp = gw; mp < NLAT / 2; mp += NGW, it += 2) {
        const int m = 2 * mp;
        const float* md = C.mods(1, m / SEQ);
        const bool more = mp + NGW < NLAT / 2;
        if (more) T1A_LD(nx0, nx1, ny0, ny1, 2 * (mp + NGW));
        do_pair(m, x0, y0, x1, y1, md, it);
        if (more) { x0 = nx0; x1 = nx1; y0 = ny0; y1 = ny1; }
    }
#undef T1A_LD
    __syncthreads();
    if (C.tid < 8) lcnt[8 + C.tid] = (int)__hip_atomic_fetch_add(C.ctl() + CW_CNT + C.tid, (unsigned)lcnt[C.tid], __ATOMIC_RELAXED, __HIP_MEMORY_SCOPE_AGENT);
    __syncthreads();
    int* TOKOF = (int*)(C.p.ws + WS_TOKOF);
    it = 0;
    for (int mp = gw; mp < NLAT / 2; mp += NGW)
      for (int q = 0; q < 2; ++q, ++it) { const int m = 2 * mp + q;
        if (C.lane == 0) {
            LAS int* rec = lrec + (C.wave * 64 + (it & 63)) * 4; const int e0 = rec[0], e1 = rec[1];
            const int j0 = lcnt[8 + e0] + rec[2], j1 = lcnt[8 + e1] + rec[3];
            RJ[2 * m] = j0; RJ[2 * m + 1] = j1;
            TOKOF[e0 * NLAT + j0] = m; TOKOF[e1 * NLAT + j1] = m;
        }
    }
}
__device__ __forceinline__ void phase_thin1a(const Ctx& C) {
    if (C.G != 256) { thin1a_generic(C); return; }
    int ln = C.lane; asm volatile("" : "+v"(ln));
    const int gw = C.vcu * NWAVES + C.wave, NGW = C.G * NWAVES;
    const bf16* Y = (const bf16*)(C.p.ws + WS_YA);
    LAS int* lcnt = (LAS int*)C.lds;
    LAS int* lrec = (LAS int*)(C.lds + 256);
    if (C.tid < 16) lcnt[C.tid] = 0;
    __syncthreads();
    const float* wr = C.p.in[27];
    int* RE = (int*)(C.p.ws + WS_RE); float* RW = (float*)(C.p.ws + WS_RW); int* RJ = (int*)(C.p.ws + WS_RJ);
    int it = 0;
    LAS float* wl = (LAS float*)(C.lds + 16384);
    for (int i = C.tid; i < D * 8 / 4; i += NT) { const int col = i >> 1, hh = i & 1;
        ((LAS f32x4*)wl)[(((col >> 8) * 4 + (col & 3)) * 2 + hh) * 64 + ((col & 255) >> 2)] = ((const f32x4*)wr)[i]; }
    constexpr int PB = 16384 + 32768;
    { const float* md = C.mods(1, C.vcu >> 4); stage5(C, 0, C.p.in[21], md + 2 * D, C.p.in[22], md + 3 * D, md + 4 * D, PB); }
    const LAS float* P = (const LAS float*)(C.lds + PB);
    __syncthreads();
    auto route = [&](int m, const float (&lg)[8], int it) {
        int e0 = 0; float v0 = lg[0];
#pragma unroll
        for (int e = 1; e < 8; ++e) if (lg[e] > v0) { v0 = lg[e]; e0 = e; }
        int e1 = (e0 == 0) ? 1 : 0; float v1 = (e0 == 0) ? lg[1] : lg[0];
#pragma unroll
        for (int e = 1; e < 8; ++e) if (e != e0 && e != e1 && lg[e] > v1) { v1 = lg[e]; e1 = e; }
        const float w1v = 1.f / (1.f + __expf(v0 - v1)), w0v = 1.f - w1v;
        if (ln == 0) {
            const int s0 = __hip_atomic_fetch_add(&lcnt[e0], 1, __ATOMIC_RELAXED, __HIP_MEMORY_SCOPE_WORKGROUP), s1 = __hip_atomic_fetch_add(&lcnt[e1], 1, __ATOMIC_RELAXED, __HIP_MEMORY_SCOPE_WORKGROUP);
            LAS int* rec = lrec + (C.wave * 64 + (it & 63)) * 4; rec[0] = e0; rec[1] = e1; rec[2] = s0; rec[3] = s1;
            RE[2 * m] = e0; RE[2 * m + 1] = e1; RW[2 * m] = w0v; RW[2 * m + 1] = w1v;
        }
    };
    auto do_pair = [&](int m, Row16& xa, const Row16& ya, Row16& xb, const Row16& yb, const float* md, int it) {
        Row16 ha, hb;
        resid_row_l(xa, ya, P, P + D, ln); resid_row_l(xb, yb, P, P + D, ln);
        st_bf(xa, (bf16*)(C.p.ws + WS_X3) + (size_t)m * D, ln); st_bf(xb, (bf16*)(C.p.ws + WS_X3) + (size_t)(m + 1) * D, ln);
        modulate_row_l(xa, ha, P + 2 * D, P + 3 * D, P + 4 * D, ln); modulate_row_l(xb, hb, P + 2 * D, P + 3 * D, P + 4 * D, ln);
        { unsigned* h8 = (unsigned*)(C.p.ws + WS_H8 + (size_t)m * D) + ln;
#pragma unroll
          for (int j = 0; j < 4; ++j) { h8[64 * j] = pk4_fp8(ha.v[j][0], ha.v[j][1], ha.v[j][2], ha.v[j][3]); h8[D / 4 + 64 * j] = pk4_fp8(hb.v[j][0], hb.v[j][1], hb.v[j][2], hb.v[j][3]); } }
        float la[8], lb[8];
#pragma unroll
        for (int e = 0; e < 8; ++e) { la[e] = 0.f; lb[e] = 0.f; }
#pragma unroll
        for (int j = 0; j < 4; ++j)
#pragma unroll
            for (int i = 0; i < 4; ++i) {
                const f32x4 w0 = ((const LAS f32x4*)wl)[((j * 4 + i) * 2 + 0) * 64 + ln], w1 = ((const LAS f32x4*)wl)[((j * 4 + i) * 2 + 1) * 64 + ln];
                const float va = ha.v[j][i], vb = hb.v[j][i];
                la[0] += va * w0[0]; la[1] += va * w0[1]; la[2] += va * w0[2]; la[3] += va * w0[3]; la[4] += va * w1[0]; la[5] += va * w1[1]; la[6] += va * w1[2]; la[7] += va * w1[3];
                lb[0] += vb * w0[0]; lb[1] += vb * w0[1]; lb[2] += vb * w0[2]; lb[3] += vb * w0[3]; lb[4] += vb * w1[0]; lb[5] += vb * w1[1]; lb[6] += vb * w1[2]; lb[7] += vb * w1[3];
            }
#pragma unroll
        for (int e = 0; e < 8; ++e) { la[e] = wave_sum(la[e]); lb[e] = wave_sum(lb[e]); }
        route(m, la, it); route(m + 1, lb, it + 1);
    };
    Row16 x0, x1, y0, y1, nx0, nx1, ny0, ny1;
#define T1A_LD(a0, a1, b0, b1, mm) do { ld_bf(a0, (const bf16*)C.p.out + (size_t)(mm) * D, ln); ld_bf(a1, (const bf16*)C.p.out + (size_t)((mm) + 1) * D, ln); \
        ld_bf(b0, Y + (size_t)(mm) * D, ln); ld_bf(b1, Y + (size_t)((mm) + 1) * D, ln); } while (0)
    { const int m0 = thin_row(C, 0); ld_bf(x0, (const bf16*)C.p.out + (size_t)m0 * D, ln); ld_bf(x1, (const bf16*)C.p.out + (size_t)(m0 + 1) * D, ln); }
#pragma nounroll
    for (int t = 0; t < 8; ++t, it += 2) {
        const int m = thin_row(C, t);
        ld_bf(y0, Y + (size_t)m * D, ln); ld_bf(y1, Y + (size_t)(m + 1) * D, ln);
        if (t < 7) { const int mn = thin_row(C, t + 1); ld_bf(nx0, (const bf16*)C.p.out + (size_t)mn * D, ln); ld_bf(nx1, (const bf16*)C.p.out + (size_t)(mn + 1) * D, ln); }
        do_pair(m, x0, y0, x1, y1, nullptr, it);
        if (t < 7) { x0 = nx0; x1 = nx1; }
    }
#undef T1A_LD
    __syncthreads();
    if (C.tid < 8) lcnt[8 + C.tid] = (int)__hip_atomic_fetch_add(C.ctl() + CW_CNT + C.tid, (unsigned)lcnt[C.tid], __ATOMIC_RELAXED, __HIP_MEMORY_SCOPE_AGENT);
    __syncthreads();
    int* TOKOF = (int*)(C.p.ws + WS_TOKOF);
    it = 0;
    for (int t = 0; t < 8; ++t)
      for (int q = 0; q < 2; ++q, ++it) { const int m = thin_row(C, t) + q;
        if (ln == 0) {
            LAS int* rec = lrec + (C.wave * 64 + (it & 63)) * 4; const int e0 = rec[0], e1 = rec[1];
            const int j0 = lcnt[8 + e0] + rec[2], j1 = lcnt[8 + e1] + rec[3];
            RJ[2 * m] = j0; RJ[2 * m + 1] = j1;
            TOKOF[e0 * NLAT + j0] = m; TOKOF[e1 * NLAT + j1] = m;
        }
    }
}
static_assert(FFE / 128 == 28 && D / 256 == 4, "K-split geometry");
constexpr int MOE_PTILE0 = (int)(((long long)WS_W8GU - (long long)WS_YS) / (256LL * D * 2));
static_assert(((long long)WS_W8GU - (long long)WS_YS) % (256LL * D * 2) == 0, "partial rows tile-aligned");
__device__ __forceinline__ void moe_split(const Ctx& C, int nT, int& tmt, int& nl) {
    tmt = ((nT * 4) / C.G) * C.G / 4; nl = nT - tmt;
    if ((C.G & 3) != 0 || nl > 8) { tmt = nT; nl = 0; }
}
__device__ __forceinline__ void phase_final(const Ctx& C) {
    const int gw = C.vcu * NWAVES + C.wave, NGW = C.G * NWAVES;
    TileTab T; load_tiletab(C, T);
    const bf16* YS = (const bf16*)(C.p.ws + WS_YS); const bf16* PART = (const bf16*)(C.p.ws + WS_W8GU);
    int tmt, nl; moe_split(C, T.tb[8], tmt, nl);
    const int* RE = (const int*)(C.p.ws + WS_RE); const float* RW = (const float*)(C.p.ws + WS_RW); const int* RJ = (const int*)(C.p.ws + WS_RJ);
    auto rows_of = [&](int m, size_t& p0, size_t& p1, float& w0, float& w1) {
        const int e0 = RE[2 * m], e1 = RE[2 * m + 1]; w0 = RW[2 * m]; w1 = RW[2 * m + 1];
        int b0 = 0, b1 = 0;
#pragma unroll
        for (int k = 0; k < NE; ++k) { b0 = (k == e0) ? T.tb[k] : b0; b1 = (k == e1) ? T.tb[k] : b1; }
        p0 = (size_t)b0 * 256 + RJ[2 * m]; p1 = (size_t)b1 * 256 + RJ[2 * m + 1]; };
    auto add_parts = [&](Row16& y, size_t p) {
        if ((int)(p >> 8) >= tmt) {
#pragma unroll
            for (int k = 0; k < 3; ++k) { Row16 t; ld_bf(t, PART + ((size_t)(8 * k + (int)(p >> 8) - tmt) * 256 + (p & 255)) * D, C.lane);
#pragma unroll
                for (int j = 0; j < 4; ++j) y.v[j] = y.v[j] + t.v[j]; } } };
    size_t pa0, pa1, pb0, pb1, qa0 = 0, qa1 = 0, qb0 = 0, qb1 = 0; float wa0, wa1, wb0, wb1, va0 = 0.f, va1 = 0.f, vb0 = 0.f, vb1 = 0.f;
    Row16 xa, xb, ya0, ya1, yb0, yb1, nxa, nxb, nya0, nya1, nyb0, nyb1;
#define FIN_LD(m_, P0, P1, Q0, Q1, W0, W1, V0, V1, XA, XB, A0, A1, B0_, B1_) do { rows_of((m_), P0, P1, W0, W1); rows_of((m_) + 1, Q0, Q1, V0, V1); \
        ld_bf(XA, (const bf16*)(C.p.ws + WS_X3) + (size_t)(m_) * D, C.lane); ld_bf(XB, (const bf16*)(C.p.ws + WS_X3) + (size_t)((m_) + 1) * D, C.lane); \
        ld_bf(A0, YS + P0 * D, C.lane); ld_bf(A1, YS + P1 * D, C.lane); ld_bf(B0_, YS + Q0 * D, C.lane); ld_bf(B1_, YS + Q1 * D, C.lane); } while (0)
    if (gw < NLAT / 2) FIN_LD(2 * gw, pa0, pa1, pb0, pb1, wa0, wa1, wb0, wb1, xa, xb, ya0, ya1, yb0, yb1);
    for (int mp = gw; mp < NLAT / 2; mp += NGW) {
        const int m = 2 * mp;
        const float* md = C.mods(1, m / SEQ);
        const bool more = mp + NGW < NLAT / 2;
        if (more) FIN_LD(2 * (mp + NGW), qa0, qa1, qb0, qb1, va0, va1, vb0, vb1, nxa, nxb, nya0, nya1, nyb0, nyb1);
        add_parts(ya0, pa0); add_parts(ya1, pa1); add_parts(yb0, pb0); add_parts(yb1, pb1);
#pragma unroll
        for (int j = 0; j < 4; ++j) { ya0.v[j] = ya0.v[j] * wa0 + ya1.v[j] * wa1; yb0.v[j] = yb0.v[j] * wb0 + yb1.v[j] * wb1; }
        resid_row(xa, ya0, C.p.in[23], md + 5 * D, C.lane);
        resid_row(xb, yb0, C.p.in[23], md + 5 * D, C.lane);
        st_f32(xa, C.p.out + (size_t)m * D, C.lane); st_f32(xb, C.p.out + (size_t)(m + 1) * D, C.lane);
        if (more) { pa0 = qa0; pa1 = qa1; pb0 = qb0; pb1 = qb1; wa0 = va0; wa1 = va1; wb0 = vb0; wb1 = vb1; xa = nxa; xb = nxb; ya0 = nya0; ya1 = nya1; yb0 = nyb0; yb1 = nyb1; }
    }
#undef FIN_LD
}

namespace pg8 {
typedef short bf16x8 __attribute__((ext_vector_type(8)));
typedef int i32x4 __attribute__((ext_vector_type(4)));
typedef int i32x8 __attribute__((ext_vector_type(8)));
constexpr int BM = 256, BK = 64, HALF = 128, HTB = HALF * BK * 2, STAGE_BYTES = 8 * HTB, NXCD = 8, WGM = 4;
#ifndef PG8_ROWMAJOR
#define PG8_ROWMAJOR 1
#endif
#if PG8_ROWMAJOR
__host__ __device__ __forceinline__ int lds_byte(int r, int c) { return r * 128 + ((((c >> 3) ^ (r & 7)) & 7) << 4) + (c & 7) * 2; }
__host__ __device__ __forceinline__ void stage_rc(int b, int& R, int& C) { R = b >> 7; C = ((((b >> 4) & 7) ^ (R & 7)) << 3) + ((b & 15) >> 1); }
#define PG8_HI(off) ((off) ^ 64)
#else
__host__ __device__ __forceinline__ int lds_byte(int r, int c) { const int st = (r >> 4) * 2 + (c >> 5), rr = r & 15, cc = c & 31, ob = rr * 64 + cc * 2; return st * 1024 + (ob ^ (((ob >> 9) & 1) << 5)); }
__host__ __device__ __forceinline__ void stage_rc(int b, int& R, int& C) { const int st = b / 1024, sb = b % 1024, swz = sb ^ (((sb >> 9) & 1) << 5); R = (st >> 1) * 16 + swz / 64; C = (st & 1) * 32 + (swz % 64) / 2; }
#define PG8_HI(off) ((off) + 1024)
#endif
__host__ __device__ __forceinline__ int perm32(int rho) { const int n = rho >> 4, i = rho & 15; return 8 * (i >> 2) + 4 * n + (i & 3); }
struct Unit { int pm, pn, xa, xb, koff, nkt; };
struct Gemm { const bf16* A; const bf16* Bt; int K; };
__device__ __forceinline__ unsigned cvt_pk_bf16(float lo, float hi) { unsigned r; asm volatile("v_cvt_pk_bf16_f32 %0, %1, %2" : "=v"(r) : "v"(lo), "v"(hi)); return r; }
__device__ __forceinline__ void static_map(int L, int nM, int nN, int& pm, int& pn) {
    const int nwg = nM * nN; int wgid = L; { const int q = nwg / NXCD, r = nwg % NXCD, xcd = wgid % NXCD, off = wgid / NXCD; wgid = (xcd < r ? xcd * (q + 1) : r * (q + 1) + (xcd - r) * q) + off; }
    const int nig = WGM * nN, gid = wgid / nig, fm = gid * WGM, gsz = (nM - fm) < WGM ? (nM - fm) : WGM;
    pm = fm + ((wgid % nig) % gsz); pn = (wgid % nig) / gsz;
}
template <class Epi, class Sched, bool ALIGN_EPI, int MODE = 0>
__device__ __forceinline__ void gemm_phase(LAS unsigned char* lds, const Gemm g, const Sched& S, const Epi& E) {
    const int tid = threadIdx.x, wid = __builtin_amdgcn_readfirstlane(tid >> 6), lane = tid & 63, wr = wid >> 2, wc = wid & 3, fr = lane & 15, fq = lane >> 4;
    constexpr bool F8 = MODE == 1, I8 = MODE == 2;
    constexpr int EB = (F8 || I8) ? 1 : 2;
    const int K = g.K, nt = K * EB / (BK * 2);
    unsigned voffB[2], cA2[2]; int RA[2];
#pragma unroll
    for (int i = 0; i < 2; ++i) { int R, C; stage_rc(tid * 16 + i * 8192, R, C); const int Rb = (R & ~31) + perm32(R & 31);
        RA[i] = R; cA2[i] = (unsigned)C * 2u; voffB[i] = (unsigned)(Rb * K * EB + C * 2); }
    const unsigned voffB0 = voffB[0];
    const size_t kstep = (size_t)(BK * 2);
    const size_t hstep = (size_t)HALF * K * EB;
    const size_t tstep = 2 * hstep;
    const unsigned ldsw = (unsigned)wid * 1024u;
    const int aoff = lds_byte(wr * 64 + fr, fq * 8), boff = lds_byte(wc * 32 + fr, fq * 8), aoffh = PG8_HI(aoff), boffh = PG8_HI(boff);
#define PG8_SA(b, h) (((b) * 2 + (h)) * HTB)
#define PG8_SB(b, h) ((4 + (b) * 2 + (h)) * HTB)
#define PG8_STAGE(bufoff, gbase, voff) do { _Pragma("unroll") for (int _i = 0; _i < 2; ++_i) \
        __builtin_amdgcn_global_load_lds((const unsigned*)((const char*)(gbase) + (voff)[_i]), (LAS unsigned*)(lds + (bufoff) + ldsw + _i * 8192), 16, 0, 0); } while (0)
#define PG8_STAGEB(bufoff, gbase) do { _Pragma("unroll") for (int _i = 0; _i < 2; ++_i) \
        __builtin_amdgcn_global_load_lds((const unsigned*)((const char*)(gbase) + (size_t)_i * 64 * K * EB + voffB0), (LAS unsigned*)(lds + (bufoff) + ldsw + _i * 8192), 16, 0, 0); } while (0)
#define PG8_LDA(dst, b, h) do { _Pragma("unroll") for (int m = 0; m < 4; ++m) { dst[m].lo = *(const LAS i32x4*)(lds + PG8_SA(b, h) + aoff + m * 2048); dst[m].hi = *(const LAS i32x4*)(lds + PG8_SA(b, h) + aoffh + m * 2048); } } while (0)
#define PG8_LDB(dst, b, h) do { _Pragma("unroll") for (int n = 0; n < 2; ++n) { dst[n].lo = *(const LAS i32x4*)(lds + PG8_SB(b, h) + boff + n * 2048); dst[n].hi = *(const LAS i32x4*)(lds + PG8_SB(b, h) + boffh + n * 2048); } } while (0)
#define PG8_H(x, k) __builtin_bit_cast(bf16x8, (k) == 0 ? (x).lo : (x).hi)
#define PG8_MMA(ai, bj, At, Bt) do { __builtin_amdgcn_s_setprio(1); \
        if constexpr (F8) { _Pragma("unroll") for (int m = 0; m < 4; ++m) _Pragma("unroll") for (int n = 0; n < 2; ++n) \
            asm volatile("v_mfma_scale_f32_16x16x128_f8f6f4 %0, %1, %2, %0, %3, %3 op_sel_hi:[0,0,0]" : "+v"(acc[ai][bj][m][n]) : "v"(Bt[n]), "v"(At[m]), "v"(sc127)); } \
        else if constexpr (I8) { _Pragma("unroll") for (int m = 0; m < 4; ++m) _Pragma("unroll") for (int n = 0; n < 2; ++n) _Pragma("unroll") for (int k = 0; k < 2; ++k) \
            acc[ai][bj][m][n] = __builtin_bit_cast(f32x4, __builtin_amdgcn_mfma_i32_16x16x64_i8((k) == 0 ? Bt[n].lo : Bt[n].hi, (k) == 0 ? At[m].lo : At[m].hi, __builtin_bit_cast(i32x4, acc[ai][bj][m][n]), 0, 0, 0)); } \
        else { _Pragma("unroll") for (int m = 0; m < 4; ++m) _Pragma("unroll") for (int n = 0; n < 2; ++n) _Pragma("unroll") for (int k = 0; k < 2; ++k) \
            acc[ai][bj][m][n] = __builtin_amdgcn_mfma_f32_16x16x32_bf16(PG8_H(Bt[n], k), PG8_H(At[m], k), acc[ai][bj][m][n], 0, 0, 0); } \
        __builtin_amdgcn_s_setprio(0); } while (0)
#define PG8_WAIT_V(n) asm volatile("s_waitcnt vmcnt(" #n ")" ::: "memory")
#define PG8_WAIT_L(n) asm volatile("s_waitcnt lgkmcnt(" #n ")" ::: "memory")
#ifndef PG8_FT_STORES
#define PG8_FT_STORES 8
#endif
#define PG8_WAIT_V_FT asm volatile("s_waitcnt vmcnt(%0)" :: "n"(8 + PG8_FT_STORES) : "memory")
#define PG8_BAR __builtin_amdgcn_s_barrier()
#define PG8_SCHED __builtin_amdgcn_sched_barrier(0)
#define PG8_AOFFS(dst, u) do { _Pragma("unroll") for (int _h = 0; _h < 2; ++_h) _Pragma("unroll") for (int _i = 0; _i < 2; ++_i) dst[_h][_i] = S.a_off(u, _h * HALF + RA[_i]) + cA2[_i]; } while (0)
    Unit cur, nxt; int ui = 0;
    if (!S.next(0, cur)) return;
#define PG8_TOKDMA(u) do { _Pragma("unroll") for (int _h = 0; _h < 2; ++_h) _Pragma("unroll") for (int _i = 0; _i < 2; ++_i) \
        __builtin_amdgcn_global_load_lds((const unsigned*)S.a_tokp(u, _h * HALF + RA[_i]), (LAS unsigned*)(lds + TOK_OFF + (wid * 4 + _h * 2 + _i) * 256), 4, 0, 0); } while (0)
    if constexpr (Sched::GATHER) { Unit u1; if (S.next(1, u1)) PG8_TOKDMA(u1); }
    f32x4 acc[2][2][4][2];
#pragma unroll
    for (int a = 0; a < 2; ++a)
#pragma unroll
        for (int b = 0; b < 2; ++b)
#pragma unroll
            for (int m = 0; m < 4; ++m)
#pragma unroll
                for (int n = 0; n < 2; ++n) acc[a][b][m][n] = (f32x4){0.f, 0.f, 0.f, 0.f};
    const int sc127 = 0x7f7f7f7f;
    i32x8 At[4], B0[2], B1[2];
    const char* pA = (const char*)g.A;
    unsigned oA[2][2], nO[2][2];
    PG8_AOFFS(oA, cur);
    constexpr bool KS = Sched::KSPLIT;
    const char* cA = KS ? pA + (size_t)cur.koff * kstep : pA;
    const char* cB = (const char*)g.Bt + (size_t)cur.pn * tstep + (KS ? (size_t)cur.koff * kstep : 0);
    int ntc = KS ? cur.nkt : nt;
    PG8_STAGEB(PG8_SB(0, 0), cB); PG8_STAGEB(PG8_SB(0, 1), cB + hstep); PG8_STAGE(PG8_SA(0, 0), cA, oA[0]); PG8_STAGE(PG8_SA(0, 1), cA, oA[1]);
    if (wr == 1) PG8_BAR;
    PG8_WAIT_V(2); PG8_BAR;
    PG8_STAGEB(PG8_SB(1, 0), cB + kstep); PG8_STAGE(PG8_SA(1, 0), cA + kstep, oA[0]); PG8_STAGEB(PG8_SB(1, 1), cB + hstep + kstep);
    PG8_WAIT_V(6); PG8_BAR;
    for (;;) {
        const bool has_next = S.next(ui + 1, nxt);
        if (has_next) { if constexpr (!Sched::GATHER) PG8_AOFFS(nO, nxt); } else {
#pragma unroll
            for (int h = 0; h < 2; ++h)
#pragma unroll
                for (int i = 0; i < 2; ++i) nO[h][i] = oA[h][i]; }
        const char* nB = has_next ? (const char*)g.Bt + (size_t)nxt.pn * tstep + (KS ? (size_t)nxt.koff * kstep : 0) : cB;
        const char* nA = (KS && has_next) ? pA + (size_t)nxt.koff * kstep : cA;
#pragma nounroll
        for (int t = 0; t < ntc; t += 2) {
            const bool last = (t == ntc - 2);
            const bool ft = (t == 0) && (ui > 0);
            if constexpr (Sched::GATHER) { if (last && has_next) {
#pragma unroll
                for (int h = 0; h < 2; ++h)
#pragma unroll
                    for (int i = 0; i < 2; ++i) nO[h][i] = *(const LAS unsigned*)(lds + TOK_OFF + (wid * 4 + h * 2 + i) * 256 + lane * 4) * S.rowbytes + cA2[i]; } }
            const char* a1 = cA + (size_t)(t + 1) * kstep;
            const char* a2 = last ? nA : cA + (size_t)(t + 2) * kstep; const char* b2 = last ? nB : cB + (size_t)(t + 2) * kstep;
            const char* a3 = a2 + kstep; const char* b3 = b2 + kstep;
#define PG8_STAGE_A2(bufoff, gbase, h) do { if constexpr (Sched::GATHER) { if (last) { PG8_STAGE(bufoff, gbase, nO[h]); } else { PG8_STAGE(bufoff, gbase, oA[h]); } } \
                else { unsigned o2_[2]; o2_[0] = last ? nO[h][0] : oA[h][0]; o2_[1] = last ? nO[h][1] : oA[h][1]; PG8_STAGE(bufoff, gbase, o2_); } } while (0)
            PG8_LDB(B0, 0, 0); PG8_LDB(B1, 0, 1); PG8_SCHED; PG8_LDA(At, 0, 0); PG8_STAGE(PG8_SA(1, 1), a1, oA[1]);
            if (ft) { PG8_WAIT_V_FT; } else { PG8_WAIT_V(8); } PG8_WAIT_L(0); PG8_BAR; PG8_MMA(0, 0, At, B0); PG8_MMA(0, 1, At, B1); PG8_BAR; PG8_SCHED;
            PG8_LDA(At, 0, 1); PG8_STAGEB(PG8_SB(0, 0), b2); PG8_STAGEB(PG8_SB(0, 1), b2 + hstep); PG8_STAGE_A2(PG8_SA(0, 0), a2, 0);
            if (ft) { PG8_WAIT_V_FT; } else { PG8_WAIT_V(8); } PG8_WAIT_L(0); PG8_BAR; PG8_MMA(1, 0, At, B0); PG8_MMA(1, 1, At, B1); PG8_BAR; PG8_SCHED;
            PG8_LDB(B0, 1, 0); PG8_LDB(B1, 1, 1); PG8_SCHED; PG8_LDA(At, 1, 0); PG8_STAGE_A2(PG8_SA(0, 1), a2, 1);
            PG8_WAIT_V(8); PG8_WAIT_L(0); PG8_BAR; PG8_MMA(0, 0, At, B0); PG8_MMA(0, 1, At, B1); PG8_BAR; PG8_SCHED;
            PG8_LDA(At, 1, 1); PG8_STAGEB(PG8_SB(1, 0), b3); PG8_STAGEB(PG8_SB(1, 1), b3 + hstep); PG8_STAGE_A2(PG8_SA(1, 0), a3, 0);
            PG8_WAIT_V(8); PG8_WAIT_L(0); PG8_BAR; PG8_MMA(1, 0, At, B0); PG8_MMA(1, 1, At, B1); PG8_BAR; PG8_SCHED;
#undef PG8_STAGE_A2
        }
        if constexpr (Sched::GATHER) { Unit u2; if (S.next(ui + 2, u2)) PG8_TOKDMA(u2); }
        if constexpr (ALIGN_EPI) { if (wr == 0) PG8_BAR; }
        asm volatile("s_nop 15\n\ts_nop 15" ::: "memory");
        E(acc, cur, wr, wc, fr, fq);
        if (!has_next) break;
#pragma unroll
        for (int a = 0; a < 2; ++a)
#pragma unroll
            for (int b = 0; b < 2; ++b)
#pragma unroll
                for (int m = 0; m < 4; ++m)
#pragma unroll
                    for (int n = 0; n < 2; ++n) acc[a][b][m][n] = (f32x4){0.f, 0.f, 0.f, 0.f};
        cur = nxt; cB = nB; cA = nA; if constexpr (KS) ntc = nxt.nkt; ++ui;
#pragma unroll
        for (int h = 0; h < 2; ++h)
#pragma unroll
            for (int i = 0; i < 2; ++i) oA[h][i] = nO[h][i];
        if constexpr (ALIGN_EPI) { if (wr == 1) PG8_BAR; }
    }
    PG8_WAIT_V(0);
    if constexpr (!ALIGN_EPI) { if (wr == 0) PG8_BAR; }
    PG8_BAR;
#undef PG8_SA
#undef PG8_SB
#undef PG8_STAGE
#undef PG8_STAGEB
#undef PG8_LDA
#undef PG8_LDB
#undef PG8_MMA
#undef PG8_H
#undef PG8_WAIT_V
#undef PG8_WAIT_L
#undef PG8_BAR
#undef PG8_SCHED
#undef PG8_AOFFS
#undef PG8_TOKDMA
}

struct EpiStore {
    bf16* O; int ldc; float qscale; int qtiles;
    __device__ __forceinline__ void operator()(f32x4 (&acc)[2][2][4][2], const Unit& u, int wr, int wc, int fr, int fq) const {
        const int row0 = u.xa * BM + wr * 64 + fr, col0 = u.xb * BM + wc * 32 + 8 * fq;
        const float sc = (u.xb < qtiles) ? qscale : 1.f;
#pragma unroll
        for (int ai = 0; ai < 2; ++ai)
#pragma unroll
            for (int m = 0; m < 4; ++m) { bf16* rowp = O + (long long)(row0 + ai * HALF + m * 16) * ldc + col0;
#pragma unroll
                for (int bj = 0; bj < 2; ++bj) { const f32x4 v0 = acc[ai][bj][m][0] * sc, v1 = acc[ai][bj][m][1] * sc;
                    u32x4 w; w.x = cvt_pk_bf16(v0[0], v0[1]); w.y = cvt_pk_bf16(v0[2], v0[3]); w.z = cvt_pk_bf16(v1[0], v1[1]); w.w = cvt_pk_bf16(v1[2], v1[3]);
                    *(u32x4*)(rowp + bj * HALF) = w; } }
    }
};
__device__ __forceinline__ float silu_fast(float g) { return g * __builtin_amdgcn_rcpf(1.f + __builtin_amdgcn_exp2f(-g * LOG2E)); }
struct EpiSwigluF {
    bf16* O; int ldc;
    __device__ __forceinline__ void operator()(f32x4 (&acc)[2][2][4][2], const Unit& u, int wr, int wc, int fr, int fq) const {
        const int row0 = u.xa * BM + wr * 64 + fr, col0 = u.xb * HALF + wc * 32 + 8 * fq;
#pragma unroll
        for (int ai = 0; ai < 2; ++ai)
#pragma unroll
            for (int m = 0; m < 4; ++m) { bf16* rowp = O + (size_t)(row0 + ai * HALF + m * 16) * ldc + col0;
                const f32x4 g0 = acc[ai][0][m][0], g1 = acc[ai][0][m][1], u0 = acc[ai][1][m][0], u1 = acc[ai][1][m][1];
                u32x4 w; w.x = cvt_pk_bf16(silu_fast(g0[0]) * u0[0], silu_fast(g0[1]) * u0[1]); w.y = cvt_pk_bf16(silu_fast(g0[2]) * u0[2], silu_fast(g0[3]) * u0[3]);
                w.z = cvt_pk_bf16(silu_fast(g1[0]) * u1[0], silu_fast(g1[1]) * u1[1]); w.w = cvt_pk_bf16(silu_fast(g1[2]) * u1[2], silu_fast(g1[3]) * u1[3]);
                *(u32x4*)rowp = w; }
    }
};
#ifndef EPI_PK
#define EPI_PK 1
#endif
#if EPI_PK
__device__ __forceinline__ float mul1(float a, float b) { return a * b; }
#else
__device__ __forceinline__ float mul1(float a, float b) { float r; asm("v_mul_f32_e32 %0, %1, %2" : "=v"(r) : "v"(a), "v"(b)); return r; }
#endif
__device__ __forceinline__ f32x4 mul4(const f32x4 a, float b) { return (f32x4){mul1(a[0], b), mul1(a[1], b), mul1(a[2], b), mul1(a[3], b)}; }
#if EPI_PK
__device__ __forceinline__ float mul1s(float a, float b) { return a * b; }
#else
__device__ __forceinline__ float mul1s(float a, float b) { float r; asm("v_mul_f32_e32 %0, %2, %1" : "=v"(r) : "v"(a), "s"(b)); return r; }
#endif
__device__ __forceinline__ f32x4 mul4s(const f32x4 a, float b) { return (f32x4){mul1s(a[0], b), mul1s(a[1], b), mul1s(a[2], b), mul1s(a[3], b)}; }
__device__ __forceinline__ f32x4 mul4(const f32x4 a, const f32x4 b) { return (f32x4){mul1(a[0], b[0]), mul1(a[1], b[1]), mul1(a[2], b[2]), mul1(a[3], b[3])}; }
#if EPI_PK
__device__ __forceinline__ f32x4 swiglu4(const f32x4 g, const f32x4 a, const f32x4 uk) {
    f32x4 e; e[0] = __builtin_amdgcn_exp2f(a[0]); e[1] = __builtin_amdgcn_exp2f(a[1]); e[2] = __builtin_amdgcn_exp2f(a[2]); e[3] = __builtin_amdgcn_exp2f(a[3]);
    const f32x4 d = e + 1.f;
    f32x4 sg; sg[0] = __builtin_amdgcn_rcpf(d[0]); sg[1] = __builtin_amdgcn_rcpf(d[1]); sg[2] = __builtin_amdgcn_rcpf(d[2]); sg[3] = __builtin_amdgcn_rcpf(d[3]);
    return (g * sg) * uk;
}
#else
__device__ __forceinline__ f32x4 swiglu4(const f32x4 g, const f32x4 a, const f32x4 uk) {
    float o0 = a[0], o1 = a[1], o2 = a[2], o3 = a[3];
    asm("v_exp_f32_e32 %0, %0\n\tv_exp_f32_e32 %1, %1\n\tv_exp_f32_e32 %2, %2\n\tv_exp_f32_e32 %3, %3\n\t"
        "v_add_f32_e32 %0, 1.0, %0\n\tv_add_f32_e32 %1, 1.0, %1\n\tv_add_f32_e32 %2, 1.0, %2\n\tv_add_f32_e32 %3, 1.0, %3\n\t"
        "v_rcp_f32_e32 %0, %0\n\tv_rcp_f32_e32 %1, %1\n\tv_rcp_f32_e32 %2, %2\n\tv_rcp_f32_e32 %3, %3\n\t"
        "v_mul_f32_e32 %0, %0, %4\n\tv_mul_f32_e32 %1, %1, %5\n\tv_mul_f32_e32 %2, %2, %6\n\tv_mul_f32_e32 %3, %3, %7\n\t"
        "v_mul_f32_e32 %0, %0, %8\n\tv_mul_f32_e32 %1, %1, %9\n\tv_mul_f32_e32 %2, %2, %10\n\tv_mul_f32_e32 %3, %3, %11"
        : "+v"(o0), "+v"(o1), "+v"(o2), "+v"(o3)
        : "v"(g[0]), "v"(g[1]), "v"(g[2]), "v"(g[3]), "v"(uk[0]), "v"(uk[1]), "v"(uk[2]), "v"(uk[3]));
    return (f32x4){o0, o1, o2, o3};
}
#endif
__device__ __forceinline__ unsigned pk4_fp8c(const f32x4 v) { return pk4_fp8(__builtin_amdgcn_fmed3f(v[0], -448.f, 448.f), __builtin_amdgcn_fmed3f(v[1], -448.f, 448.f), __builtin_amdgcn_fmed3f(v[2], -448.f, 448.f), __builtin_amdgcn_fmed3f(v[3], -448.f, 448.f)); }
struct EpiSwiglu8 {
    unsigned char* O; int ldc; float insc, outsc;
    __device__ __forceinline__ void operator()(f32x4 (&acc)[2][2][4][2], const Unit& u, int wr, int wc, int fr, int fq) const {
        const int row0 = u.xa * BM + wr * 64 + fr, col0 = u.xb * HALF + wc * 32 + 8 * fq;
        const float k1 = -insc * LOG2E, k2 = insc * insc * outsc;
#pragma unroll
        for (int ai = 0; ai < 2; ++ai)
#pragma unroll
            for (int m = 0; m < 4; ++m) { unsigned char* rowp = O + (size_t)(row0 + ai * HALF + m * 16) * ldc + col0;
                const f32x4 g0 = acc[ai][0][m][0], g1 = acc[ai][0][m][1], u0 = acc[ai][1][m][0], u1 = acc[ai][1][m][1];
                u32x2 w; w.x = pk4_fp8c(swiglu4(g0, mul4s(g0, k1), mul4s(u0, k2))); w.y = pk4_fp8c(swiglu4(g1, mul4s(g1, k1), mul4s(u1, k2)));
                *(u32x2*)rowp = w; }
    }
};
struct EpiDeqSwiglu8 {
    unsigned char* O; int ldc; float outsc; const float* rs; const unsigned* cm;
    __device__ __forceinline__ void operator()(f32x4 (&acc)[2][2][4][2], const Unit& u, int wr, int wc, int fr, int fq) const {
        const int row0 = u.pm * BM + wr * 64 + fr, colb = u.pn * BM + wc * 32 + 8 * fq;
        f32x4 cg[2], cu[2];
#pragma unroll
        for (int n = 0; n < 2; ++n) { const u32x4 a = *(const u32x4*)(cm + colb + 4 * n), b = *(const u32x4*)(cm + colb + HALF + 4 * n);
            cg[n] = mul4s((f32x4){__uint_as_float(a.x), __uint_as_float(a.y), __uint_as_float(a.z), __uint_as_float(a.w)}, 1.f / 127.f);
            cu[n] = mul4s((f32x4){__uint_as_float(b.x), __uint_as_float(b.y), __uint_as_float(b.z), __uint_as_float(b.w)}, outsc / 127.f); }
        float r[2][4];
#pragma unroll
        for (int ai = 0; ai < 2; ++ai)
#pragma unroll
            for (int m = 0; m < 4; ++m) r[ai][m] = rs[row0 + ai * HALF + m * 16];
#pragma unroll
        for (int ai = 0; ai < 2; ++ai)
#pragma unroll
            for (int m = 0; m < 4; ++m) { unsigned char* rowp = O + (size_t)(u.xa * BM + wr * 64 + fr + ai * HALF + m * 16) * ldc + u.xb * HALF + wc * 32 + 8 * fq;
                const float rl = mul1(r[ai][m], -LOG2E), r2 = mul1(r[ai][m], r[ai][m]);
                u32x2 w;
#pragma unroll
                for (int n = 0; n < 2; ++n) { const i32x4 ga = __builtin_bit_cast(i32x4, acc[ai][0][m][n]), ua = __builtin_bit_cast(i32x4, acc[ai][1][m][n]);
                    const f32x4 t0 = mul4((f32x4){(float)ga[0], (float)ga[1], (float)ga[2], (float)ga[3]}, cg[n]);
                    const f32x4 uk = mul4(mul4((f32x4){(float)ua[0], (float)ua[1], (float)ua[2], (float)ua[3]}, cu[n]), r2);
                    const unsigned p = pk4_fp8c(swiglu4(t0, mul4(t0, rl), uk));
                    if (n == 0) w.x = p; else w.y = p; }
                *(u32x2*)rowp = w; }
    }
};
struct EpiQkv0 {
    bf16* O; const float* gq; const float* gk; const LAS f32x2* rope;
    __device__ __forceinline__ void operator()(f32x4 (&acc)[2][2][4][2], const Unit& u, int wr, int wc, int fr, int fq) const {
        const int s = 4 * u.xb + wc;
        const bool isv = (s == 10 || s == 11 || s == 22 || s == 23), isq = (s < 8) || (s >= 12 && s < 20), norm = s < 10, lat = u.xa < NLAT / 256;
        const float* g = (s < 8) ? gq : gk;
        f32x4 gv[2][2];
#pragma unroll
        for (int bj = 0; bj < 2; ++bj)
#pragma unroll
            for (int n = 0; n < 2; ++n) gv[bj][n] = norm ? *(const f32x4*)(g + 32 * bj + 8 * fq + 4 * n) : (f32x4){1.f, 1.f, 1.f, 1.f};
        const int row0 = u.xa * BM + wr * 64 + fr;
#pragma unroll
        for (int ai = 0; ai < 2; ++ai)
#pragma unroll
            for (int m = 0; m < 4; ++m) {
                const int row = row0 + ai * HALF + m * 16;
                f32x4 v[2][2];
#pragma unroll
                for (int bj = 0; bj < 2; ++bj)
#pragma unroll
                    for (int n = 0; n < 2; ++n) v[bj][n] = acc[ai][bj][m][n];
                if (norm) {
                    float ss = 0.f;
#pragma unroll
                    for (int bj = 0; bj < 2; ++bj)
#pragma unroll
                        for (int n = 0; n < 2; ++n) ss += (v[bj][n][0] * v[bj][n][0] + v[bj][n][1] * v[bj][n][1]) + (v[bj][n][2] * v[bj][n][2] + v[bj][n][3] * v[bj][n][3]);
                    ss += __shfl_xor(ss, 16); ss += __shfl_xor(ss, 32);
                    const float rs = rsqrtf(ss * (1.f / 64.f) + EPS);
#pragma unroll
                    for (int bj = 0; bj < 2; ++bj)
#pragma unroll
                        for (int n = 0; n < 2; ++n) v[bj][n] = v[bj][n] * rs * gv[bj][n];
                }
                if (lat && !isv) {
                    const int t = row & (SEQ - 1);
#pragma unroll
                    for (int bj = 0; bj < 2; ++bj) { const int pos = (bj == 0) ? (t >> 6) : (t & 63);
#pragma unroll
                        for (int n = 0; n < 2; ++n) { const f32x2 c0 = rope[pos * 17 + 4 * fq + 2 * n], c1 = rope[pos * 17 + 4 * fq + 2 * n + 1];
                            const float a0 = v[bj][n][0], a1 = v[bj][n][1], a2 = v[bj][n][2], a3 = v[bj][n][3];
                            v[bj][n][0] = a0 * c0.x - a1 * c0.y; v[bj][n][1] = a0 * c0.y + a1 * c0.x; v[bj][n][2] = a2 * c1.x - a3 * c1.y; v[bj][n][3] = a2 * c1.y + a3 * c1.x; } }
                }
                const float sc = isq ? QSCALE : 1.f;
                bf16* rowp = O + (size_t)row * NQKV0 + s * 64 + 8 * fq;
#pragma unroll
                for (int bj = 0; bj < 2; ++bj) { const f32x4 v0 = v[bj][0] * sc, v1 = v[bj][1] * sc;
                    u32x4 w; w.x = cvt_pk_bf16(v0[0], v0[1]); w.y = cvt_pk_bf16(v0[2], v0[3]); w.z = cvt_pk_bf16(v1[0], v1[1]); w.w = cvt_pk_bf16(v1[2], v1[3]);
                    *(u32x4*)(rowp + 32 * bj) = w; }
            }
    }
};
template <class Inner> struct EpiDeq {
    Inner in; const float* rs; const unsigned* cm;
    __device__ __forceinline__ void operator()(f32x4 (&acc)[2][2][4][2], const Unit& u, int wr, int wc, int fr, int fq) const {
        const int row0 = u.pm * BM + wr * 64 + fr, col0 = u.pn * BM + wc * 32 + 8 * fq;
        f32x4 cv[2][2];
#pragma unroll
        for (int bj = 0; bj < 2; ++bj)
#pragma unroll
            for (int n = 0; n < 2; ++n) { const u32x4 w = *(const u32x4*)(cm + col0 + bj * HALF + 4 * n);
                cv[bj][n] = (f32x4){__uint_as_float(w.x), __uint_as_float(w.y), __uint_as_float(w.z), __uint_as_float(w.w)} * (1.f / 127.f); }
#pragma unroll
        for (int ai = 0; ai < 2; ++ai)
#pragma unroll
            for (int m = 0; m < 4; ++m) { const float r = rs[row0 + ai * HALF + m * 16];
#pragma unroll
                for (int bj = 0; bj < 2; ++bj)
#pragma unroll
                    for (int n = 0; n < 2; ++n) { const i32x4 a = __builtin_bit_cast(i32x4, acc[ai][bj][m][n]);
                        acc[ai][bj][m][n] = (f32x4){(float)a[0], (float)a[1], (float)a[2], (float)a[3]} * r * cv[bj][n]; } }
        in(acc, u, wr, wc, fr, fq);
    }
};
struct SchedStatic {
    static constexpr bool GATHER = false, KSPLIT = false;
    int nM, nN, G, c; unsigned rowbytes;
    __device__ __forceinline__ bool next(int i, Unit& u) const { const long L = (long)i * G + c; if (L >= (long)nM * nN) return false; static_map((int)L, nM, nN, u.pm, u.pn); u.xa = u.pm; u.xb = u.pn; u.koff = 0; u.nkt = 0; return true; }
    __device__ __forceinline__ unsigned a_off(const Unit& u, int r) const { return (unsigned)(u.pm * BM + r) * rowbytes; }
};
struct SchedIn1 {
    static constexpr bool GATHER = false, KSPLIT = false;
    int G, c;
    __device__ __forceinline__ bool next(int i, Unit& u) const { const long L = (long)i * G + c; if (L >= 1536 + 128) return false;
        if (L < 1536) static_map((int)L, 128, 12, u.pm, u.pn); else { const int l2 = (int)L - 1536; u.pm = 128 + (l2 & 15); u.pn = 4 + (l2 >> 4); }
        u.xa = u.pm; u.xb = u.pn; u.koff = 0; u.nkt = 0; return true; }
    __device__ __forceinline__ unsigned a_off(const Unit& u, int r) const { return (unsigned)(u.pm * BM + r) * (unsigned)D; }
};
}
template <bool GATHER_> struct SchedMoeT {
    static constexpr bool GATHER = GATHER_, gather = GATHER_, KSPLIT = !GATHER_;
    TileTab T; int t0, nT, nN, G, c; const int* tokof; unsigned rowbytes;
    int um, tmt, nl, ptile0;
    __device__ __forceinline__ bool next(int i, pg8::Unit& u) const { const long L = (long)i * G + c;
        int lt, pn, kp = 0; u.koff = 0; u.nkt = 28;
        if (!KSPLIT || L < um) { if (L >= (KSPLIT ? (long)um : (long)nT * nN)) return false; pg8::static_map((int)L, KSPLIT ? tmt : nT, nN, lt, pn); }
        else { const int sx = (int)(L - um); if (sx >= nl * 16) return false; lt = tmt + (sx >> 4); pn = (sx >> 2) & 3; kp = sx & 3; u.koff = (kp < 2) ? 8 * kp : 16 + 6 * (kp - 2); u.nkt = (kp < 2) ? 8 : 6; }
        const int e = tile_expert(T, t0 + lt);
        int tbe = 0;
#pragma unroll
        for (int k = 0; k < NE; ++k) tbe = (k == e) ? T.tb[k] : tbe;
        u.pm = gather ? (t0 + lt - tbe) * 256 : lt; u.pn = e * nN + pn; u.xa = gather ? lt : (kp == 0 ? t0 + lt : ptile0 + 8 * (kp - 1) + (lt - tmt)); u.xb = pn; return true; }
    __device__ __forceinline__ unsigned a_off(const pg8::Unit& u, int r) const {
        if (gather) { const int e = u.pn / nN, j = u.pm + r; int ce = 0;
#pragma unroll
            for (int k = 0; k < NE; ++k) ce = (k == e) ? T.cnt[k] : ce;
            const int tok = tokof[e * NLAT + min(j, ce - 1)]; return (unsigned)tok * rowbytes; }
        return (unsigned)(u.pm * 256 + r) * rowbytes; }
    __device__ __forceinline__ const int* a_tokp(const pg8::Unit& u, int r) const {
        const int e = u.pn / nN, j = u.pm + r; int ce = 0;
#pragma unroll
        for (int k = 0; k < NE; ++k) ce = (k == e) ? T.cnt[k] : ce;
        return tokof + (e * NLAT + min(j, ce - 1)); }
};

struct ConvJob { const float* W; unsigned char* WT; const unsigned* cm; int K, N, gu, up, head, f8; float sc; };
__device__ __forceinline__ void conv_load(const ConvJob& J, float (&rg)[32], int item, int lane) {
    const int nblk = J.N / 32, kb = item / nblk, nb = item % nblk, k0 = 64 * kb, n0 = 32 * nb;
    const float* p = J.W + (size_t)(k0 + (lane >> 5)) * J.N + n0 + (lane & 31);
#pragma unroll
    for (int i = 0; i < 32; ++i) rg[i] = p[(size_t)(2 * i) * J.N];
}
__device__ __forceinline__ void conv_finish(const ConvJob& J, LAS float* scr, const float (&rg)[32], int item, int lane) {
    const int nblk = J.N / 32, kb = item / nblk, nb = item % nblk, k0 = 64 * kb, n0 = 32 * nb;
#pragma unroll
    for (int i = 0; i < 32; ++i) { const int kk = 2 * i + (lane >> 5); scr[kk * 33 + (lane & 31)] = rg[i]; }
    asm volatile("s_waitcnt lgkmcnt(0)" ::: "memory");
    const int c = lane & 7;
#pragma unroll
    for (int j = 0; j < 4; ++j) { const int n = n0 + (lane >> 3) + 8 * j; const LAS float* sp = scr + (8 * c) * 33 + (lane >> 3) + 8 * j;
        int row = n;
        if (J.gu) row = 256 * (n >> 7) + 128 * J.up + (n & 127);
        else if (J.head) { const int o = n & 255; row = (n & ~255) + 128 * ((o >> 5) & 1) + 32 * (o >> 6) + (o & 31); }
        const float v0 = sp[0 * 33] * J.sc, v1 = sp[1 * 33] * J.sc, v2 = sp[2 * 33] * J.sc, v3 = sp[3 * 33] * J.sc, v4 = sp[4 * 33] * J.sc, v5 = sp[5 * 33] * J.sc, v6 = sp[6 * 33] * J.sc, v7 = sp[7 * 33] * J.sc;
        if (J.f8 == 2) { const float qs = 127.f / fmaxf(__uint_as_float(J.cm[row]), 1e-30f) / J.sc;
            const int a0 = (int)__builtin_rintf(v0 * qs), a1 = (int)__builtin_rintf(v1 * qs), a2 = (int)__builtin_rintf(v2 * qs), a3 = (int)__builtin_rintf(v3 * qs), a4 = (int)__builtin_rintf(v4 * qs), a5 = (int)__builtin_rintf(v5 * qs), a6 = (int)__builtin_rintf(v6 * qs), a7 = (int)__builtin_rintf(v7 * qs);
            u32x2 o; o.x = (unsigned)(a0 & 255) | ((unsigned)(a1 & 255) << 8) | ((unsigned)(a2 & 255) << 16) | ((unsigned)a3 << 24);
            o.y = (unsigned)(a4 & 255) | ((unsigned)(a5 & 255) << 8) | ((unsigned)(a6 & 255) << 16) | ((unsigned)a7 << 24); *(u32x2*)(J.WT + (size_t)row * J.K + k0 + 8 * c) = o; }
        else if (J.f8) { u32x2 o; o.x = pk4_fp8(v0, v1, v2, v3); o.y = pk4_fp8(v4, v5, v6, v7); *(u32x2*)(J.WT + (size_t)row * J.K + k0 + 8 * c) = o; }
        else { u32x4 o; o.x = pk2(v0, v1); o.y = pk2(v2, v3); o.z = pk2(v4, v5); o.w = pk2(v6, v7); *(u32x4*)(J.WT + ((size_t)row * J.K + k0 + 8 * c) * 2) = o; } }
    asm volatile("s_waitcnt lgkmcnt(0)" ::: "memory");
}
__device__ __forceinline__ void conv_item(const ConvJob& J, LAS float* scr, int item, int lane) { float rg[32]; conv_load(J, rg, item, lane); conv_finish(J, scr, rg, item, lane); }
constexpr int I_IN0 = 16 * 48, I_OUT = 16 * 32, I_G0 = 16 * 88, I_D0 = 44 * 32, I_IN1 = 16 * 96, I_GE = 16 * 112, I_DE = 56 * 32;
constexpr int NCONV0 = I_OUT + I_D0;
constexpr int NCONVQ = I_IN0 + 2 * I_G0;
constexpr int NFILL_L1 = I_IN1 + I_OUT, NFILL = NFILL_L1 + 8 * (2 * I_GE + I_DE);
__device__ __forceinline__ void conv0_job(const Ctx& C, int& r, ConvJob& J) {
    unsigned char* ws = C.p.ws; J.gu = 0; J.up = 0; J.head = 0; J.f8 = 0; J.sc = 1.f; J.K = D; J.cm = nullptr;
    if (r < I_OUT) { J.W = C.p.in[11]; J.WT = ws + WS_WOUT0; J.N = D; return; } r -= I_OUT;
    J.W = C.p.in[17]; J.WT = ws + WS_WDN0; J.K = FF0; J.N = D; J.f8 = 1; J.sc = W8DN0_SCALE;
}
__device__ __forceinline__ void convq_job(const Ctx& C, int& r, ConvJob& J) {
    unsigned char* ws = C.p.ws; J.gu = 0; J.up = 0; J.head = 0; J.f8 = 2; J.sc = 1.f; J.K = D;
    if (r < I_IN0) { J.W = C.p.in[10]; J.WT = ws + WS_WIN0; J.N = NQKV0; J.head = 1; J.cm = C.ctl() + CM_IN0; return; } r -= I_IN0;
    J.WT = ws + WS_WGU0; J.N = FF0; J.gu = 1; J.cm = C.ctl() + CM_GU0;
    if (r < I_G0) { J.W = C.p.in[15]; return; } r -= I_G0;
    J.W = C.p.in[16]; J.up = 1;
}
__device__ __forceinline__ void fill_job(const Ctx& C, int& r, ConvJob& J) {
    unsigned char* ws = C.p.ws; J.gu = 0; J.up = 0; J.head = 0; J.f8 = 0; J.sc = 1.f; J.K = D; J.cm = nullptr;
    if (r < I_IN1) { J.W = C.p.in[24]; J.WT = ws + WS_WIN1; J.N = NQKV1; J.f8 = 2; J.cm = C.ctl() + CM_IN1; return; } r -= I_IN1;
    if (r < I_OUT) { J.W = C.p.in[25]; J.WT = ws + WS_WOUT1; J.N = D; return; } r -= I_OUT;
    const int e = r / (2 * I_GE + I_DE); r -= e * (2 * I_GE + I_DE); J.f8 = 1;
    if (r < I_GE) { J.W = C.p.in[28] + (size_t)e * D * FFE; J.WT = ws + WS_W8GU + (size_t)e * 2 * FFE * D; J.N = FFE; J.gu = 1; J.sc = W8GU_SCALE; return; } r -= I_GE;
    if (r < I_GE) { J.W = C.p.in[29] + (size_t)e * D * FFE; J.WT = ws + WS_W8GU + (size_t)e * 2 * FFE * D; J.N = FFE; J.gu = 1; J.up = 1; J.sc = W8GU_SCALE; return; } r -= I_GE;
    J.W = C.p.in[30] + (size_t)e * FFE * D; J.WT = ws + WS_W8DN + (size_t)e * D * FFE; J.K = FFE; J.N = D; J.sc = W8DN_SCALE;
}
__device__ __forceinline__ void phase_convert(const Ctx& C) {
    LAS float* scr = (LAS float*)(C.lds + C.wave * 16384);
    const int gw = C.vcu * NWAVES + C.wave, NGW = C.G * NWAVES;
    for (int it = gw; it < NCONV0; it += NGW) { int r = it; ConvJob J; conv0_job(C, r, J); conv_item(J, scr, r, C.lane); }
}
__device__ __forceinline__ void phase_convert_q(const Ctx& C) {
    LAS float* scr = (LAS float*)(C.lds + C.wave * 16384);
    const int gw = C.vcu * NWAVES + C.wave, NGW = C.G * NWAVES;
    for (int it = gw; it < NCONVQ; it += NGW) { int r = it; ConvJob J; convq_job(C, r, J); conv_item(J, scr, r, C.lane); }
}
__device__ __forceinline__ void phase_colmax(const Ctx& C) {
    const int gw = C.vcu * NWAVES + C.wave, NGW = C.G * NWAVES;
    constexpr int B0 = (NQKV0 / 64) * 32, B1 = (FF0 / 64) * 32, B3 = (NQKV1 / 64) * 32;
    for (int it = gw; it < B0 + 2 * B1 + B3; it += NGW) {
        int r = it; const float* W; int N, kind, up = 0; unsigned* cm;
        if (r < B0) { W = C.p.in[10]; N = NQKV0; kind = 1; cm = C.ctl() + CM_IN0; }
        else if ((r -= B0) < B1) { W = C.p.in[15]; N = FF0; kind = 2; cm = C.ctl() + CM_GU0; }
        else if ((r -= B1) < B1) { W = C.p.in[16]; N = FF0; kind = 2; up = 1; cm = C.ctl() + CM_GU0; }
        else { r -= B1; W = C.p.in[24]; N = NQKV1; kind = 0; cm = C.ctl() + CM_IN1; }
        const int cb = r >> 5, kc = r & 31, n = cb * 64 + C.lane;
        const float* p = W + (size_t)(kc * 32) * N + n;
        float m = 0.f;
#pragma unroll
        for (int k = 0; k < 32; ++k) m = fmaxf(m, fabsf(p[(size_t)k * N]));
        int row = n;
        if (kind == 2) row = 256 * (n >> 7) + 128 * up + (n & 127);
        else if (kind == 1) { const int o = n & 255; row = (n & ~255) + 128 * ((o >> 5) & 1) + 32 * (o >> 6) + (o & 31); }
        __hip_atomic_fetch_max(cm + row, __float_as_uint(m), __ATOMIC_RELAXED, __HIP_MEMORY_SCOPE_AGENT);
    }
}
__device__ __forceinline__ void filler(const Ctx& C, int seam, int need, volatile LAS unsigned* misc) {
    __syncthreads();
    if (misc[0] != 0u) return;
    unsigned* done = C.ctl() + CW_DONE + 64 * seam; unsigned* head = C.ctl() + CW_FILL;
    if (C.tid == 0) __hip_atomic_fetch_add(done, 1u, __ATOMIC_RELAXED, __HIP_MEMORY_SCOPE_AGENT);
    LAS float* scr = (LAS float*)(C.lds + C.wave * 16384);
    bool force = need > 0;
    for (;;) {
        if (C.tid == 0) {
            unsigned first = ~0u;
            bool go = force;
            if (!go) go = __hip_atomic_load(done, __ATOMIC_RELAXED, __HIP_MEMORY_SCOPE_AGENT) < (unsigned)C.G;
            if (go) { first = __hip_atomic_fetch_add(head, (unsigned)(2 * NWAVES), __ATOMIC_RELAXED, __HIP_MEMORY_SCOPE_AGENT); if (first >= (unsigned)NFILL) { first = ~0u; misc[0] = 1u; } }
            misc[1] = first;
        }
        __syncthreads();
        const unsigned first = misc[1];
        __syncthreads();
        if (first == ~0u) break;
        const unsigned ia = first + (unsigned)C.wave, ib = ia + (unsigned)NWAVES;
        if (ib < (unsigned)NFILL) { int ra = (int)ia, rb = (int)ib; ConvJob JA, JB; fill_job(C, ra, JA); fill_job(C, rb, JB);
            float ga[32], gb[32]; conv_load(JA, ga, ra, C.lane); conv_load(JB, gb, rb, C.lane); conv_finish(JA, scr, ga, ra, C.lane); conv_finish(JB, scr, gb, rb, C.lane); }
        else if (ia < (unsigned)NFILL) { int r = (int)ia; ConvJob J; fill_job(C, r, J); conv_item(J, scr, r, C.lane); }
        force = (int)first + 2 * NWAVES < need;
    }
}
__device__ __forceinline__ void phase_fgemm(const Ctx& C, const bf16* A, const bf16* Bt, int nM, int nN, int K, bf16* O, int ldo) {
    pg8::Gemm g{A, Bt, K}; pg8::SchedStatic S{nM, nN, C.G, (int)blockIdx.x, (unsigned)K * 2u}; pg8::EpiStore E{O, ldo, 1.f, 0};
    pg8::gemm_phase<pg8::EpiStore, pg8::SchedStatic, true>(C.lds, g, S, E);
}
__device__ __forceinline__ void phase_fgemm_in0(const Ctx& C) {
    pg8::Gemm g{(const bf16*)(C.p.ws + WS_HB), (const bf16*)(C.p.ws + WS_WIN0), D}; pg8::SchedStatic S{MTOT / 256, NQKV0 / 256, C.G, (int)blockIdx.x, (unsigned)D};
    typedef pg8::EpiDeq<pg8::EpiQkv0> Epi;
    Epi E{pg8::EpiQkv0{(bf16*)(C.p.ws + WS_QKV), C.p.in[12], C.p.in[13], (const LAS f32x2*)(C.lds + ROPE_OFF)}, (const float*)(C.p.ws + WS_HS), C.ctl() + CM_IN0};
    pg8::gemm_phase<Epi, pg8::SchedStatic, true, 2>(C.lds, g, S, E);
}
__device__ __forceinline__ void phase_fgemm_gu0(const Ctx& C) {
    pg8::Gemm g{(const bf16*)(C.p.ws + WS_HB), (const bf16*)(C.p.ws + WS_WGU0), D}; pg8::SchedStatic S{MTOT / 256, 2 * FF0 / 256, C.G, (int)blockIdx.x, (unsigned)D};
    typedef pg8::EpiDeqSwiglu8 Epi;
    Epi E{C.p.ws + WS_ACT0, FF0, ACT0_SCALE, (const float*)(C.p.ws + WS_HS), C.ctl() + CM_GU0};
    pg8::gemm_phase<Epi, pg8::SchedStatic, true, 2>(C.lds, g, S, E);
}
#ifdef PROBE_GU0
template <class Inner> struct EpiIf { Inner in; int on;
    __device__ __forceinline__ void operator()(f32x4 (&acc)[2][2][4][2], const pg8::Unit& u, int wr, int wc, int fr, int fq) const { if (on) in(acc, u, wr, wc, fr, fq); } };
__device__ __forceinline__ void phase_fgemm_gu0_probe(const Ctx& C) {
    pg8::Gemm g{(const bf16*)(C.p.ws + WS_HB), (const bf16*)(C.p.ws + WS_WGU0), D}; pg8::SchedStatic S{MTOT / 256, 2 * FF0 / 256, C.G, (int)blockIdx.x, (unsigned)D};
    typedef EpiIf<pg8::EpiDeq<pg8::EpiSwiglu8>> Epi;
    Epi E{pg8::EpiDeq<pg8::EpiSwiglu8>{pg8::EpiSwiglu8{C.p.ws + WS_ACT0, FF0, 1.f, ACT0_SCALE}, (const float*)(C.p.ws + WS_HS), C.ctl() + CM_GU0}, (PROBE_GU0 == 1) ? 1 : (C.p.tpc == 77)};
    pg8::gemm_phase<Epi, pg8::SchedStatic, true, 2>(C.lds, g, S, E);
}
#endif
__device__ __forceinline__ void phase_fgemm_dn0(const Ctx& C) {
    pg8::Gemm g{(const bf16*)(C.p.ws + WS_ACT0), (const bf16*)(C.p.ws + WS_WDN0), FF0}; pg8::SchedStatic S{MTOT / 256, D / 256, C.G, (int)blockIdx.x, (unsigned)FF0};
    pg8::EpiStore E{(bf16*)(C.p.ws + WS_YB), D, 1.f / (W8DN0_SCALE * ACT0_SCALE), 1 << 20};
    pg8::gemm_phase<pg8::EpiStore, pg8::SchedStatic, true, 1>(C.lds, g, S, E);
}
__device__ __forceinline__ void phase_fgemm_in1(const Ctx& C) {
    pg8::Gemm g{(const bf16*)(C.p.ws + WS_HB), (const bf16*)(C.p.ws + WS_WIN1), D}; pg8::SchedIn1 S{C.G, (int)blockIdx.x};
    typedef pg8::EpiDeq<pg8::EpiStore> Epi;
    Epi E{pg8::EpiStore{(bf16*)(C.p.ws + WS_QKV), NQKV1, QSCALE, 4}, (const float*)(C.p.ws + WS_HS), C.ctl() + CM_IN1};
    pg8::gemm_phase<Epi, pg8::SchedIn1, true, 2>(C.lds, g, S, E);
}
__device__ __forceinline__ void phase_moe_gu_fast(const Ctx& C) {
    SchedMoeT<true> S; load_tiletab(C, S.T);
    S.t0 = 0; S.nT = S.T.tb[8]; S.nN = 2 * FFE / 256; S.G = C.G; S.c = (int)blockIdx.x; S.tokof = (const int*)(C.p.ws + WS_TOKOF); S.rowbytes = D; S.um = 0; S.tmt = 0; S.nl = 0; S.ptile0 = 0;
    pg8::Gemm g{(const bf16*)(C.p.ws + WS_H8), (const bf16*)(C.p.ws + WS_W8GU), D}; pg8::EpiSwiglu8 E{C.p.ws + WS_ACT8, FFE, 1.f / W8GU_SCALE, 1.f};
    pg8::gemm_phase<pg8::EpiSwiglu8, SchedMoeT<true>, true, 1>(C.lds, g, S, E);
}
__device__ __forceinline__ void phase_moe_dn_fast(const Ctx& C) {
    SchedMoeT<false> S; load_tiletab(C, S.T);
    S.t0 = 0; S.nT = S.T.tb[8]; S.nN = D / 256; S.G = C.G; S.c = (int)blockIdx.x; S.tokof = nullptr; S.rowbytes = FFE;
    moe_split(C, S.nT, S.tmt, S.nl); S.um = S.tmt * 4; S.ptile0 = MOE_PTILE0;
    pg8::Gemm g{(const bf16*)(C.p.ws + WS_ACT8), (const bf16*)(C.p.ws + WS_W8DN), FFE}; pg8::EpiStore E{(bf16*)(C.p.ws + WS_YS), D, 1.f / W8DN_SCALE, 1 << 20};
    pg8::gemm_phase<pg8::EpiStore, SchedMoeT<false>, true, 1>(C.lds, g, S, E);
}
namespace att {
typedef short bf16x8 __attribute__((ext_vector_type(8)));
typedef short s16x4 __attribute__((ext_vector_type(4)));
typedef float f32x16 __attribute__((ext_vector_type(16)));
constexpr int NSLOT = 4, SLOTB = 8192, LDS_K = 0, LDS_V = NSLOT * SLOTB, LDS_WS = 2 * NSLOT * SLOTB, LDS_OST = LDS_WS + 8 * 64 * 4, LDS_BIAS = LDS_OST + 8 * 4096, LDS_END = LDS_BIAS + 4096;
constexpr int BIAS_PAD = 64;
constexpr float THR = 8.f;
static_assert(LDS_END <= 131072, "attention LDS");
__device__ __forceinline__ int crow(int r, int hi) { return (r & 3) + 8 * (r >> 2) + 4 * hi; }
__device__ __forceinline__ void glds16(const void* gsrc, unsigned lds_dst) { unsigned keep;
    asm volatile("s_mov_b32 %0, m0\n\ts_mov_b32 m0, %2\n\ts_nop 0\n\tglobal_load_lds_dwordx4 %1, off\n\ts_mov_b32 m0, %0" : "=&s"(keep) : "v"(gsrc), "s"(lds_dst) : "memory"); }
#define ATT_WAIT_BAR(N) asm volatile("s_waitcnt vmcnt(" #N ") lgkmcnt(0)\n\ts_barrier" ::: "memory")
#define ATT_WAIT_BAR_Q(N, q) asm volatile("s_waitcnt vmcnt(" #N ") lgkmcnt(0)\n\ts_barrier" : "+v"(q[0]), "+v"(q[1]), "+v"(q[2]), "+v"(q[3]) :: "memory")
#define ATT_MX3(a, b, c) __builtin_fmaxf(__builtin_fmaxf((a), (b)), (c))
__device__ __forceinline__ unsigned cvtpk(float lo, float hi) { typedef float f2 __attribute__((ext_vector_type(2))); typedef __bf16 b2 __attribute__((ext_vector_type(2))); f2 v = {lo, hi}; b2 b = __builtin_convertvector(v, b2); return __builtin_bit_cast(unsigned, b); }
template <bool PF>
__device__ __forceinline__ void qkt(f32x16& p0, f32x16& p1, const LAS char* kslot, const bf16x8* qr, const f32x16& negm, int r32, int hi) {
    const LAS char* kb = kslot + hi * 1024 + r32 * 16;
    if constexpr (!PF) {
#pragma unroll
        for (int d0 = 0; d0 < 4; ++d0) {
            const bf16x8 b0 = *(const LAS bf16x8*)(kb + d0 * 2048);
            const bf16x8 b1 = *(const LAS bf16x8*)(kb + d0 * 2048 + 512);
            if (d0 == 0) { p0 = __builtin_amdgcn_mfma_f32_32x32x16_bf16(b0, qr[0], negm, 0, 0, 0); p1 = __builtin_amdgcn_mfma_f32_32x32x16_bf16(b1, qr[0], negm, 0, 0, 0); }
            else { p0 = __builtin_amdgcn_mfma_f32_32x32x16_bf16(b0, qr[d0], p0, 0, 0, 0); p1 = __builtin_amdgcn_mfma_f32_32x32x16_bf16(b1, qr[d0], p1, 0, 0, 0); } }
        return;
    }
    bf16x8 kf[8];
#pragma unroll
    for (int d0 = 0; d0 < 4; ++d0) { kf[2 * d0] = *(const LAS bf16x8*)(kb + d0 * 2048); kf[2 * d0 + 1] = *(const LAS bf16x8*)(kb + d0 * 2048 + 512); }
    __builtin_amdgcn_sched_barrier(0);
    p0 = __builtin_amdgcn_mfma_f32_32x32x16_bf16(kf[0], qr[0], negm, 0, 0, 0); p1 = __builtin_amdgcn_mfma_f32_32x32x16_bf16(kf[1], qr[0], negm, 0, 0, 0);
#pragma unroll
    for (int d0 = 1; d0 < 4; ++d0) { p0 = __builtin_amdgcn_mfma_f32_32x32x16_bf16(kf[2 * d0], qr[d0], p0, 0, 0, 0); p1 = __builtin_amdgcn_mfma_f32_32x32x16_bf16(kf[2 * d0 + 1], qr[d0], p1, 0, 0, 0); }
    __builtin_amdgcn_sched_barrier(0);
}
__device__ __forceinline__ void pv_load(s16x4 (&lo)[8], s16x4 (&hi)[8], int vb) {
#pragma unroll
    for (int d0 = 0; d0 < 2; ++d0)
#pragma unroll
        for (int ks = 0; ks < 4; ++ks) {
            asm volatile("ds_read_b64_tr_b16 %0,%1 offset:%c2" : "=&v"(lo[d0 * 4 + ks]) : "v"(vb), "i"(d0 * 4096 + ks * 1024) : "memory");
            asm volatile("ds_read_b64_tr_b16 %0,%1 offset:%c2" : "=&v"(hi[d0 * 4 + ks]) : "v"(vb), "i"(d0 * 4096 + ks * 1024 + 512) : "memory"); }
}
__device__ __forceinline__ void pv_mma(f32x16* o, const s16x4 (&lo)[8], const s16x4 (&hi)[8], bf16x8 pa0, bf16x8 pa1, bf16x8 pa2, bf16x8 pa3) {
    asm volatile("s_waitcnt lgkmcnt(0)" ::: "memory"); __builtin_amdgcn_sched_barrier(0);
#define ATT_PK(k) (bf16x8){lo[k][0], lo[k][1], lo[k][2], lo[k][3], hi[k][0], hi[k][1], hi[k][2], hi[k][3]}
#pragma unroll
    for (int d0 = 0; d0 < 2; ++d0) {
        o[d0] = __builtin_amdgcn_mfma_f32_32x32x16_bf16(pa0, ATT_PK(d0 * 4 + 0), o[d0], 0, 0, 0);
        o[d0] = __builtin_amdgcn_mfma_f32_32x32x16_bf16(pa1, ATT_PK(d0 * 4 + 1), o[d0], 0, 0, 0);
        o[d0] = __builtin_amdgcn_mfma_f32_32x32x16_bf16(pa2, ATT_PK(d0 * 4 + 2), o[d0], 0, 0, 0);
        o[d0] = __builtin_amdgcn_mfma_f32_32x32x16_bf16(pa3, ATT_PK(d0 * 4 + 3), o[d0], 0, 0, 0);
    }
#undef ATT_PK
}
struct UnitDesc {
    const bf16* q;
    const bf16* kv;
    bf16* o;
    const float* rpb;
    float mfix;
    int pitch, kcol, vcol;
    int base0, n0, base1, n1;
    int kind;
    int mk0, mk1;
    int has_sink; float sink2;
};
template <bool HAS1, bool HAS2, class DescFn>
__device__ __forceinline__ void attn_run(const Ctx& C, int nunits, const DescFn& desc) {
    if (nunits <= 0) return;
    const int lane = C.lane, r32 = lane & 31, hi = lane >> 5, wid = C.wave;
    LAS char* shm = (LAS char*)C.lds;
    const unsigned lds0 = (unsigned)(size_t)shm;
    LAS float* wsf = (LAS float*)(shm + LDS_WS) + wid * 64;
    LAS float* biasl = (LAS float*)(shm + LDS_BIAS);
    const unsigned kdst = lds0 + LDS_K + wid * 1024, vdst = lds0 + LDS_V + wid * 1024;
    const int vb0 = (int)(lds0 + LDS_V) + ((lane >> 4) & 1) * 32 + (lane & 3) * 8 + (4 * hi + ((lane & 15) >> 2)) * 64;
    const float NEG = -__builtin_inff();
#define ATT_TROW(U, t) ((t) < (U).n0 ? (U).base0 + 64 * (t) : (U).base1 + 64 * ((t) - (U).n0))
#define ATT_DMA(U, t, slot) do { const size_t ro_ = (size_t)(ATT_TROW(U, t)) * (U).pitch; \
        glds16((U).kv + (U).kcol + (size_t)lane * (U).pitch + wid * 8 + ro_, (unsigned)__builtin_amdgcn_readfirstlane(kdst + (slot))); \
        glds16((U).kv + (U).vcol + (size_t)(16 * (wid & 3) + (lane >> 2)) * (U).pitch + (wid >> 2) * 32 + (lane & 3) * 8 + ro_, (unsigned)__builtin_amdgcn_readfirstlane(vdst + (slot))); } while (0)
#define ATT_LDQ(dst, U) do { _Pragma("unroll") for (int d0_ = 0; d0_ < 4; ++d0_) { const bf16* qp_ = (U).q + (size_t)(wid * 32 + r32) * (U).pitch + d0_ * 16 + hi * 8; \
        asm volatile("global_load_dwordx4 %0, %1, off" : "=v"(dst[d0_]) : "v"(qp_) : "memory"); } } while (0)
    UnitDesc U, Un; desc(0, U); Un = U;
    bf16x8 qr[4];
    ATT_LDQ(qr, U);
    ATT_DMA(U, 0, 0); ATT_DMA(U, 1, SLOTB); ATT_DMA(U, 2, 2 * SLOTB);
    int gs = 0;
    const float* bias_have = nullptr;
    for (int ui = 0; ui < nunits; ++ui) {
        const bool has_next = ui + 1 < nunits;
        if (has_next) desc(ui + 1, Un);
        const int NTL = U.n0 + U.n1;
        unsigned mbits = 0xffffffffu;
        int c_q = 0;
        if (HAS2 && U.kind == 2) {
            if (U.rpb != bias_have) {
                asm volatile("s_waitcnt lgkmcnt(0)\n\ts_barrier" ::: "memory");
                for (int i = C.tid; i < 1024; i += NT) { const int j = i - BIAS_PAD; biasl[i] = (j >= 0 && j < 465) ? U.rpb[j] * LOG2E : 0.f; }
                asm volatile("s_waitcnt lgkmcnt(0)\n\ts_barrier" ::: "memory");
                bias_have = U.rpb;
            }
            c_q = 32 * (wid & 1) + r32; const int cs = min(max(c_q - 8, 0), 48);
            mbits = 0u;
#pragma unroll
            for (int i = 0; i < 16; ++i) { const int kc = 4 * hi + (i & 3) + 8 * (i >> 2);
                if (kc >= cs && kc <= cs + 15) mbits |= 1u << i;
                if (kc + 32 >= cs && kc + 32 <= cs + 15) mbits |= 1u << (16 + i); }
        }
        const bool fx = (U.kind == 0) && (U.mfix > 0.f) && (U.mfix <= 30.f);
        float mhat = fx ? U.mfix : 0.f, lsum = 0.f; f32x16 o[2]; o[0] = f32x16{}; o[1] = f32x16{};
        f32x16 negm;
#pragma unroll
        for (int i = 0; i < 16; ++i) negm[i] = -mhat;
        ATT_WAIT_BAR_Q(0, qr);
        if (!HAS2 && fx) {
            const f32x16 zc = f32x16{};
            mhat = 0.f;
            f32x16 pa0, pa1, pb0, pb1;
            qkt<true>(pa0, pa1, shm + LDS_K + (gs & 3) * SLOTB, qr, zc, r32, hi);
            auto step = [&](f32x16& pc0, f32x16& pc1, f32x16& pn0, f32x16& pn1, int t) __attribute__((always_inline)) {
                const int slot = (gs & 3) * SLOTB, nslot = ((gs + 1) & 3) * SLOTB;
                if (has_next || t + 2 < NTL) { ATT_WAIT_BAR(2); } else { ATT_WAIT_BAR(0); }
                { const int qslot = ((gs + 3) & 3) * SLOTB;
                  if (t + 3 < NTL) { ATT_DMA(U, t + 3, qslot); } else if (has_next) { ATT_DMA(Un, t + 3 - NTL, qslot); } }
                const LAS char* kb = shm + LDS_K + nslot + hi * 1024 + r32 * 16;
                bf16x8 kf[8];
#pragma unroll
                for (int d0 = 0; d0 < 4; ++d0) { kf[2 * d0] = *(const LAS bf16x8*)(kb + d0 * 2048); kf[2 * d0 + 1] = *(const LAS bf16x8*)(kb + d0 * 2048 + 512); }
                __builtin_amdgcn_sched_barrier(0);
                typedef LAS s16x4 LTV;
                LAS char* vp = shm + (vb0 + slot - (int)lds0);
                s16x4 vlo[8], vhi[8];
#pragma unroll
                for (int d0 = 0; d0 < 2; ++d0)
#pragma unroll
                    for (int ks = 0; ks < 4; ++ks) {
                        vlo[d0 * 4 + ks] = __builtin_amdgcn_ds_read_tr16_b64_v4i16((LTV*)(vp + d0 * 4096 + ks * 1024));
                        vhi[d0 * 4 + ks] = __builtin_amdgcn_ds_read_tr16_b64_v4i16((LTV*)(vp + d0 * 4096 + ks * 1024 + 512)); }
                pn0 = __builtin_amdgcn_mfma_f32_32x32x16_bf16(kf[0], qr[0], zc, 0, 0, 0); pn1 = __builtin_amdgcn_mfma_f32_32x32x16_bf16(kf[1], qr[0], zc, 0, 0, 0);
#pragma unroll
                for (int d0 = 1; d0 < 4; ++d0) { pn0 = __builtin_amdgcn_mfma_f32_32x32x16_bf16(kf[2 * d0], qr[d0], pn0, 0, 0, 0); pn1 = __builtin_amdgcn_mfma_f32_32x32x16_bf16(kf[2 * d0 + 1], qr[d0], pn1, 0, 0, 0); }
#pragma unroll
                for (int i = 0; i < 16; ++i) { pc0[i] = __builtin_amdgcn_exp2f(pc0[i]); pc1[i] = __builtin_amdgcn_exp2f(pc1[i]); }
                u32x4 w0, w1, w2, w3;
                w0 = (u32x4){cvtpk(pc0[0], pc0[1]), cvtpk(pc0[2], pc0[3]), cvtpk(pc0[4], pc0[5]), cvtpk(pc0[6], pc0[7])};
                w1 = (u32x4){cvtpk(pc0[8], pc0[9]), cvtpk(pc0[10], pc0[11]), cvtpk(pc0[12], pc0[13]), cvtpk(pc0[14], pc0[15])};
                w2 = (u32x4){cvtpk(pc1[0], pc1[1]), cvtpk(pc1[2], pc1[3]), cvtpk(pc1[4], pc1[5]), cvtpk(pc1[6], pc1[7])};
                w3 = (u32x4){cvtpk(pc1[8], pc1[9]), cvtpk(pc1[10], pc1[11]), cvtpk(pc1[12], pc1[13]), cvtpk(pc1[14], pc1[15])};
#pragma unroll
                for (int g = 0; g < 8; ++g) { __builtin_amdgcn_sched_group_barrier(0x400, 4, 0); __builtin_amdgcn_sched_group_barrier(0x008, 1, 0); __builtin_amdgcn_sched_group_barrier(0x100, 2, 0); __builtin_amdgcn_sched_group_barrier(0x002, 2, 0); }
                __builtin_amdgcn_sched_barrier(0);
#define ATT_PK(k) (bf16x8){vlo[k][0], vlo[k][1], vlo[k][2], vlo[k][3], vhi[k][0], vhi[k][1], vhi[k][2], vhi[k][3]}
                { const bf16x8 a0 = __builtin_bit_cast(bf16x8, w0), a1 = __builtin_bit_cast(bf16x8, w1), a2 = __builtin_bit_cast(bf16x8, w2), a3 = __builtin_bit_cast(bf16x8, w3);
#pragma unroll
                  for (int d0 = 0; d0 < 2; ++d0) {
                      o[d0] = __builtin_amdgcn_mfma_f32_32x32x16_bf16(a0, ATT_PK(d0 * 4 + 0), o[d0], 0, 0, 0);
                      o[d0] = __builtin_amdgcn_mfma_f32_32x32x16_bf16(a1, ATT_PK(d0 * 4 + 1), o[d0], 0, 0, 0);
                      o[d0] = __builtin_amdgcn_mfma_f32_32x32x16_bf16(a2, ATT_PK(d0 * 4 + 2), o[d0], 0, 0, 0);
                      o[d0] = __builtin_amdgcn_mfma_f32_32x32x16_bf16(a3, ATT_PK(d0 * 4 + 3), o[d0], 0, 0, 0); } }
#undef ATT_PK
                float sa = pc0[0], sb = pc0[1], sc = pc1[0], sd = pc1[1];
#pragma unroll
                for (int i = 2; i < 16; i += 2) {
                    asm("v_add_f32 %0, %1, %0" : "+v"(sa) : "v"(pc0[i])); asm("v_add_f32 %0, %1, %0" : "+v"(sb) : "v"(pc0[i + 1]));
                    asm("v_add_f32 %0, %1, %0" : "+v"(sc) : "v"(pc1[i])); asm("v_add_f32 %0, %1, %0" : "+v"(sd) : "v"(pc1[i + 1])); }
                asm("v_add_f32 %0, %1, %0" : "+v"(sa) : "v"(sb)); asm("v_add_f32 %0, %1, %0" : "+v"(sc) : "v"(sd));
                asm("v_add_f32 %0, %1, %0" : "+v"(sa) : "v"(sc));
                asm("v_add_f32 %0, %1, %0" : "+v"(lsum) : "v"(sa));
            };
            for (int t = 0; t < NTL; t += 2) {
                step(pa0, pa1, pb0, pb1, t); ++gs;
                if (t + 1 < NTL) { step(pb0, pb1, pa0, pa1, t + 1); ++gs; }
            }
        } else
        for (int t = 0; t < NTL; ++t, ++gs) {
            const int slot = (gs & 3) * SLOTB, pslot = ((gs + 2) & 3) * SLOTB;
            if (t == 0) { }
            else if (has_next || t + 2 < NTL) { ATT_WAIT_BAR(4); }
            else if (t + 1 < NTL) { ATT_WAIT_BAR(2); }
            else { ATT_WAIT_BAR(0); }
            { const int qslot = ((gs + 3) & 3) * SLOTB;
              if (t + 3 < NTL) { ATT_DMA(U, t + 3, qslot); } else if (has_next) { ATT_DMA(Un, t + 3 - NTL, qslot); } }
            const int sgi = t - U.n0;
            bool active = true, need_mask = false;
            if (sgi >= 0) {
                if (HAS1 && U.kind == 1) { const int klo = U.mk0 + 64 * sgi; active = (klo + 63 >= 32 * wid - 128) && (klo <= 32 * wid + 31 + 128);
                    need_mask = !((klo - 32 * wid - 31 >= -128) && (klo + 63 - 32 * wid <= 128)); }
                else if (HAS2 && U.kind == 2) { const int kr = U.mk0 + sgi, r = U.mk1 + (wid >> 1), rs = min(max(r - 4, 0), 24); active = (kr >= rs) && (kr <= rs + 7); }
            }
            if (active) {
                f32x16 p0, p1;
                constexpr bool PF = !HAS2;
                qkt<PF>(p0, p1, shm + LDS_K + slot, qr, negm, r32, hi);
                s16x4 vlo[8], vhi[8];
                if constexpr (PF) pv_load(vlo, vhi, vb0 + slot);
                if (HAS1 && sgi >= 0 && U.kind == 1) {
                    if (need_mask) {
                        const int kb = U.mk0 + 64 * sgi + 4 * hi - (32 * wid + r32);
#pragma unroll
                        for (int i = 0; i < 16; ++i) { const int d = kb + (i & 3) + 8 * (i >> 2);
                            if (d < -128 || d > 128) p0[i] = NEG;
                            if (d + 32 < -128 || d + 32 > 128) p1[i] = NEG; }
                    }
                } else if (HAS2 && sgi >= 0 && U.kind == 2) {
                    const int kr = U.mk0 + sgi, r = U.mk1 + (wid >> 1);
                    const LAS float* bp = biasl + (BIAS_PAD + (kr - r + 7) * 31 + 15 - c_q + 4 * hi);
#pragma unroll
                    for (int g4 = 0; g4 < 4; ++g4) {
#pragma unroll
                        for (int i = 4 * g4; i < 4 * g4 + 4; ++i) {
                            { const int m = ((int)(mbits << (31 - i))) >> 31; const unsigned x = __float_as_uint(p0[i] + bp[(i & 3) + 8 * (i >> 2)]); p0[i] = __uint_as_float((x & (unsigned)m) | (0xff800000u & ~(unsigned)m)); }
                            { const int m = ((int)(mbits << (15 - i))) >> 31; const unsigned x = __float_as_uint(p1[i] + bp[32 + (i & 3) + 8 * (i >> 2)]); p1[i] = __uint_as_float((x & (unsigned)m) | (0xff800000u & ~(unsigned)m)); } }
                    }
                if (!fx) {
                }
                float ma = ATT_MX3(p0[0], p0[1], p1[0]), mb = ATT_MX3(p0[2], p0[3], p1[1]); ma = ATT_MX3(ma, p1[2], p1[3]);
#pragma unroll
                for (int i = 4; i < 16; i += 4) { ma = ATT_MX3(ma, p0[i], p0[i + 1]); mb = ATT_MX3(mb, p0[i + 2], p0[i + 3]); ma = ATT_MX3(ma, p1[i], p1[i + 1]); mb = ATT_MX3(mb, p1[i + 2], p1[i + 3]); }
                float rm = __builtin_fmaxf(ma, mb);
                { auto rr = __builtin_amdgcn_permlane32_swap(__float_as_uint(rm), __float_as_uint(rm), false, false); rm = __builtin_fmaxf(__uint_as_float(rr[0]), __uint_as_float(rr[1])); }
                if (__any((t == 0) || (rm > THR))) {
                    const float dl = (t == 0) ? rm : __builtin_fmaxf(rm, 0.f);
                    mhat += dl;
#pragma unroll
                    for (int i = 0; i < 16; ++i) { p0[i] -= dl; p1[i] -= dl; }
#pragma unroll
                    for (int i = 0; i < 16; ++i) negm[i] = -mhat;
                    if (t != 0) {
                        const float f = __builtin_amdgcn_exp2f(-dl); lsum *= f;
                        if (hi == 0) wsf[r32] = f;
                        asm volatile("s_waitcnt lgkmcnt(0)" ::: "memory");
#pragma unroll
                        for (int i = 0; i < 16; ++i) { const float g = wsf[crow(i, hi)]; o[0][i] *= g; o[1][i] *= g; }
                    }
                }
                }
#pragma unroll
                for (int i = 0; i < 16; ++i) { p0[i] = __builtin_amdgcn_exp2f(p0[i]); p1[i] = __builtin_amdgcn_exp2f(p1[i]); }
                f32x2 s2 = (f32x2){0.f, 0.f};
#pragma unroll
                for (int i = 0; i < 16; i += 2) { s2 += (f32x2){p0[i], p0[i + 1]}; s2 += (f32x2){p1[i], p1[i + 1]}; }
                lsum += s2.x + s2.y;
                u32x4 w0, w1, w2, w3;
                w0 = (u32x4){cvtpk(p0[0], p0[1]), cvtpk(p0[2], p0[3]), cvtpk(p0[4], p0[5]), cvtpk(p0[6], p0[7])};
                w1 = (u32x4){cvtpk(p0[8], p0[9]), cvtpk(p0[10], p0[11]), cvtpk(p0[12], p0[13]), cvtpk(p0[14], p0[15])};
                w2 = (u32x4){cvtpk(p1[0], p1[1]), cvtpk(p1[2], p1[3]), cvtpk(p1[4], p1[5]), cvtpk(p1[6], p1[7])};
                w3 = (u32x4){cvtpk(p1[8], p1[9]), cvtpk(p1[10], p1[11]), cvtpk(p1[12], p1[13]), cvtpk(p1[14], p1[15])};
                if constexpr (!PF) pv_load(vlo, vhi, vb0 + slot);
                pv_mma(o, vlo, vhi, __builtin_bit_cast(bf16x8, w0), __builtin_bit_cast(bf16x8, w1), __builtin_bit_cast(bf16x8, w2), __builtin_bit_cast(bf16x8, w3));
            }
        }
        if (has_next) ATT_LDQ(qr, Un);
        { auto rr = __builtin_amdgcn_permlane32_swap(__float_as_uint(lsum), __float_as_uint(lsum), false, false); lsum = __uint_as_float(rr[0]) + __uint_as_float(rr[1]); }
        if (U.has_sink) lsum += __builtin_amdgcn_exp2f(U.sink2 - mhat);
        if (hi == 0) wsf[32 + r32] = lsum;
        asm volatile("s_waitcnt lgkmcnt(0)" ::: "memory");
        LAS bf16* stg = (LAS bf16*)(shm + LDS_OST) + wid * 2048;
#pragma unroll
        for (int i = 0; i < 16; ++i) { const int orow = crow(i, hi); const float rl = __builtin_amdgcn_rcpf(wsf[32 + orow]);
#pragma unroll
            for (int d0 = 0; d0 < 2; ++d0) stg[orow * 64 + d0 * 32 + r32] = (bf16)f2bf(o[d0][i] * rl); }
        asm volatile("s_waitcnt lgkmcnt(0)" ::: "memory");
        bf16* Ow = U.o + (size_t)(wid * 32) * D;
#pragma unroll
        for (int i = 0; i < 4; ++i) { const int row = i * 8 + (lane >> 3), ch = lane & 7; const u32x4 v = *(const LAS u32x4*)(stg + row * 64 + ch * 8); *(u32x4*)(Ow + (size_t)row * D + ch * 8) = v; }
        asm volatile("s_waitcnt lgkmcnt(0)" ::: "memory");
        if (has_next) U = Un;
    }
    asm volatile("s_waitcnt vmcnt(0) lgkmcnt(0)\n\ts_barrier" ::: "memory");
#undef ATT_TROW
#undef ATT_DMA
#undef ATT_LDQ
}

template <int MODE, class DescFn>
__device__ __forceinline__ void attn_run_na(const Ctx& C, int nunits, const DescFn& desc) {
    if (nunits <= 0) return;
    const int lane = C.lane, n = lane & 31, hi = lane >> 5, wid = C.wave;
    const int jg = wid & 3, pr = wid >> 2;
    const int kc0 = (jg == 0) ? 0 : (jg == 1) ? 8 : (jg == 2) ? 24 : 32;
    const int qrl = 2 * pr + (n >> 4), qc = 16 * jg + (n & 15);
    const int tokrel = qrl * 64 + qc;
    LAS char* shm = (LAS char*)C.lds;
    const unsigned lds0 = (unsigned)(size_t)shm;
    LAS float* wsf = (LAS float*)(shm + LDS_WS) + wid * 64;
    LAS float* biasl = (LAS float*)(shm + LDS_BIAS);
    const unsigned kdst = lds0 + LDS_K + wid * 1024, vdst = lds0 + LDS_V + wid * 1024;
    const int vbl = (int)(lds0 + LDS_V) + ((lane >> 4) & 1) * 32 + (lane & 3) * 8 + (4 * hi + ((lane & 15) >> 2)) * 64;
    const float NEG = -__builtin_inff();
    unsigned cbits = 0u;
    { const int cs = min(max(qc - 8, 0), 48);
#pragma unroll
      for (int i = 0; i < 16; ++i) { const int kc = kc0 + crow(i, hi); if (kc >= cs && kc <= cs + 15) cbits |= 1u << i; } }
#define ATT_TROW(U, t) ((t) < (U).n0 ? (U).base0 + 64 * (t) : (U).base1 + 64 * ((t) - (U).n0))
#define ATT_DMA(U, t, slot) do { const size_t ro_ = (size_t)(ATT_TROW(U, t)) * (U).pitch; \
        glds16((U).kv + (U).kcol + (size_t)lane * (U).pitch + wid * 8 + ro_, (unsigned)__builtin_amdgcn_readfirstlane(kdst + (slot))); \
        glds16((U).kv + (U).vcol + (size_t)(16 * (wid & 3) + (lane >> 2)) * (U).pitch + (wid >> 2) * 32 + (lane & 3) * 8 + ro_, (unsigned)__builtin_amdgcn_readfirstlane(vdst + (slot))); } while (0)
#define ATT_LDQ(dst, U) do { _Pragma("unroll") for (int d0_ = 0; d0_ < 4; ++d0_) { const bf16* qp_ = (U).q + (size_t)tokrel * (U).pitch + d0_ * 16 + hi * 8; \
        asm volatile("global_load_dwordx4 %0, %1, off" : "=v"(dst[d0_]) : "v"(qp_) : "memory"); } } while (0)
    UnitDesc U, Un; desc(0, U); Un = U;
    bf16x8 qr[4];
    if (MODE != 1) ATT_LDQ(qr, U); else { for (int d0_ = 0; d0_ < 4; ++d0_) qr[d0_] = bf16x8{}; }
    ATT_DMA(U, 0, 0); ATT_DMA(U, 1, SLOTB); ATT_DMA(U, 2, 2 * SLOTB);
    int gs = 0;
    const float* bias_have = nullptr;
    for (int ui = 0; ui < nunits; ++ui) {
        const bool has_next = ui + 1 < nunits;
        if (has_next) desc(ui + 1, Un);
        const int NTL = U.n0 + U.n1;
        if (U.rpb != bias_have) {
            asm volatile("s_waitcnt lgkmcnt(0)\n\ts_barrier" ::: "memory");
            for (int i = C.tid; i < 1024; i += NT) { const int j = i - BIAS_PAD; biasl[i] = (j >= 0 && j < 465) ? U.rpb[j] * LOG2E : 0.f; }
            asm volatile("s_waitcnt lgkmcnt(0)\n\ts_barrier" ::: "memory");
            bias_have = U.rpb;
        }
        const int rA = U.mk1 + 2 * pr;
        const int rq = rA + (n >> 4);
        const int rsq = min(max(rq - 4, 0), 24);
        float mhat = 0.f, lsum = 0.f; f32x16 o[2]; o[0] = f32x16{}; o[1] = f32x16{};
        f32x16 negm = f32x16{};
        bool first = true;
        for (int t = 0; t < NTL; ++t, ++gs) {
            const int slot = (gs & 3) * SLOTB, pslot = ((gs + 2) & 3) * SLOTB;
            if (MODE == 2) { if (gs < 2) { ATT_DMA(U, t + 2, pslot); } ATT_WAIT_BAR_Q(0, qr); }
            else if (t == 0) { ATT_WAIT_BAR_Q(0, qr); }
            else if (has_next || t + 2 < NTL) { ATT_WAIT_BAR(4); }
            else if (t + 1 < NTL) { ATT_WAIT_BAR(2); }
            else { ATT_WAIT_BAR(0); }
            if (MODE != 2) { const int qslot = ((gs + 3) & 3) * SLOTB;
              if (t + 3 < NTL) { ATT_DMA(U, t + 3, qslot); } else if (has_next) { ATT_DMA(Un, t + 3 - NTL, qslot); } }
            const int sgi = t - U.n0;
            const bool band = sgi >= 0;
            const int kr = U.mk0 + sgi;
            bool active = true;
            if (band) { const int rsa = min(max(rA - 4, 0), 24), rsb = min(max(rA + 1 - 4, 0), 24); active = (kr >= rsa) && (kr <= rsb + 7); }
            if (MODE == 1) active = false;
            if (active) {
                const int nblk = band ? 1 : 2;
                for (int bi = 0; bi < nblk; ++bi) {
                    const int kcb = band ? kc0 : 32 * bi;
                    const LAS char* kb = shm + LDS_K + slot + hi * 1024 + (kcb + n) * 16;
                    bf16x8 kf[4];
#pragma unroll
                    for (int d0 = 0; d0 < 4; ++d0) kf[d0] = *(const LAS bf16x8*)(kb + d0 * 2048);
                    f32x16 p = __builtin_amdgcn_mfma_f32_32x32x16_bf16(kf[0], qr[0], negm, 0, 0, 0);
#pragma unroll
                    for (int d0 = 1; d0 < 4; ++d0) p = __builtin_amdgcn_mfma_f32_32x32x16_bf16(kf[d0], qr[d0], p, 0, 0, 0);
                    s16x4 vlo[4], vhi[4];
                    { const int t0 = kcb, t1 = kcb + 8, t2 = kcb + 16, t3 = kcb + 24;
                      const int a0 = vbl + slot + (t0 >> 4) * 1024 + ((t0 >> 3) & 1) * 512, a1 = vbl + slot + (t1 >> 4) * 1024 + ((t1 >> 3) & 1) * 512;
                      const int a2 = vbl + slot + (t2 >> 4) * 1024 + ((t2 >> 3) & 1) * 512, a3 = vbl + slot + (t3 >> 4) * 1024 + ((t3 >> 3) & 1) * 512;
                      asm volatile("ds_read_b64_tr_b16 %0,%1" : "=&v"(vlo[0]) : "v"(a0) : "memory"); asm volatile("ds_read_b64_tr_b16 %0,%1" : "=&v"(vhi[0]) : "v"(a1) : "memory");
                      asm volatile("ds_read_b64_tr_b16 %0,%1" : "=&v"(vlo[1]) : "v"(a2) : "memory"); asm volatile("ds_read_b64_tr_b16 %0,%1" : "=&v"(vhi[1]) : "v"(a3) : "memory");
                      asm volatile("ds_read_b64_tr_b16 %0,%1 offset:4096" : "=&v"(vlo[2]) : "v"(a0) : "memory"); asm volatile("ds_read_b64_tr_b16 %0,%1 offset:4096" : "=&v"(vhi[2]) : "v"(a1) : "memory");
                      asm volatile("ds_read_b64_tr_b16 %0,%1 offset:4096" : "=&v"(vlo[3]) : "v"(a2) : "memory"); asm volatile("ds_read_b64_tr_b16 %0,%1 offset:4096" : "=&v"(vhi[3]) : "v"(a3) : "memory"); }
                    if (band) {
                        const bool rowok = (kr >= rsq) && (kr <= rsq + 7);
                        const unsigned mb = rowok ? cbits : 0u;
                        const LAS float* bp = biasl + (BIAS_PAD + (kr - rq + 7) * 31 + 15 - qc + kcb + 4 * hi);
#pragma unroll
                        for (int i = 0; i < 16; ++i) { const int m = ((int)(mb << (31 - i))) >> 31; const unsigned x = __float_as_uint(p[i] + bp[(i & 3) + 8 * (i >> 2)]);
                            p[i] = __uint_as_float((x & (unsigned)m) | (0xff800000u & ~(unsigned)m)); }
                    }
                    float ma = ATT_MX3(p[0], p[1], p[2]), mb2 = ATT_MX3(p[3], p[4], p[5]);
                    ma = ATT_MX3(ma, p[6], p[7]); mb2 = ATT_MX3(mb2, p[8], p[9]); ma = ATT_MX3(ma, p[10], p[11]); mb2 = ATT_MX3(mb2, p[12], p[13]); ma = ATT_MX3(ma, p[14], p[15]);
                    float rm = __builtin_fmaxf(ma, mb2);
                    { auto rr = __builtin_amdgcn_permlane32_swap(__float_as_uint(rm), __float_as_uint(rm), false, false); rm = __builtin_fmaxf(__uint_as_float(rr[0]), __uint_as_float(rr[1])); }
                    if (__any(first || (rm > THR))) {
                        const float dl = first ? rm : __builtin_fmaxf(rm, 0.f);
                        mhat += dl;
#pragma unroll
                        for (int i = 0; i < 16; ++i) p[i] -= dl;
#pragma unroll
                        for (int i = 0; i < 16; ++i) negm[i] = -mhat;
                        if (!first) {
                            const float f = __builtin_amdgcn_exp2f(-dl); lsum *= f;
                            if (hi == 0) wsf[n] = f;
                            asm volatile("s_waitcnt lgkmcnt(0)" ::: "memory");
#pragma unroll
                            for (int i = 0; i < 16; ++i) { const float g = wsf[crow(i, hi)]; o[0][i] *= g; o[1][i] *= g; }
                        }
                    }
                    first = false;
                    float sacc = 0.f;
#pragma unroll
                    for (int i = 0; i < 16; ++i) { p[i] = __builtin_amdgcn_exp2f(p[i]); sacc += p[i]; }
                    lsum += sacc;
                    const u32x4 w0 = (u32x4){cvtpk(p[0], p[1]), cvtpk(p[2], p[3]), cvtpk(p[4], p[5]), cvtpk(p[6], p[7])};
                    const u32x4 w1 = (u32x4){cvtpk(p[8], p[9]), cvtpk(p[10], p[11]), cvtpk(p[12], p[13]), cvtpk(p[14], p[15])};
                    asm volatile("s_waitcnt lgkmcnt(0)" ::: "memory"); __builtin_amdgcn_sched_barrier(0);
#define ATT_VF(k) (bf16x8){vlo[k][0], vlo[k][1], vlo[k][2], vlo[k][3], vhi[k][0], vhi[k][1], vhi[k][2], vhi[k][3]}
                    o[0] = __builtin_amdgcn_mfma_f32_32x32x16_bf16(__builtin_bit_cast(bf16x8, w0), ATT_VF(0), o[0], 0, 0, 0);
                    o[0] = __builtin_amdgcn_mfma_f32_32x32x16_bf16(__builtin_bit_cast(bf16x8, w1), ATT_VF(1), o[0], 0, 0, 0);
                    o[1] = __builtin_amdgcn_mfma_f32_32x32x16_bf16(__builtin_bit_cast(bf16x8, w0), ATT_VF(2), o[1], 0, 0, 0);
                    o[1] = __builtin_amdgcn_mfma_f32_32x32x16_bf16(__builtin_bit_cast(bf16x8, w1), ATT_VF(3), o[1], 0, 0, 0);
#undef ATT_VF
                }
            }
        }
        if (MODE == 1) { if (has_next) U = Un; continue; }
        if (has_next) ATT_LDQ(qr, Un);
        { auto rr = __builtin_amdgcn_permlane32_swap(__float_as_uint(lsum), __float_as_uint(lsum), false, false); lsum = __uint_as_float(rr[0]) + __uint_as_float(rr[1]); }
        if (hi == 0) wsf[32 + n] = lsum;
        asm volatile("s_waitcnt lgkmcnt(0)" ::: "memory");
        LAS bf16* stg = (LAS bf16*)(shm + LDS_OST) + wid * 2048;
#pragma unroll
        for (int i = 0; i < 16; ++i) { const int orow = crow(i, hi); const float rl = __builtin_amdgcn_rcpf(wsf[32 + orow]);
#pragma unroll
            for (int d0 = 0; d0 < 2; ++d0) stg[orow * 64 + d0 * 32 + n] = (bf16)f2bf(o[d0][i] * rl); }
        asm volatile("s_waitcnt lgkmcnt(0)" ::: "memory");
#pragma unroll
        for (int i = 0; i < 4; ++i) { const int sl = i * 8 + (lane >> 3), ch = lane & 7; const u32x4 v = *(const LAS u32x4*)(stg + sl * 64 + ch * 8);
            const int trel = (2 * pr + (sl >> 4)) * 64 + 16 * jg + (sl & 15);
            if (MODE == 0 || C.p.tpc == 77) *(u32x4*)(U.o + (size_t)trel * D + ch * 8) = v; }
        asm volatile("s_waitcnt lgkmcnt(0)" ::: "memory");
        if (has_next) U = Un;
    }
    asm volatile("s_waitcnt vmcnt(0) lgkmcnt(0)\n\ts_barrier" ::: "memory");
#undef ATT_TROW
#undef ATT_DMA
#undef ATT_LDQ
}
}

struct Desc0 {
    const bf16* QKV; bf16* O; const float* sink; int v; float mfix;
    __device__ __forceinline__ void operator()(int i, att::UnitDesc& U) const {
        const int b = v >> 4, kvh = (v >> 3) & 1, qb = v & 7;
        U.mfix = 0.f;
        const size_t qrow0 = (size_t)b * SEQ + 256 * qb;
        U.kv = QKV; U.rpb = nullptr; U.pitch = NQKV0; U.mk1 = 0;
        if (i < 4) {
            const int h = kvh * 4 + i;
            U.q = QKV + qrow0 * NQKV0 + h * 64; U.o = O + qrow0 * D + h * 64; U.kcol = 512 + kvh * 64; U.vcol = 640 + kvh * 64;
            U.base0 = b * SEQ; U.n0 = 32; U.base1 = NLAT + b * CTXL; U.n1 = 4; U.kind = 0; U.mk0 = 0; U.has_sink = 0; U.sink2 = 0.f; U.mfix = mfix;
        } else if (i < 8) {
            const int h = kvh * 4 + (i - 4);
            const int jlo = (qb == 0) ? 2 : 0, jhi = (qb == 7) ? 6 : 8;
            U.q = QKV + qrow0 * NQKV0 + 768 + h * 64; U.o = O + qrow0 * D + 512 + h * 64; U.kcol = 1280 + kvh * 64; U.vcol = 1408 + kvh * 64;
            U.base0 = NLAT + b * CTXL; U.n0 = 4; U.base1 = b * SEQ + 256 * qb - 128 + 64 * jlo; U.n1 = jhi - jlo; U.kind = 1; U.mk0 = -128 + 64 * jlo; U.has_sink = 1; U.sink2 = sink[h] * LOG2E;
        } else {
            const int h16 = v & 15, isA = h16 < 8, hh = h16 & 7, kh = hh >> 2;
            const size_t crow0 = (size_t)NLAT + (size_t)b * CTXL;
            U.q = QKV + crow0 * NQKV0 + (isA ? 0 : 768) + hh * 64; U.o = O + crow0 * D + h16 * 64;
            U.kcol = (isA ? 512 : 1280) + kh * 64; U.vcol = (isA ? 640 : 1408) + kh * 64;
            U.base0 = NLAT + b * CTXL; U.n0 = 4; U.base1 = 0; U.n1 = 0; U.kind = 0; U.mk0 = 0; U.has_sink = isA ? 0 : 1; U.sink2 = isA ? 0.f : sink[hh] * LOG2E; U.mfix = isA ? mfix : 0.f;
        }
    }
};
__device__ __forceinline__ void phase_attn0_fast(const Ctx& C) {
    float gq = fabsf(C.p.in[12][C.lane]), gk = fabsf(C.p.in[13][C.lane]);
#pragma unroll
    for (int o = 32; o >= 1; o >>= 1) { gq = fmaxf(gq, __shfl_xor(gq, o)); gk = fmaxf(gk, __shfl_xor(gk, o)); }
    const float mfix = __builtin_bit_cast(float, __builtin_amdgcn_readfirstlane(__builtin_bit_cast(int, 64.f * gq * gk * QSCALE * 1.02f)));
    for (int v = C.vcu; v < 256; v += C.G) {
        Desc0 d{(const bf16*)(C.p.ws + WS_QKV), C.hb(), C.p.in[14], v, mfix};
        att::attn_run<true, false>(C, 9, d);
    }
}
struct Desc1 {
    const bf16* QKV; bf16* O; const float* rpb; int v;
    __device__ __forceinline__ void operator()(int rb, att::UnitDesc& U) const {
        const int x = v >> 5, j = v & 31, g = j >> 3, st = rb;
        const int h = 2 * x + (g >> 1), b = (g & 1) * 8 + st; rb = (j + st) & 7;
        const int rq0 = 4 * rb, krlo = min(max(rq0 - 4, 0), 24), krhi = min(max(rq0 + 3 - 4, 0), 24) + 7;
        const size_t qrow0 = (size_t)b * SEQ + 256 * rb;
        U.q = QKV + qrow0 * NQKV1 + h * 64; U.kv = QKV; U.o = O + qrow0 * D + h * 64; U.rpb = rpb + (size_t)h * 465; U.pitch = NQKV1; U.kcol = 1024 + h * 64; U.vcol = 2048 + h * 64;
        U.base0 = NLAT + b * CTXL; U.n0 = 4; U.base1 = b * SEQ + 64 * krlo; U.n1 = krhi - krlo + 1; U.kind = 2; U.mk0 = krlo; U.mk1 = rq0; U.has_sink = 0; U.sink2 = 0.f; U.mfix = 0.f;
    }
};
__device__ __forceinline__ void phase_attn1_fast(const Ctx& C) {
    for (int v = C.vcu; v < 256; v += C.G) {
        Desc1 d{(const bf16*)(C.p.ws + WS_QKV), C.hb(), C.p.in[26], v};
        att::attn_run_na<0>(C, 8, d);
    }
}
#ifdef PROBE_ATT1
__device__ __forceinline__ void phase_attn1_probe(const Ctx& C) {
    for (int v = C.vcu; v < 256; v += C.G) {
        Desc1 d{(const bf16*)(C.p.ws + WS_QKV), C.hb(), C.p.in[26], v};
        att::attn_run_na<PROBE_ATT1>(C, 8, d);
    }
}
#endif

constexpr int S_MODS = 0, S_MOD0 = 1, S_IN0 = 2, S_ATT0 = 3, S_OUT0 = 4, S_THIN0A = 5, S_GU0 = 6, S_DN0 = 7, S_THIN0B = 8,
              S_IN1 = 9, S_ATT1 = 10, S_OUT1 = 11, S_THIN1A = 12, S_MOE = 13, S_FINAL = S_MOE + 2, S_END = S_FINAL + 1;
#ifndef REP_ATT0
#define REP_ATT0 1
#endif
#ifndef REP_ATT1
#define REP_ATT1 1
#endif
#ifndef REP_MOE
#define REP_MOE 1
#endif
#ifndef REP_FFN0
#define REP_FFN0 1
#endif
#ifndef REP_PROJ
#define REP_PROJ 1
#endif
#ifndef REP_PRO
#define REP_PRO 1
#endif
#define RPT1(...) __VA_ARGS__
#define RPT2(...) __VA_ARGS__ __VA_ARGS__
#define RPT_(n, ...) RPT##n(__VA_ARGS__)
#define RPT(n, ...) RPT_(n, __VA_ARGS__)
#ifndef MK_ONE_LAUNCH
#define MK_ONE_LAUNCH 1
#endif

__global__ void __launch_bounds__(NT, 2) k_run(Params p, int lo, int hi) {
    extern __shared__ __attribute__((aligned(16))) unsigned char lds_raw[];
    Ctx C; C.p = p; C.lds = (LAS unsigned char*)lds_raw;
    C.tid = threadIdx.x; C.lane = C.tid & 63; C.wave = __builtin_amdgcn_readfirstlane(C.tid >> 6);
    C.G = gridDim.x; { const int bx = blockIdx.x; C.vcu = (C.G % 8 == 0) ? (bx % 8) * (C.G / 8) + bx / 8 : bx; }
    volatile LAS unsigned* MISC = (volatile LAS unsigned*)(C.lds + MISC_OFF);
    if (C.tid < 32) MISC[C.tid] = 0u;
    for (int i = C.tid; i < 1024; i += NT) { const int pos = i >> 4, j = i & 15; const float ang = (float)pos * exp2f(-(float)j * (13.287712379549449f / 16.f)); float sn, cs; __sincosf(ang, &sn, &cs);
        ((LAS f32x2*)(C.lds + ROPE_OFF))[pos * 17 + j] = (f32x2){cs, sn}; }
    __syncthreads();
    const bool one = (hi - lo) > 1;
    XcdBarrier bar; bar.bar = (unsigned*)C.ctl() + CW_BAR; bar.x = 0; bar.st = nullptr;
    if (one) bar = xcd_barrier_post((unsigned*)C.ctl() + CW_BAR, MISC + 8);
#define IN(k) (lo <= (k) && (k) < hi)
#define SEAM(k, need) do { if (one) { filler(C, (k), (need), MISC); xcd_barrier(bar); } } while (0)
#define SEAMP() do { if (one) xcd_barrier(bar); } while (0)
    unsigned char* ws = p.ws;
    RPT(REP_PRO, if (IN(S_MODS)) { phase_mods(C); __syncthreads(); phase_colmax(C); phase_convert(C); SEAMP(); })
    if (IN(S_MOD0)) { phase_modulate0(C); phase_convert_q(C); SEAMP(); }
    RPT(REP_PROJ, if (IN(S_IN0)) { phase_fgemm_in0(C); SEAM(2, 0); })
    RPT(REP_ATT0, if (IN(S_ATT0)) { phase_attn0_fast(C); SEAMP(); })
    RPT(REP_PROJ, if (IN(S_OUT0)) { phase_fgemm(C, C.hb(), (const bf16*)(ws + WS_WOUT0), MTOT / 256, D / 256, D, (bf16*)(ws + WS_YA), D); SEAM(4, 0); })
    if (IN(S_THIN0A)) { phase_thin0a(C); SEAMP(); }
#ifdef PROBE_GU0
    if (IN(S_GU0)) { phase_fgemm_gu0_probe(C); SEAM(6, 0); }
#endif
    RPT(REP_FFN0, if (IN(S_GU0)) { phase_fgemm_gu0(C); SEAM(6, 0); }
    if (IN(S_DN0)) { phase_fgemm_dn0(C); SEAM(7, 0); })
    if (IN(S_THIN0B)) { phase_thin0b(C); SEAM(8, NFILL_L1); }
    RPT(REP_PROJ, if (IN(S_IN1)) { phase_fgemm_in1(C); SEAM(9, 0); })
    RPT(REP_ATT1, if (IN(S_ATT1)) { phase_attn1_fast(C); SEAMP(); })
#ifdef PROBE_ATT1
    if (IN(S_ATT1)) { phase_attn1_probe(C); SEAMP(); }
#endif
    RPT(REP_PROJ, if (IN(S_OUT1)) { phase_fgemm(C, C.hb(), (const bf16*)(ws + WS_WOUT1), NLAT / 256, D / 256, D, (bf16*)(ws + WS_YA), D); SEAMP(); })
    if (IN(S_THIN1A)) { phase_thin1a(C); SEAM(12, NFILL); }
    RPT(REP_MOE, if (IN(S_MOE)) { phase_moe_gu_fast(C); SEAMP(); }
    if (IN(S_MOE + 1)) { phase_moe_dn_fast(C); SEAMP(); })
    if (IN(S_FINAL)) phase_final(C);
#undef IN
#undef SEAM
#undef SEAMP
}

extern "C" void kernel_launch(void* const* d_in, const int* in_sizes, int n_in, void* d_out, int out_size, void* d_ws, size_t ws_size, hipStream_t stream) {
    static int grid = 0;
    if (grid == 0) {
        if (n_in != 31 || out_size != NLAT * D || ws_size < WS_MIN) { fprintf(stderr, "kernel_launch: unexpected problem (n_in %d out %d ws %zu)\n", n_in, out_size, ws_size); grid = -1; return; }
        int dev = 0, cus = 0;
        if (hipGetDevice(&dev) != hipSuccess || hipDeviceGetAttribute(&cus, hipDeviceAttributeMultiprocessorCount, dev) != hipSuccess) { grid = -1; return; }
        if (hipFuncSetAttribute((const void*)k_run, hipFuncAttributeMaxDynamicSharedMemorySize, LDS_BYTES) != hipSuccess) { grid = -1; return; }
        grid = cus;
    }
    if (grid < 0) return;
    (void)hipMemsetAsync((char*)d_ws + WS_CTL, 0, CTL_ZERO_BYTES, stream);
    Params p{};
    for (int i = 0; i < 31; ++i) p.in[i] = (const float*)d_in[i];
    p.out = (float*)d_out; p.ws = (unsigned char*)d_ws;
    p.tpc = 0; p.pad = 0;
#if MK_ONE_LAUNCH
    hipLaunchKernelGGL(k_run, dim3(grid), dim3(NT), LDS_BYTES, stream, p, 0, S_END);
#else
    for (int s = 0; s < S_END; ++s) hipLaunchKernelGGL(k_run, dim3(grid), dim3(NT), LDS_BYTES, stream, p, s, s + 1);
#endif
}
```
